# Optimizing an MI355X kernel written in HIP

```python
import math
import jax, jax.numpy as jnp
from jax import lax
import numpy as np

D_MODEL = 1024
BATCH = 4
SEQ = 4096
DEPTH = 2

GRID_W = 64
CTX_LEN = 256
EPS = 1e-6
POOL_WINDOWS = (2, 4, 8, 16)
POOL_GROUP = D_MODEL // 16
POOL_WIDTH = len(POOL_WINDOWS) * POOL_GROUP
DIFF_HEAD_DIM = 64
DIFF_V_DIM = 2 * DIFF_HEAD_DIM
DIFF_HEADS = (D_MODEL - POOL_WIDTH) // DIFF_V_DIM
DIFF_WIDTH = DIFF_HEADS * DIFF_V_DIM
QK_WIDTH = DIFF_HEADS * 2 * DIFF_HEAD_DIM
EVEN_IN_WIDTH = POOL_WIDTH + 2 * QK_WIDTH + DIFF_WIDTH
SPLIT_IDX = [POOL_WIDTH, POOL_WIDTH + QK_WIDTH, POOL_WIDTH + 2 * QK_WIDTH]
KV_START = POOL_WIDTH + QK_WIDTH
Q_BLOCK = 128
ROPE_THETA = 10000.0
ROPE_AXIS_PAIRS = DIFF_HEAD_DIM // 4
CHUNK = 128
SG_WIDTH = 2 * D_MODEL
SG_GROUPS = 8
SG_GROUP_DIM = SG_WIDTH // SG_GROUPS
FFN_HIDDEN = 4 * D_MODEL

kernel_name = 'hybrid_pool_diffattn_sgmlp_prefix_dit'


def rms_norm(x, g):
    xf = x.astype(jnp.float32)
    y = xf * lax.rsqrt(jnp.mean(xf * xf, axis=-1, keepdims=True) + EPS) * g
    return y.astype(x.dtype)


def layer_norm(x, g, b):
    xf = x.astype(jnp.float32)
    mu = jnp.mean(xf, axis=-1, keepdims=True)
    var = jnp.mean(jnp.square(xf - mu), axis=-1, keepdims=True)
    return ((xf - mu) * lax.rsqrt(var + EPS) * g + b).astype(x.dtype)


def modulate(h, shift, scale):
    return h * (1.0 + scale) + shift


def axial_rope(n_tok):
    t = jnp.arange(n_tok, dtype=jnp.int32)
    rows = (t // GRID_W).astype(jnp.float32)
    cols = (t % GRID_W).astype(jnp.float32)
    inv = ROPE_THETA ** (-jnp.arange(ROPE_AXIS_PAIRS, dtype=jnp.float32) / ROPE_AXIS_PAIRS)
    ang = jnp.concatenate([rows[:, None] * inv, cols[:, None] * inv], axis=-1)
    return jnp.cos(ang), jnp.sin(ang)


def apply_rope(x, cos, sin):
    shp = (1, cos.shape[0]) + (1,) * (x.ndim - 3) + (cos.shape[1],)
    cs, sn = cos.reshape(shp), sin.reshape(shp)
    xr = x.astype(jnp.float32).reshape(x.shape[:-1] + (-1, 2))
    x0, x1 = xr[..., 0], xr[..., 1]
    out = jnp.stack([x0 * cs - x1 * sn, x0 * sn + x1 * cs], axis=-1)
    return out.reshape(x.shape).astype(x.dtype)


def heads_qk(t, g):
    t = t.reshape(t.shape[:2] + (DIFF_HEADS, 2, DIFF_HEAD_DIM))
    return rms_norm(t, g)


def pool_mix(u, pool_w, pool_scale):
    b_, n, _ = u.shape
    uf = u.astype(jnp.float32)
    csum = jnp.concatenate([jnp.zeros((b_, 1, POOL_WIDTH), jnp.float32), jnp.cumsum(uf, axis=1)], axis=1)
    t = jnp.arange(n)
    outs = []
    for gi, w in enumerate(POOL_WINDOWS):
        lo = jnp.clip(t - w // 2, 0, n)
        hi = jnp.clip(t + w // 2, 0, n)
        sl = slice(gi * POOL_GROUP, (gi + 1) * POOL_GROUP)
        cs = csum[:, :, sl]
        mean = (cs[:, hi] - cs[:, lo]) / (hi - lo).astype(jnp.float32)[None, :, None]
        outs.append(mean - uf[:, :, sl])
    pooled = jnp.stack(outs, axis=2).astype(u.dtype)
    y = jnp.einsum('blgc,gcd->blgd', pooled, pool_w).reshape(b_, n, POOL_WIDTH)
    return y * pool_scale


def diff_attention(q, k, v, lam):
    b_, n = q.shape[:2]
    nb = n // Q_BLOCK
    qb = jnp.moveaxis(q.reshape((b_, nb, Q_BLOCK) + q.shape[2:]), 1, 0)
    scale = DIFF_HEAD_DIM ** -0.5

    def block(qi):
        s = jnp.einsum('bqhcd,bkhcd->bchqk', qi, k, preferred_element_type=jnp.float32) * scale
        p = jax.nn.softmax(s, axis=-1)
        wgt = p[:, 0] - lam * p[:, 1]
        return jnp.einsum('bhqk,bkhe->bqhe', wgt.astype(v.dtype), v)

    out = lax.map(block, qb)
    return jnp.moveaxis(out, 0, 1).reshape(b_, n, DIFF_HEADS, DIFF_V_DIM)


def even_merge(pool_in, attn, w_out, pool_w, pool_scale, sub_g, lam_init):
    attn = rms_norm(attn, sub_g) * (1.0 - lam_init)
    y = jnp.concatenate([pool_mix(pool_in, pool_w, pool_scale),
                         attn.reshape(attn.shape[:2] + (DIFF_WIDTH,))], axis=-1)
    return y @ w_out


def even_mixer(h, hc, w_in, w_out, pool_w, pool_scale, q_g, k_g, lam, sub_g, lam_init, cos, sin, ctx_out):
    b_, n, _ = h.shape
    pool_in, q, k, v = jnp.split(h @ w_in, SPLIT_IDX, axis=-1)
    q = apply_rope(heads_qk(q, q_g), cos, sin)
    k = apply_rope(heads_qk(k, k_g), cos, sin)
    v = v.reshape(b_, n, DIFF_HEADS, DIFF_V_DIM)
    if ctx_out:
        pool_c, qc, kc, vc = jnp.split(hc @ w_in, SPLIT_IDX, axis=-1)
    else:
        kc, vc = jnp.split(hc @ w_in[:, KV_START:], [QK_WIDTH], axis=-1)
    kc = heads_qk(kc, k_g)
    vc = vc.reshape(b_, -1, DIFF_HEADS, DIFF_V_DIM)
    k_all = jnp.concatenate([kc, k], axis=1)
    v_all = jnp.concatenate([vc, v], axis=1)
    y = even_merge(pool_in, diff_attention(q, k_all, v_all, lam), w_out, pool_w, pool_scale, sub_g, lam_init)
    yc = None
    if ctx_out:
        attn_c = diff_attention(heads_qk(qc, q_g), kc, vc, lam)
        yc = even_merge(pool_c, attn_c, w_out, pool_w, pool_scale, sub_g, lam_init)
    return y, yc


def spatial_gating(h, w_in, ln_g, ln_b, sg_w, sg_b, w_out):
    b_, n, _ = h.shape
    u, v = jnp.split(jax.nn.gelu(h @ w_in, approximate=False), 2, axis=-1)
    v = layer_norm(v, ln_g, ln_b)
    vc = v.reshape(b_, n // CHUNK, CHUNK, SG_GROUPS, SG_GROUP_DIM)
    mixed = jnp.einsum('gmn,bkngc->bkmgc', sg_w, vc) + jnp.swapaxes(sg_b, 0, 1)[:, :, None]
    return (u * mixed.reshape(b_, n, SG_WIDTH)) @ w_out


def sq_relu_ffn(h, w1, w2):
    return jnp.square(jax.nn.relu(h @ w1)) @ w2


def setup_inputs(seed: int = 0) -> dict:
    key = jax.random.key(seed)
    ks = iter(jax.random.split(key, 32))
    D = D_MODEL
    ne, no = (DEPTH + 1) // 2, DEPTH // 2

    def nrm(shape, s):
        return jax.random.normal(next(ks), shape, jnp.float32) * s

    return {
        'x': nrm((BATCH, SEQ, D), 1.0),
        'c': nrm((BATCH, D), 1.0),
        'ctx': nrm((BATCH, CTX_LEN, D), 1.0),
        'c_ctx': nrm((D,), 1.0),
        'ada_w': nrm((DEPTH, D, 6 * D), D ** -0.5),
        'ada_b': nrm((DEPTH, 6 * D), 0.02),
        'norm_mix_g': 1.0 + nrm((DEPTH, D), 0.02),
        'norm_ffn_g': 1.0 + nrm((DEPTH, D), 0.02),
        'ffn_w1': nrm((DEPTH, D, FFN_HIDDEN), D ** -0.5),
        'ffn_w2': nrm((DEPTH, FFN_HIDDEN, D), FFN_HIDDEN ** -0.5),
        'ev_w_in': nrm((ne, D, EVEN_IN_WIDTH), D ** -0.5),
        'ev_w_out': nrm((ne, POOL_WIDTH + DIFF_WIDTH, D), (POOL_WIDTH + DIFF_WIDTH) ** -0.5),
        'pool_w': nrm((ne, len(POOL_WINDOWS), POOL_GROUP, POOL_GROUP), POOL_GROUP ** -0.5),
        'pool_scale': 1.0 + nrm((ne, POOL_WIDTH), 0.02),
        'q_norm_g': 1.0 + nrm((ne, DIFF_HEAD_DIM), 0.02),
        'k_norm_g': 1.0 + nrm((ne, DIFF_HEAD_DIM), 0.02),
        'lam_q1': nrm((ne, DIFF_HEAD_DIM), 0.1),
        'lam_k1': nrm((ne, DIFF_HEAD_DIM), 0.1),
        'lam_q2': nrm((ne, DIFF_HEAD_DIM), 0.1),
        'lam_k2': nrm((ne, DIFF_HEAD_DIM), 0.1),
        'sub_norm_g': 1.0 + nrm((ne, DIFF_V_DIM), 0.02),
        'od_w_in': nrm((no, D, 2 * SG_WIDTH), D ** -0.5),
        'sg_ln_g': 1.0 + nrm((no, SG_WIDTH), 0.02),
        'sg_ln_b': nrm((no, SG_WIDTH), 0.02),
        'sg_w': nrm((no, SG_GROUPS, CHUNK, CHUNK), CHUNK ** -0.5),
        'sg_b': 1.0 + nrm((no, SG_GROUPS, CHUNK), 0.02),
        'od_w_out': nrm((no, SG_WIDTH, D), SG_WIDTH ** -0.5),
    }


def reference(x, c, ctx, c_ctx, ada_w, ada_b, norm_mix_g, norm_ffn_g, ffn_w1, ffn_w2,
              ev_w_in, ev_w_out, pool_w, pool_scale, q_norm_g, k_norm_g,
              lam_q1, lam_k1, lam_q2, lam_k2, sub_norm_g,
              od_w_in, sg_ln_g, sg_ln_b, sg_w, sg_b, od_w_out):
    n_lat = x.shape[1]
    cos, sin = axial_rope(n_lat)
    sc = jax.nn.silu(c)
    scc = jax.nn.silu(c_ctx)
    xc = ctx
    for l in range(DEPTH):
        ctx_out = any(j % 2 == 0 for j in range(l + 1, DEPTH))
        uses_ctx = (l % 2 == 0) or ctx_out
        sh1, sc1, g1, sh2, sc2, g2 = jnp.split((sc @ ada_w[l] + ada_b[l])[:, None, :], 6, axis=-1)
        h = modulate(rms_norm(x, norm_mix_g[l]), sh1, sc1)
        hc = None
        if uses_ctx:
            csh1, csc1, cg1, csh2, csc2, cg2 = jnp.split(scc @ ada_w[l] + ada_b[l], 6)
            hc = modulate(rms_norm(xc, norm_mix_g[l]), csh1, csc1)
        if l % 2 == 0:
            e = l // 2
            lam_init = 0.8 - 0.6 * math.exp(-0.3 * l)
            lam = (jnp.exp(jnp.sum(lam_q1[e].astype(jnp.float32) * lam_k1[e].astype(jnp.float32)))
                   - jnp.exp(jnp.sum(lam_q2[e].astype(jnp.float32) * lam_k2[e].astype(jnp.float32)))
                   + lam_init)
            y, yc = even_mixer(h, hc, ev_w_in[e], ev_w_out[e], pool_w[e], pool_scale[e],
                               q_norm_g[e], k_norm_g[e], lam, sub_norm_g[e], lam_init, cos, sin, ctx_out)
        else:
            o = l // 2
            y = spatial_gating(h, od_w_in[o], sg_ln_g[o], sg_ln_b[o], sg_w[o], sg_b[o], od_w_out[o])
            yc = None
            if ctx_out:
                yc = spatial_gating(hc, od_w_in[o], sg_ln_g[o], sg_ln_b[o], sg_w[o], sg_b[o], od_w_out[o])
        x = x + g1 * y
        x = x + g2 * sq_relu_ffn(modulate(rms_norm(x, norm_ffn_g[l]), sh2, sc2), ffn_w1[l], ffn_w2[l])
        if ctx_out:
            xc = xc + cg1 * yc
            xc = xc + cg2 * sq_relu_ffn(modulate(rms_norm(xc, norm_ffn_g[l]), csh2, csc2), ffn_w1[l], ffn_w2[l])
    return x
```

```cpp
#include <hip/hip_runtime.h>
#include <hip/hip_cooperative_groups.h>
#include <cstdio>
#include <cstdint>
namespace cg = cooperative_groups;
__device__ __forceinline__ int ltid() { int t = threadIdx.x; asm volatile("" : "+v"(t)); return t; }
namespace pg8 {
#define PG8_LAS __attribute__((address_space(3)))
typedef unsigned short bf16_t;
typedef short bf16x8 __attribute__((ext_vector_type(8)));
typedef float f32x4 __attribute__((ext_vector_type(4)));
typedef unsigned u32x4 __attribute__((ext_vector_type(4)));
constexpr int BM = 256, BK = 64, HALF = 128, HTB = HALF * BK * 2  , STAGE_BYTES = 8 * HTB, NXCD = 8, WGM = 8;

__host__ __device__ __forceinline__ int lds_byte(int r, int c) { const int st = (r >> 4) * 2 + (c >> 5), rr = r & 15, cc = c & 31, ob = rr * 64 + cc * 2; return st * 1024 + (ob ^ (((ob >> 9) & 1) << 5)); }
__host__ __device__ __forceinline__ void stage_rc(int b, int& R, int& C) { const int st = b / 1024, sb = b % 1024, swz = sb ^ (((sb >> 9) & 1) << 5); R = (st >> 1) * 16 + swz / 64; C = (st & 1) * 32 + (swz % 64) / 2; }
__host__ __device__ __forceinline__ int perm32(int rho) { const int n = rho >> 4, i = rho & 15; return 8 * (i >> 2) + 4 * n + (i & 3); }

struct Unit { int pm, pn; };
struct Gemm { const bf16_t* A; const bf16_t* Bt; int M, N, K; };

struct StaticOrder {
    int nM, nN, nwg, G, c;
    __host__ __device__ void init(int M, int N, int G_, int c_) { nM = M / BM; nN = N / BM; nwg = nM * nN; G = G_; c = c_; }
    __host__ __device__ bool next(int i, Unit& u) const {
        const long L = (long)i * G + c; if (L >= nwg) return false;
        int wgid = (int)L; { const int q = nwg / NXCD, r = nwg % NXCD, xcd = wgid % NXCD, off = wgid / NXCD; wgid = (xcd < r ? xcd * (q + 1) : r * (q + 1) + (xcd - r) * q) + off; }
        const int nig = WGM * nN, gid = wgid / nig, fm = gid * WGM, gsz = (nM - fm) < WGM ? (nM - fm) : WGM;
        u.pm = fm + ((wgid % nig) % gsz); u.pn = (wgid % nig) / gsz; return true;
    }
    __device__ __forceinline__ void a_ready(const Unit&) const {}
    __device__ __forceinline__ void done(const Unit&) const {}
};

__device__ __forceinline__ unsigned cvt_pk_bf16(float lo, float hi) { unsigned r; asm volatile("v_cvt_pk_bf16_f32 %0, %1, %2" : "=v"(r) : "v"(lo), "v"(hi)); return r; }
typedef float f32x2 __attribute__((ext_vector_type(2)));
__device__ __forceinline__ f32x2 gelu_pk(f32x2 v) {
    const f32x2 av = __builtin_elementwise_abs(v), d = av * 0.2316418882f + 1.0f;
    f32x2 t; t.x = __builtin_amdgcn_rcpf(d.x); t.y = __builtin_amdgcn_rcpf(d.y);
    f32x2 q = t * 0.5307027145f + (-0.7265760135f); q = q * t + 0.7107068705f; q = q * t + (-0.142248368f); q = q * t + 0.127414796f; q = q * t;
    const f32x2 s = (v * v) * (-0.72134752044f);
    f32x2 e; e.x = __builtin_amdgcn_exp2f(s.x); e.y = __builtin_amdgcn_exp2f(s.y);
    const f32x2 m = v * (q * e), r = v - m;
    f32x2 o; o.x = v.x < 0.f ? m.x : r.x; o.y = v.y < 0.f ? m.y : r.y; return o;
}


struct EpiAct {
    static constexpr bool PERM = true, AFTER_DRAIN = false;
    bf16_t* O; int ldc; int act;
    __device__ __forceinline__ void operator()(const f32x4 (&acc)[2][2][4][2], const Unit& u, int wr, int wc, int fr, int fq) const {
        const int row0 = u.pm * BM + wr * 64 + fr; const int col0 = u.pn * BM + wc * 32 + 8 * fq;
#pragma unroll
        for (int ai = 0; ai < 2; ++ai)
#pragma unroll
            for (int m = 0; m < 4; ++m) { bf16_t* rowp = O + (size_t)(row0 + ai * HALF + m * 16) * ldc + col0;
#pragma unroll
                for (int bj = 0; bj < 2; ++bj) { f32x4 v0 = acc[ai][bj][m][0], v1 = acc[ai][bj][m][1];
                    if (act == 1) { f32x2 a = gelu_pk((f32x2){v0[0], v0[1]}), b = gelu_pk((f32x2){v0[2], v0[3]}), c = gelu_pk((f32x2){v1[0], v1[1]}), d = gelu_pk((f32x2){v1[2], v1[3]});
                        v0 = (f32x4){a.x, a.y, b.x, b.y}; v1 = (f32x4){c.x, c.y, d.x, d.y}; }
                    else if (act == 2) {
#pragma unroll
                        for (int e = 0; e < 4; ++e) { const float a = fmaxf(v0[e], 0.f), b = fmaxf(v1[e], 0.f); v0[e] = a * a; v1[e] = b * b; } }
                    u32x4 w; w.x = cvt_pk_bf16(v0[0], v0[1]); w.y = cvt_pk_bf16(v0[2], v0[3]); w.z = cvt_pk_bf16(v1[0], v1[1]); w.w = cvt_pk_bf16(v1[2], v1[3]);
                    *(u32x4*)(rowp + bj * HALF) = w; } }
    }
};
struct EpiRoute {
    static constexpr bool PERM = true, AFTER_DRAIN = false;
    bf16_t *pool, *q, *k, *v;
    __device__ __forceinline__ void operator()(const f32x4 (&acc)[2][2][4][2], const Unit& u, int wr, int wc, int fr, int fq) const {
        const int pm = u.pm, pn = u.pn; bf16_t* base; int ld, colt; long rowbase;
        if (pm < 64) { const int b = pm >> 4; const long lat = (long)pm * 256, kvrow = (long)b * 4352 + 256 + (pm & 15) * 256;
            if (pn == 0)     { base = pool; ld = 256; colt = 0;              rowbase = lat; }
            else if (pn < 4) { base = q;    ld = 768; colt = (pn - 1) * 256; rowbase = lat; }
            else if (pn < 7) { base = k;    ld = 768; colt = (pn - 4) * 256; rowbase = kvrow; }
            else             { base = v;    ld = 768; colt = (pn - 7) * 256; rowbase = kvrow; }
        } else { const int b = pm - 64; rowbase = (long)b * 4352; ld = 768;
            if (pn < 7) { base = k; colt = (pn - 4) * 256; } else { base = v; colt = (pn - 7) * 256; } }
        const long row0 = rowbase + wr * 64 + fr; const int col0 = colt + wc * 32 + 8 * fq;
#pragma unroll
        for (int ai = 0; ai < 2; ++ai)
#pragma unroll
            for (int m = 0; m < 4; ++m) { bf16_t* rowp = base + (size_t)(row0 + ai * HALF + m * 16) * ld + col0;
#pragma unroll
                for (int bj = 0; bj < 2; ++bj) { const f32x4 v0 = acc[ai][bj][m][0], v1 = acc[ai][bj][m][1];
                    u32x4 w; w.x = cvt_pk_bf16(v0[0], v0[1]); w.y = cvt_pk_bf16(v0[2], v0[3]); w.z = cvt_pk_bf16(v1[0], v1[1]); w.w = cvt_pk_bf16(v1[2], v1[3]);
                    *(u32x4*)(rowp + bj * HALF) = w; } }
    }
};
struct EpiRes {
    static constexpr bool PERM = false, AFTER_DRAIN = false;
    const float* base; float* out; const float* gate;
    __device__ __forceinline__ void operator()(const f32x4 (&acc)[2][2][4][2], const Unit& u, int wr, int wc, int fr, int fq) const {
        const int col0 = u.pn * BM + wc * 32 + 4 * fq; const float* gp = gate + (size_t)(u.pm >> 4) * 6144 + col0;
        f32x4 gv[2][2];
#pragma unroll
        for (int bj = 0; bj < 2; ++bj)
#pragma unroll
            for (int n = 0; n < 2; ++n) gv[bj][n] = *(const f32x4*)(gp + bj * HALF + n * 16);
#pragma unroll
        for (int ai = 0; ai < 2; ++ai)
#pragma unroll
            for (int m = 0; m < 4; ++m) { const size_t off = (size_t)(u.pm * BM + ai * HALF + wr * 64 + m * 16 + fr) * 1024 + col0;
#pragma unroll
                for (int bj = 0; bj < 2; ++bj)
#pragma unroll
                    for (int n = 0; n < 2; ++n) { const f32x4 bs = *(const f32x4*)(base + off + bj * HALF + n * 16);
                        *(f32x4*)(out + off + bj * HALF + n * 16) = bs + gv[bj][n] * acc[ai][bj][m][n]; }
                if (m & 1) asm volatile("" ::: "memory"); }
    }
};
struct OrderQKV {
    StaticOrder so;
    __host__ __device__ void init(int G_, int c_) { so.init(16384, 2560, G_, c_); }
    __host__ __device__ bool next(int i, Unit& u) const {
        const long L = (long)i * so.G + so.c; if (L < so.nwg) return so.next(i, u);
        const int e = (int)(L - so.nwg); if (e >= 24) return false; u.pm = 64 + e / 6; u.pn = 4 + e % 6; return true; }
    __device__ __forceinline__ void a_ready(const Unit&) const {}
    __device__ __forceinline__ void done(const Unit&) const {}
};

template <class Epi, class Sched, bool ALIGN_EPI = false, bool SP2 = false>
__device__ __forceinline__ void gemm_phase(PG8_LAS unsigned char* lds, const Gemm g, const Sched& S, const Epi& E) {
    const int tid = ltid(), wid = __builtin_amdgcn_readfirstlane(tid >> 6), lane = tid & 63, wr = wid >> 2, wc = wid & 3, fr = lane & 15, fq = lane >> 4;
    const int K = g.K, nt = K / BK;
    unsigned voffA[2], voffB[2];
#pragma unroll
    for (int i = 0; i < 2; ++i) { int R, C; stage_rc(tid * 16 + i * 8192, R, C); const int Rb = Epi::PERM ? ((R & ~31) + perm32(R & 31)) : R;
        voffA[i] = (unsigned)(R * K + C) * 2u; voffB[i] = (unsigned)(Rb * K + C) * 2u; }
    const size_t kstep = (size_t)(BK * 2);
    const size_t hstep = (size_t)HALF * K * 2;
    const size_t tstep = 2 * hstep;
    const unsigned ldsw = (unsigned)wid * 1024u;
    const int aoff = lds_byte(wr * 64 + fr, fq * 8), boff = lds_byte(wc * 32 + fr, fq * 8);
#define PG8_SA(b, h) (((b) * 2 + (h)) * HTB)
#define PG8_SB(b, h) ((4 + (b) * 2 + (h)) * HTB)
#define PG8_STAGE(bufoff, gbase, voff) do { _Pragma("unroll") for (int _i = 0; _i < 2; ++_i) \
        __builtin_amdgcn_global_load_lds((const unsigned*)((const char*)(gbase) + (voff)[_i]), (PG8_LAS unsigned*)(lds + (bufoff) + ldsw + _i * 8192), 16, 0, 0); } while (0)
#define PG8_LDA(dst, b, h) do { _Pragma("unroll") for (int m = 0; m < 4; ++m) _Pragma("unroll") for (int k = 0; k < 2; ++k) dst[m][k] = *(const PG8_LAS bf16x8*)(lds + PG8_SA(b, h) + aoff + m * 2048 + k * 1024); } while (0)
#define PG8_LDB(dst, b, h) do { _Pragma("unroll") for (int n = 0; n < 2; ++n) _Pragma("unroll") for (int k = 0; k < 2; ++k) dst[n][k] = *(const PG8_LAS bf16x8*)(lds + PG8_SB(b, h) + boff + n * 2048 + k * 1024); } while (0)
#define PG8_MMA(ai, bj, At, Bt) do { __builtin_amdgcn_s_setprio(1); _Pragma("unroll") for (int m = 0; m < 4; ++m) _Pragma("unroll") for (int n = 0; n < 2; ++n) _Pragma("unroll") for (int k = 0; k < 2; ++k) \
        acc[ai][bj][m][n] = __builtin_amdgcn_mfma_f32_16x16x32_bf16(Bt[n][k], At[m][k], acc[ai][bj][m][n], 0, 0, 0); __builtin_amdgcn_s_setprio(0); } while (0)
#define PG8_WAIT_V(n) asm volatile("s_waitcnt vmcnt(" #n ")" ::: "memory")
#define PG8_WAIT_L(n) asm volatile("s_waitcnt lgkmcnt(" #n ")" ::: "memory")
#define PG8_BAR __builtin_amdgcn_s_barrier()
#define PG8_SCHED __builtin_amdgcn_sched_barrier(0)
    Unit cur, nxt; int ui = 0;
    if (!S.next(0, cur)) return;
    f32x4 acc[2][2][4][2];
#pragma unroll
    for (int a = 0; a < 2; ++a)
#pragma unroll
        for (int b = 0; b < 2; ++b)
#pragma unroll
            for (int m = 0; m < 4; ++m)
#pragma unroll
                for (int n = 0; n < 2; ++n) acc[a][b][m][n] = (f32x4){0.f, 0.f, 0.f, 0.f};
    bf16x8 At[4][2], B0[2][2], B1[2][2];
    const char* cA = (const char*)g.A + (size_t)cur.pm * tstep; const char* cB = (const char*)g.Bt + (size_t)cur.pn * tstep;
    S.a_ready(cur);
    if constexpr (SP2) {
        PG8_STAGE(PG8_SB(0, 0), cB, voffB); PG8_STAGE(PG8_SB(0, 1), cB + hstep, voffB); PG8_STAGE(PG8_SA(0, 0), cA, voffA); PG8_STAGE(PG8_SA(0, 1), cA + hstep, voffA);
        if (wr == 1) PG8_BAR;
        PG8_WAIT_V(2); PG8_BAR;
        PG8_STAGE(PG8_SB(1, 0), cB + kstep, voffB); PG8_STAGE(PG8_SA(1, 0), cA + kstep, voffA); PG8_STAGE(PG8_SB(1, 1), cB + hstep + kstep, voffB);
        PG8_WAIT_V(6); PG8_BAR;
    } else {
        PG8_STAGE(PG8_SB(0, 0), cB, voffB); PG8_STAGE(PG8_SA(0, 0), cA, voffA); PG8_STAGE(PG8_SB(0, 1), cB + hstep, voffB); PG8_STAGE(PG8_SA(0, 1), cA + hstep, voffA);
        if (wr == 1) PG8_BAR;
        PG8_WAIT_V(4); PG8_BAR;
        PG8_STAGE(PG8_SB(1, 0), cB + kstep, voffB); PG8_STAGE(PG8_SA(1, 0), cA + kstep, voffA); PG8_STAGE(PG8_SB(1, 1), cB + hstep + kstep, voffB);
        PG8_WAIT_V(6); PG8_BAR;
    }
    for (;;) {
        const bool has_next = S.next(ui + 1, nxt);
        const char* nA = has_next ? (const char*)g.A + (size_t)nxt.pm * tstep : cA; const char* nB = has_next ? (const char*)g.Bt + (size_t)nxt.pn * tstep : cB;
        for (int t = 0; t < nt; t += 2) {
            const bool last = (t == nt - 2);
            const char* a1 = cA + (size_t)(t + 1) * kstep;
            const char* a2 = last ? nA : cA + (size_t)(t + 2) * kstep; const char* b2 = last ? nB : cB + (size_t)(t + 2) * kstep;
            const char* a3 = a2 + kstep; const char* b3 = b2 + kstep;
            if (last && has_next) S.a_ready(nxt);
            if constexpr (SP2) {
            PG8_LDB(B0, 0, 0); PG8_LDB(B1, 0, 1); PG8_SCHED; PG8_LDA(At, 0, 0); PG8_STAGE(PG8_SA(1, 1), a1 + hstep, voffA);
            PG8_WAIT_V(8); PG8_WAIT_L(0); PG8_BAR; PG8_MMA(0, 0, At, B0); PG8_MMA(0, 1, At, B1); PG8_BAR; PG8_SCHED;
            PG8_LDA(At, 0, 1); PG8_STAGE(PG8_SB(0, 0), b2, voffB); PG8_STAGE(PG8_SB(0, 1), b2 + hstep, voffB); PG8_STAGE(PG8_SA(0, 0), a2, voffA);
            PG8_WAIT_V(8); PG8_WAIT_L(0); PG8_BAR; PG8_MMA(1, 0, At, B0); PG8_MMA(1, 1, At, B1); PG8_BAR; PG8_SCHED;
            PG8_LDB(B0, 1, 0); PG8_LDB(B1, 1, 1); PG8_SCHED; PG8_LDA(At, 1, 0); PG8_STAGE(PG8_SA(0, 1), a2 + hstep, voffA);
            PG8_WAIT_V(8); PG8_WAIT_L(0); PG8_BAR; PG8_MMA(0, 0, At, B0); PG8_MMA(0, 1, At, B1); PG8_BAR; PG8_SCHED;
            PG8_LDA(At, 1, 1); PG8_STAGE(PG8_SB(1, 0), b3, voffB); PG8_STAGE(PG8_SB(1, 1), b3 + hstep, voffB); PG8_STAGE(PG8_SA(1, 0), a3, voffA);
            PG8_WAIT_V(8); PG8_WAIT_L(0); PG8_BAR; PG8_MMA(1, 0, At, B0); PG8_MMA(1, 1, At, B1); PG8_BAR; PG8_SCHED;
            } else {
            PG8_LDB(B0, 0, 0); PG8_SCHED; PG8_LDA(At, 0, 0); PG8_STAGE(PG8_SA(1, 1), a1 + hstep, voffA);
            PG8_WAIT_L(8); PG8_BAR; PG8_WAIT_L(0); PG8_MMA(0, 0, At, B0); PG8_BAR; PG8_SCHED;
            PG8_LDB(B1, 0, 1); PG8_STAGE(PG8_SB(0, 0), b2, voffB);
            PG8_BAR; PG8_WAIT_L(0); PG8_MMA(0, 1, At, B1); PG8_BAR;
            PG8_LDA(At, 0, 1); PG8_STAGE(PG8_SA(0, 0), a2, voffA);
            PG8_BAR; PG8_WAIT_L(0); PG8_MMA(1, 0, At, B0); PG8_BAR; PG8_SCHED;
            PG8_STAGE(PG8_SB(0, 1), b2 + hstep, voffB);
            PG8_WAIT_V(6); PG8_BAR; PG8_MMA(1, 1, At, B1); PG8_BAR;
            PG8_LDB(B0, 1, 0); PG8_SCHED; PG8_LDA(At, 1, 0); PG8_STAGE(PG8_SA(0, 1), a2 + hstep, voffA);
            PG8_WAIT_L(8); PG8_BAR; PG8_WAIT_L(0); PG8_MMA(0, 0, At, B0); PG8_BAR; PG8_SCHED;
            PG8_LDB(B1, 1, 1); PG8_STAGE(PG8_SB(1, 0), b3, voffB);
            PG8_BAR; PG8_WAIT_L(0); PG8_MMA(0, 1, At, B1); PG8_BAR;
            PG8_LDA(At, 1, 1); PG8_STAGE(PG8_SA(1, 0), a3, voffA);
            PG8_BAR; PG8_WAIT_L(0); PG8_MMA(1, 0, At, B0); PG8_BAR; PG8_SCHED;
            PG8_STAGE(PG8_SB(1, 1), b3 + hstep, voffB);
            PG8_WAIT_V(6); PG8_BAR; PG8_MMA(1, 1, At, B1); PG8_BAR;
            }
        }
        if constexpr (ALIGN_EPI) { if (wr == 0) PG8_BAR; }
        if constexpr (!Epi::AFTER_DRAIN) { E(acc, cur, wr, wc, fr, fq); S.done(cur); }
        if (!has_next) break;
#pragma unroll
        for (int a = 0; a < 2; ++a)
#pragma unroll
            for (int b = 0; b < 2; ++b)
#pragma unroll
                for (int m = 0; m < 4; ++m)
#pragma unroll
                    for (int n = 0; n < 2; ++n) acc[a][b][m][n] = (f32x4){0.f, 0.f, 0.f, 0.f};
        cur = nxt; cA = nA; cB = nB; ++ui;
        if constexpr (ALIGN_EPI) { if (wr == 1) PG8_BAR; }
    }
    PG8_WAIT_V(0);
    if constexpr (!ALIGN_EPI) { if (wr == 0) PG8_BAR; }
    PG8_BAR;
    if constexpr (Epi::AFTER_DRAIN) { E.fused(acc, cur, wr, wc, fr, fq, lds, wid, lane); S.done(cur); }
#undef PG8_SA
#undef PG8_SB
#undef PG8_STAGE
#undef PG8_LDA
#undef PG8_LDB
#undef PG8_MMA
#undef PG8_WAIT_V
#undef PG8_WAIT_L
#undef PG8_BAR
#undef PG8_SCHED
}
}

namespace att {
using bf16x8 = __attribute__((ext_vector_type(8))) short;
using s16x4  = __attribute__((ext_vector_type(4))) short;
using f32x16 = __attribute__((ext_vector_type(16))) float;
using u32x4  = __attribute__((ext_vector_type(4))) unsigned;
typedef unsigned short bf16;
constexpr int NW = 8, QBLK = 32, KVBLK = 64, LDQ = 768, LDK = 768, LDY = 1024, SEQK = 4352;
constexpr float SCALE = 0.125f, THR = 8.f;
constexpr int SDEPTH = 2;
constexpr size_t SHM_V = KVBLK * 128 * 2, SHM_K = KVBLK * 128 * 2, SHM_ATTN = 2 * SHM_V + 2 * SHM_K + NW * 64 * 4;
#define KSWZ(row, colB) ((row) * 256 + ((colB) ^ (((row) & 7) << 4)))
#define SBAR() __builtin_amdgcn_sched_barrier(0)
__device__ __forceinline__ int crow(int r, int hi) { return (r & 3) + 8 * (r >> 2) + 4 * hi; }
__device__ __forceinline__ unsigned cvtpk(float lo, float hi) { unsigned r; asm volatile("v_cvt_pk_bf16_f32 %0, %1, %2" : "=v"(r) : "v"(lo), "v"(hi)); return r; }
__device__ __forceinline__ unsigned short f2bf(float f) { unsigned u = __builtin_bit_cast(unsigned, f); return (unsigned short)((u + 0x7fffu + ((u >> 16) & 1u)) >> 16); }

__device__ __forceinline__ void partialSM(f32x16& p0, f32x16& p1, float& m_reg, float& mn, float& alpha) {
  constexpr float C = SCALE * 1.4426950408889634f;
  float pmax = p0[0];
#pragma unroll
  for (int r = 1; r < 16; ++r) pmax = fmaxf(pmax, p0[r]);
#pragma unroll
  for (int r = 0; r < 16; ++r) pmax = fmaxf(pmax, p1[r]);
  { auto rr = __builtin_amdgcn_permlane32_swap(__float_as_uint(pmax), __float_as_uint(pmax), false, false);
    pmax = fmaxf(__uint_as_float(rr[0]), __uint_as_float(rr[1])); }
  if (__builtin_expect(__all(pmax - m_reg <= THR / SCALE), 1)) { mn = m_reg; alpha = 1.f; }
  else { mn = fmaxf(m_reg, pmax); alpha = __builtin_amdgcn_exp2f((m_reg - mn) * C); m_reg = mn; }
  float mnC = -mn * C;
#pragma unroll
  for (int r = 0; r < 16; ++r) p0[r] = fmaf(p0[r], C, mnC);
#pragma unroll
  for (int r = 0; r < 16; ++r) p1[r] = fmaf(p1[r], C, mnC);
#pragma unroll
  for (int r = 0; r < 16; ++r) p0[r] = __builtin_amdgcn_exp2f(p0[r]);
}
__device__ __forceinline__ void finishSM(f32x16& p0, f32x16& p1, float alpha, float& l_reg, bf16x8& pa0, bf16x8& pa1, bf16x8& pa2, bf16x8& pa3) {
#pragma unroll
  for (int r = 0; r < 16; ++r) p1[r] = __builtin_amdgcn_exp2f(p1[r]);
  float ps = 0;
#pragma unroll
  for (int r = 0; r < 16; ++r) ps += p0[r];
#pragma unroll
  for (int r = 0; r < 16; ++r) ps += p1[r];
  { auto rr = __builtin_amdgcn_permlane32_swap(__float_as_uint(ps), __float_as_uint(ps), false, false);
    ps = __uint_as_float(rr[0]) + __uint_as_float(rr[1]); }
  l_reg = l_reg * alpha + ps;
#define PK4(P, BASE, OUT) do { unsigned a0 = cvtpk(P[BASE + 0], P[BASE + 1]), a1 = cvtpk(P[BASE + 2], P[BASE + 3]);   \
    unsigned b0 = cvtpk(P[BASE + 4], P[BASE + 5]), b1 = cvtpk(P[BASE + 6], P[BASE + 7]);                              \
    auto r0 = __builtin_amdgcn_permlane32_swap(a0, b0, false, false); auto r1 = __builtin_amdgcn_permlane32_swap(a1, b1, false, false); \
    u32x4 w = {r0[0], r1[0], r0[1], r1[1]}; OUT = *reinterpret_cast<bf16x8*>(&w); } while (0)
  PK4(p0, 0, pa0); PK4(p0, 8, pa1); PK4(p1, 0, pa2); PK4(p1, 8, pa3);
#undef PK4
}
__device__ __forceinline__ void qkt(f32x16& p0, f32x16& p1, const bf16* Ks, const bf16x8* qr, int r32, int hi, int comp) {
  p0 = f32x16{}; p1 = f32x16{};
#pragma unroll
  for (int d0 = 0; d0 < 4; ++d0) { int cb = (comp * 64 + d0 * 16 + hi * 8) * 2;
    bf16x8 b0 = *reinterpret_cast<const bf16x8*>((const char*)Ks + KSWZ(r32, cb));
    bf16x8 b1 = *reinterpret_cast<const bf16x8*>((const char*)Ks + KSWZ(32 + r32, cb));
    p0 = __builtin_amdgcn_mfma_f32_32x32x16_bf16(b0, qr[d0], p0, 0, 0, 0);
    p1 = __builtin_amdgcn_mfma_f32_32x32x16_bf16(b1, qr[d0], p1, 0, 0, 0); }
}
__device__ __forceinline__ int v_st(int k, int c) { const int kk = (k & ~0xC) | ((k & 4) << 1) | ((k & 8) >> 1); return ((kk >> 3) * 4 + (c >> 5)) * 512 + ((kk & 7) * 32 + (c & 31)) * 2; }
__device__ __forceinline__ int v_rd_base(int lane) { return ((lane & 3) << 3) | (((lane >> 2) & 3) << 6) | (((lane >> 4) & 1) << 5) | (((lane >> 5) & 1) << 8); }
constexpr int v_rd_off(int d0, int ks, int half) { return d0 * 512 + ks * 4096 + half * 2048; }
template <int OFF> __device__ __forceinline__ s16x4 tr_read(int vb) {
  s16x4 r; asm volatile("ds_read_b64_tr_b16 %0, %1 offset:%2" : "=&v"(r) : "v"(vb), "i"(OFF) : "memory"); return r;
}
template <int D0> __device__ __forceinline__ void pv_one(f32x16& od, int vb, bf16x8 pa0, bf16x8 pa1, bf16x8 pa2, bf16x8 pa3) {
  const s16x4 l0 = tr_read<v_rd_off(D0, 0, 0)>(vb), h0 = tr_read<v_rd_off(D0, 0, 1)>(vb), l1 = tr_read<v_rd_off(D0, 1, 0)>(vb), h1 = tr_read<v_rd_off(D0, 1, 1)>(vb);
  const s16x4 l2 = tr_read<v_rd_off(D0, 2, 0)>(vb), h2 = tr_read<v_rd_off(D0, 2, 1)>(vb), l3 = tr_read<v_rd_off(D0, 3, 0)>(vb), h3 = tr_read<v_rd_off(D0, 3, 1)>(vb);
  asm volatile("s_waitcnt lgkmcnt(0)" ::: "memory"); SBAR();
#define PK(L, H) (bf16x8){L[0], L[1], L[2], L[3], H[0], H[1], H[2], H[3]}
  od = __builtin_amdgcn_mfma_f32_32x32x16_bf16(pa0, PK(l0, h0), od, 0, 0, 0);
  od = __builtin_amdgcn_mfma_f32_32x32x16_bf16(pa1, PK(l1, h1), od, 0, 0, 0);
  od = __builtin_amdgcn_mfma_f32_32x32x16_bf16(pa2, PK(l2, h2), od, 0, 0, 0);
  od = __builtin_amdgcn_mfma_f32_32x32x16_bf16(pa3, PK(l3, h3), od, 0, 0, 0);
#undef PK
}
__device__ __forceinline__ void pv_d0(f32x16* o, int vb, bf16x8 pa0, bf16x8 pa1, bf16x8 pa2, bf16x8 pa3) {
  pv_one<0>(o[0], vb, pa0, pa1, pa2, pa3); pv_one<1>(o[1], vb, pa0, pa1, pa2, pa3); pv_one<2>(o[2], vb, pa0, pa1, pa2, pa3); pv_one<3>(o[3], vb, pa0, pa1, pa2, pa3);
}

__device__ __forceinline__ void attn_unit(const bf16* __restrict__ Qb, const bf16* __restrict__ Kh, const bf16* __restrict__ Vh, bf16* __restrict__ Yb,
                                          const float* __restrict__ subg, float lam, char* lds) {
  const int tid = ltid(), wid = tid >> 6, lane = tid & 63, r32 = lane & 31, hi = lane >> 5;
  const int comp = wid >> 2, wq = wid & 3;
  bf16* V_lds = (bf16*)lds; bf16* K_lds = (bf16*)(lds + 2 * SHM_V);
  float* ws = (float*)(lds + 2 * SHM_V + 2 * SHM_K) + wid * 64; float* li_l = ws; float* al_l = ws + 32;
  float m_reg = -1e30f, l_reg = 0; f32x16 o[4] = {}; bf16x8 qr[4];
  const bf16* Qw = Qb + (long)(wq * QBLK + r32) * LDQ + comp * 64 + hi * 8;
#pragma unroll
  for (int d0 = 0; d0 < 4; ++d0) qr[d0] = *reinterpret_cast<const bf16x8*>(Qw + d0 * 16);
  const int sr = tid >> 4, sc = (tid & 15) * 8, vst0 = v_st(sr, sc), vst1 = v_st(32 + sr, sc);
  const int vb0 = (int)(uintptr_t)V_lds + v_rd_base(lane);
  struct { bf16x8 vs0, vs1, ks0, ks1; } sr_[SDEPTH];
#define SLOAD(i, k0) do { sr_[i].vs0 = *reinterpret_cast<const bf16x8*>(&Vh[(long)((k0) + sr) * LDK + sc]); sr_[i].vs1 = *reinterpret_cast<const bf16x8*>(&Vh[(long)((k0) + 32 + sr) * LDK + sc]); \
    sr_[i].ks0 = *reinterpret_cast<const bf16x8*>(&Kh[(long)((k0) + sr) * LDK + sc]); sr_[i].ks1 = *reinterpret_cast<const bf16x8*>(&Kh[(long)((k0) + 32 + sr) * LDK + sc]); } while (0)
#define SWRITE(b, i) do { *(bf16x8*)((char*)V_lds + (b) * SHM_V + vst0) = sr_[i].vs0;          \
    *(bf16x8*)((char*)V_lds + (b) * SHM_V + vst1) = sr_[i].vs1; int kc = sc * 2;               \
    *(bf16x8*)((char*)K_lds + (b) * SHM_K + KSWZ(sr, kc)) = sr_[i].ks0;                       \
    *(bf16x8*)((char*)K_lds + (b) * SHM_K + KSWZ(32 + sr, kc)) = sr_[i].ks1; } while (0)
#define SWAIT() do { asm volatile("s_waitcnt vmcnt(4)" ::: "memory"); } while (0)
#define RESC(a) do { if (__any((a) < 1.f)) { if (hi == 0) al_l[r32] = (a); asm volatile("s_waitcnt lgkmcnt(0)" ::: "memory"); \
    _Pragma("unroll") for (int d = 0; d < 4; ++d) _Pragma("unroll") for (int r = 0; r < 16; ++r) o[d][r] *= al_l[crow(r, hi)]; } } while (0)
  f32x16 pA0, pA1, pB0, pB1; float mnA, mnB, alA, alB; bf16x8 pa0, pa1, pa2, pa3; constexpr int NT = SEQK / KVBLK;
  constexpr int SE = 0, SO = SDEPTH - 1;
  SLOAD(SE, 0); asm volatile("s_waitcnt vmcnt(0)" ::: "memory"); SWRITE(0, SE); __syncthreads();
  qkt(pA0, pA1, K_lds, qr, r32, hi, comp); partialSM(pA0, pA1, m_reg, mnA, alA);
  SLOAD(SO, KVBLK); if (2 < NT) SLOAD(SE, 2 * KVBLK);
  SWAIT(); SWRITE(1, SO); __syncthreads();
  for (int j = 1; j + 1 < NT; j += 2) {
    SBAR(); qkt(pB0, pB1, (bf16*)((char*)K_lds + SHM_K), qr, r32, hi, comp);
    finishSM(pA0, pA1, alA, l_reg, pa0, pa1, pa2, pa3); SBAR();
    SLOAD(SO, (j + SDEPTH) * KVBLK); SBAR();
    pv_d0(o, vb0, pa0, pa1, pa2, pa3); partialSM(pB0, pB1, m_reg, mnB, alB);
    __syncthreads(); SWAIT(); SWRITE(0, SE);
    RESC(alB); __syncthreads();
    SBAR(); qkt(pA0, pA1, K_lds, qr, r32, hi, comp);
    finishSM(pB0, pB1, alB, l_reg, pa0, pa1, pa2, pa3); SBAR();
    if (j + 3 < NT) SLOAD(SE, (j + 1 + SDEPTH) * KVBLK); SBAR();
    pv_d0(o, vb0 + (int)SHM_V, pa0, pa1, pa2, pa3); partialSM(pA0, pA1, m_reg, mnA, alA);
    __syncthreads(); SWAIT(); SWRITE(1, SO);
    RESC(alA); __syncthreads();
  }
  SBAR(); qkt(pB0, pB1, (bf16*)((char*)K_lds + SHM_K), qr, r32, hi, comp);
  finishSM(pA0, pA1, alA, l_reg, pa0, pa1, pa2, pa3); SBAR();
  pv_d0(o, vb0, pa0, pa1, pa2, pa3); partialSM(pB0, pB1, m_reg, mnB, alB);
  __syncthreads(); RESC(alB);
  finishSM(pB0, pB1, alB, l_reg, pa0, pa1, pa2, pa3); SBAR();
  pv_d0(o, vb0 + (int)SHM_V, pa0, pa1, pa2, pa3);
  if (hi == 0) li_l[r32] = l_reg; asm volatile("s_waitcnt lgkmcnt(0)" ::: "memory");
  float rli[16];
#pragma unroll
  for (int r = 0; r < 16; ++r) rli[r] = __builtin_amdgcn_rcpf(li_l[crow(r, hi)]);
  __syncthreads();
  float* X = (float*)lds + wq * 4096;
  if (comp == 1) {
#pragma unroll
    for (int d0 = 0; d0 < 4; ++d0)
#pragma unroll
      for (int r = 0; r < 16; ++r) X[(d0 * 16 + r) * 64 + lane] = o[d0][r] * rli[r] * lam;
  }
  __syncthreads();
  if (comp == 0) {
    float ss[16];
#pragma unroll
    for (int r = 0; r < 16; ++r) ss[r] = 0.f;
#pragma unroll
    for (int d0 = 0; d0 < 4; ++d0)
#pragma unroll
      for (int r = 0; r < 16; ++r) { const float d = o[d0][r] * rli[r] - X[(d0 * 16 + r) * 64 + lane]; o[d0][r] = d; ss[r] += d * d; }
#pragma unroll
    for (int r = 0; r < 16; ++r) {
#pragma unroll
      for (int off = 1; off < 32; off <<= 1) ss[r] += __shfl_xor(ss[r], off);
    }
    float g4[4];
#pragma unroll
    for (int d0 = 0; d0 < 4; ++d0) g4[d0] = subg[d0 * 32 + r32] * 0.8f;
#pragma unroll
    for (int r = 0; r < 16; ++r) { const float rs = rsqrtf(ss[r] * (1.f / 128.f) + 1e-6f); bf16* yrow = Yb + (long)(wq * QBLK + crow(r, hi)) * LDY;
#pragma unroll
      for (int d0 = 0; d0 < 4; ++d0) yrow[d0 * 32 + r32] = f2bf(o[d0][r] * rs * g4[d0]); }
  }
  __syncthreads();
#undef SLOAD
#undef SWRITE
#undef SWAIT
#undef RESC
}
#undef SBAR
}


#ifndef MK_DEBUG
#define MK_DEBUG 0
#endif
#ifndef MK_SIMPLE6
#define MK_SIMPLE6 0
#endif
#ifndef NPH_RUN
#define NPH_RUN 16
#endif
#ifndef PHMASK
#define PHMASK 0xFFFF
#endif
#define PHM(k) ((PHMASK >> (k)) & 1)
#ifndef MK_MULTI
#define MK_MULTI 0
#endif
#define LAS __attribute__((address_space(3)))
#define GAS __attribute__((address_space(1)))
typedef unsigned short bf16;
typedef unsigned v4u __attribute__((ext_vector_type(4)));
typedef unsigned v2u __attribute__((ext_vector_type(2)));
typedef float f32x4 __attribute__((ext_vector_type(4)));
typedef short bf16x8 __attribute__((ext_vector_type(8)));
typedef float f32x16 __attribute__((ext_vector_type(16)));
#define LDS_WAIT() asm volatile("s_waitcnt lgkmcnt(0)" ::: "memory")
constexpr int NWAVES = 8, NTHR = 512, NPH = 16;
constexpr int SEQ = 4096, DM = 1024, MTOK = 16384, TKV = 4352, FF = 4096, MODW = 6144;
constexpr size_t MiB = 1u << 20;
constexpr size_t WS_MOD = 1 * MiB, WS_WIN = 2 * MiB, WS_WOUT = 7 * MiB, WS_W1 = 9 * MiB, WS_W2 = 25 * MiB, WS_ODIN = 41 * MiB, WS_ODOUT = 49 * MiB;
constexpr size_t WS_XN = 56 * MiB;
constexpr size_t WS_Q = 92 * MiB, WS_K = 116 * MiB, WS_V = 142 * MiB, WS_POOL = 168 * MiB, WS_Y = 176 * MiB;
constexpr size_t WS_HB = 92 * MiB;
constexpr size_t WS_U = 92 * MiB, WS_VT = 156 * MiB;
constexpr size_t WS_END = 220 * MiB;
constexpr int LDS_BYTES = 147456;

__device__ __forceinline__ unsigned f2bf(float f) { unsigned u = __builtin_bit_cast(unsigned, f); return (u + 0x7fffu + ((u >> 16) & 1u)) >> 16; }
__device__ __forceinline__ unsigned pk2(float lo, float hi) { return f2bf(lo) | (f2bf(hi) << 16); }
__device__ __forceinline__ float bflo(unsigned w) { return __builtin_bit_cast(float, w << 16); }
__device__ __forceinline__ float bfhi(unsigned w) { return __builtin_bit_cast(float, w & 0xffff0000u); }
__device__ __forceinline__ float wave_sum(float v) {
#pragma unroll
    for (int o = 1; o < 64; o <<= 1) v += __shfl_xor(v, o);
    return v;
}

struct Args { const float* in[27]; float* out; unsigned char* ws; int ph_lo, ph_hi; };

__device__ __forceinline__ void p0_transpose_item(const float* W, int K, int N, bf16* WT, LAS float* scr, int item, int lane) {
    const int nblk = N / 32, kb = item / nblk, nb = item % nblk, k0 = 64 * kb, n0 = 32 * nb;
#pragma unroll 8
    for (int i = 0; i < 32; ++i) { const int kk = 2 * i + (lane >> 5); scr[kk * 33 + (lane & 31)] = W[(size_t)(k0 + kk) * N + n0 + (lane & 31)]; }
    LDS_WAIT(); asm volatile("" ::: "memory");
    const int c = lane & 7;
#pragma unroll
    for (int j = 0; j < 4; ++j) { const int n = (lane >> 3) + 8 * j; const LAS float* s = scr + (8 * c) * 33 + n;
        v4u o; o.x = pk2(s[0 * 33], s[1 * 33]); o.y = pk2(s[2 * 33], s[3 * 33]); o.z = pk2(s[4 * 33], s[5 * 33]); o.w = pk2(s[6 * 33], s[7 * 33]);
        *(v4u*)(WT + (size_t)(n0 + n) * K + k0 + 8 * c) = o; }
    LDS_WAIT(); asm volatile("" ::: "memory");
}
__device__ __forceinline__ void p0_prep(const Args& a, unsigned char* ldsg, int vcu, int G) {
    LAS unsigned char* lds = (LAS unsigned char*)ldsg;
    const int tid = ltid(), lane = tid & 63, wave = tid >> 6;
    float* mod = (float*)(a.ws + WS_MOD);
    for (int item = blockIdx.x; item < 192; item += G) {
        LAS float* sin_ = (LAS float*)lds;
        for (int i = tid; i < 5 * 1024; i += NTHR) { const int r = i >> 10, k = i & 1023; const float c = r < 4 ? a.in[1][r * 1024 + k] : a.in[3][k]; sin_[i] = c / (1.f + __expf(-c)); }
        __syncthreads();
        const int l = item / 96, cb = item % 96;
        const float* W = a.in[4] + (size_t)l * 1024 * MODW + cb * 64 + lane;
        float acc[5] = {0.f, 0.f, 0.f, 0.f, 0.f};
        const int k0 = wave * 128;
#pragma unroll 8
        for (int kk = 0; kk < 128; ++kk) { const int k = k0 + kk; const float w = W[(size_t)k * MODW];
#pragma unroll
            for (int r = 0; r < 5; ++r) acc[r] += sin_[r * 1024 + k] * w; }
        LAS float* red = (LAS float*)(lds + 20480);
#pragma unroll
        for (int r = 0; r < 5; ++r) red[(wave * 5 + r) * 64 + lane] = acc[r];
        __syncthreads();
        if (tid < 320) { const int r = tid >> 6, col = tid & 63; float s = 0.f;
#pragma unroll
            for (int w = 0; w < 8; ++w) s += red[(w * 5 + r) * 64 + col];
            s += a.in[5][l * MODW + cb * 64 + col]; mod[(size_t)(l * 5 + r) * MODW + cb * 64 + col] = s; }
        __syncthreads();
    }
    LAS float* scr = (LAS float*)(lds + 32768 + wave * 8448);
    const int gw = vcu * NWAVES + wave, NGW = G * NWAVES;
    constexpr int I_WIN = 16 * 80, I_WOUT = 16 * 32, I_W1 = 16 * 128, I_W2 = 64 * 32, I_ODIN = 16 * 128, I_ODOUT = 32 * 32;
    constexpr int NITEMS = I_WIN + I_WOUT + 2 * I_W1 + 2 * I_W2 + I_ODIN + I_ODOUT;
    for (int it = gw; it < NITEMS; it += NGW) {
        int r = it;
        if (r < I_WIN) { p0_transpose_item(a.in[10], 1024, 2560, (bf16*)(a.ws + WS_WIN), scr, r, lane); continue; } r -= I_WIN;
        if (r < I_WOUT) { p0_transpose_item(a.in[11], 1024, 1024, (bf16*)(a.ws + WS_WOUT), scr, r, lane); continue; } r -= I_WOUT;
        if (r < 2 * I_W1) { const int l = r / I_W1; p0_transpose_item(a.in[8] + (size_t)l * 1024 * 4096, 1024, 4096, (bf16*)(a.ws + WS_W1) + (size_t)l * 4096 * 1024, scr, r % I_W1, lane); continue; } r -= 2 * I_W1;
        if (r < 2 * I_W2) { const int l = r / I_W2; p0_transpose_item(a.in[9] + (size_t)l * 4096 * 1024, 4096, 1024, (bf16*)(a.ws + WS_W2) + (size_t)l * 1024 * 4096, scr, r % I_W2, lane); continue; } r -= 2 * I_W2;
        if (r < I_ODIN) { p0_transpose_item(a.in[21], 1024, 4096, (bf16*)(a.ws + WS_ODIN), scr, r, lane); continue; } r -= I_ODIN;
        p0_transpose_item(a.in[26], 2048, 1024, (bf16*)(a.ws + WS_ODOUT), scr, r, lane);
    }
}

__device__ __forceinline__ void norm_row(const float* xrow, bf16* orow, const f32x4 (&gs)[4], const f32x4 (&sh)[4], int lane) {
    const f32x4* xr = (const f32x4*)xrow + lane;
    f32x4 v[4]; float s2 = 0.f;
#pragma unroll
    for (int j = 0; j < 4; ++j) { v[j] = xr[64 * j]; s2 += (v[j].x * v[j].x + v[j].y * v[j].y) + (v[j].z * v[j].z + v[j].w * v[j].w); }
    const float rstd = rsqrtf(wave_sum(s2) * (1.f / 1024.f) + 1e-6f);
    unsigned long long* o8 = (unsigned long long*)orow + lane;
#pragma unroll
    for (int j = 0; j < 4; ++j) { const f32x4 y = v[j] * rstd * gs[j] + sh[j];
        o8[64 * j] = (unsigned long long)pk2(y.x, y.y) | ((unsigned long long)pk2(y.z, y.w) << 32); }
}
__device__ __forceinline__ void load_mod(const float* g, const float* shp, const float* scp, f32x4 (&gs)[4], f32x4 (&sh)[4], int lane) {
#pragma unroll
    for (int j = 0; j < 4; ++j) { const int idx = 4 * lane + 256 * j; const f32x4 gv = *(const f32x4*)(g + idx), sv = *(const f32x4*)(scp + idx); gs[j] = gv * (sv + 1.0f); sh[j] = *(const f32x4*)(shp + idx); }
}
__device__ __forceinline__ void norm_phase(const float* src, const float* g, const float* modl, int sh_off, int sc_off, bf16* dst, const float* ctx, int vcu, int G) {
    const int tid = ltid(), lane = tid & 63, wave = tid >> 6;
    for (int rb = vcu; rb < 256; rb += G) {
        const int b = rb >> 6; f32x4 gs[4], sh[4];
        load_mod(g, modl + (size_t)b * MODW + sh_off, modl + (size_t)b * MODW + sc_off, gs, sh, lane);
        for (int rr = 0; rr < 8; ++rr) { const size_t row = (size_t)rb * 64 + wave * 8 + rr; norm_row(src + row * 1024, dst + row * 1024, gs, sh, lane); }
        if (ctx && wave < 4) {
            load_mod(g, modl + (size_t)4 * MODW + sh_off, modl + (size_t)4 * MODW + sc_off, gs, sh, lane);
            const size_t row = (size_t)rb * 4 + wave; norm_row(ctx + row * 1024, dst + ((size_t)MTOK + row) * 1024, gs, sh, lane);
        }
    }
}

__device__ __forceinline__ void qknorm_pool_phase(const Args& a, unsigned char* lds, int vcu, int G) {
    const int tid = ltid(), lane = tid & 63, wave = tid >> 6;
    float2* tab = (float2*)lds;
    for (int i = tid; i < 1024; i += NTHR) { const int pos = i >> 4, f = i & 15; const float inv = powf(10000.0f, -(float)f / 16.0f); const float ang = (float)pos * inv; float s, c; sincosf(ang, &s, &c); tab[i] = make_float2(c, s); }
    __syncthreads();
    bf16* Q = (bf16*)(a.ws + WS_Q); bf16* KA = (bf16*)(a.ws + WS_K);
    const float* qg = a.in[14]; const float* kg = a.in[15];
    constexpr int NGQ = MTOK * 12, NGC = 1024 * 12, NITEM = (2 * NGQ + NGC) * 8;
    const int part = tid & 7;
    for (int idx = vcu * NTHR + tid; idx < NITEM; idx += G * NTHR) {
        int gi = idx >> 3; bf16* p; const float* gam; bool rope = true; int t = 0;
        if (gi < NGQ) { const int row = gi / 12, hg = gi - row * 12; p = Q + (size_t)row * 768 + hg * 64; gam = qg; t = row & 4095; }
        else if (gi < 2 * NGQ) { gi -= NGQ; const int row = gi / 12, hg = gi - row * 12; t = row & 4095; p = KA + ((size_t)(row >> 12) * TKV + 256 + t) * 768 + hg * 64; gam = kg; }
        else { gi -= 2 * NGQ; const int row = gi / 12, hg = gi - row * 12; p = KA + ((size_t)(row >> 8) * TKV + (row & 255)) * 768 + hg * 64; gam = kg; rope = false; }
        p += part * 8;
        const v4u w = *(const v4u*)p; float x[8];
        x[0] = bflo(w.x); x[1] = bfhi(w.x); x[2] = bflo(w.y); x[3] = bfhi(w.y); x[4] = bflo(w.z); x[5] = bfhi(w.z); x[6] = bflo(w.w); x[7] = bfhi(w.w);
        float ss = 0.f;
#pragma unroll
        for (int e = 0; e < 8; ++e) ss += x[e] * x[e];
        ss += __shfl_xor(ss, 1); ss += __shfl_xor(ss, 2); ss += __shfl_xor(ss, 4);
        const float rstd = rsqrtf(ss * (1.f / 64.f) + 1e-6f);
        const f32x4 g0 = *(const f32x4*)(gam + part * 8), g1 = *(const f32x4*)(gam + part * 8 + 4);
        x[0] *= rstd * g0.x; x[1] *= rstd * g0.y; x[2] *= rstd * g0.z; x[3] *= rstd * g0.w; x[4] *= rstd * g1.x; x[5] *= rstd * g1.y; x[6] *= rstd * g1.z; x[7] *= rstd * g1.w;
        if (rope) { const int pos = part < 4 ? (t >> 6) : (t & 63); const float2* tp = tab + pos * 16 + (part & 3) * 4;
#pragma unroll
            for (int pr = 0; pr < 4; ++pr) { const float2 cs = tp[pr]; const float x0 = x[2 * pr], x1 = x[2 * pr + 1]; x[2 * pr] = x0 * cs.x - x1 * cs.y; x[2 * pr + 1] = x0 * cs.y + x1 * cs.x; } }
        v4u o; o.x = pk2(x[0], x[1]); o.y = pk2(x[2], x[3]); o.z = pk2(x[4], x[5]); o.w = pk2(x[6], x[7]);
        *(v4u*)p = o;
    }
    bf16* in_ = (bf16*)(lds + 8192);
    float* pooled = (float*)(lds + 8192 + 40960);
    const bf16* PI = (const bf16*)(a.ws + WS_POOL); bf16* Y = (bf16*)(a.ws + WS_Y);
    const float* pw = a.in[12]; const float* pscale = a.in[13];
    for (int tb = vcu; tb < 256; tb += G) {
        const int b = tb >> 6, t0 = (tb & 63) * 64;
        __syncthreads();
#pragma unroll
        for (int ps = 0; ps < 5; ++ps) { const int row = ps * 16 + (tid >> 5), c8 = (tid & 31) * 8, t = t0 - 8 + row;
            v4u w = {0u, 0u, 0u, 0u}; if (t >= 0 && t < SEQ) w = *(const v4u*)(PI + ((size_t)b * SEQ + t) * 256 + c8);
            *(v4u*)(in_ + row * 256 + c8) = w; }
        __syncthreads();
        { const int c = tid & 255, th = tid >> 8, hw = 1 << (c >> 6);
            for (int tt = 0; tt < 32; ++tt) { const int tl = th * 32 + tt, t = t0 + tl; const int lo = max(t - hw, 0), hi = min(t + hw, SEQ);
                float s = 0.f; for (int j = lo; j < hi; ++j) s += bflo((unsigned)in_[(j - t0 + 8) * 256 + c]);
                pooled[tl * 256 + c] = s / (float)(hi - lo) - bflo((unsigned)in_[(tl + 8) * 256 + c]); } }
        __syncthreads();
        { const int gi = wave & 3, th = wave >> 2; float pwr[64];
#pragma unroll
            for (int c = 0; c < 64; ++c) pwr[c] = pw[gi * 4096 + c * 64 + lane];
            const float psc = pscale[gi * 64 + lane];
            for (int tt = 0; tt < 32; ++tt) { const int tl = th * 32 + tt; const f32x4* pp = (const f32x4*)(pooled + tl * 256 + gi * 64); float acc = 0.f;
#pragma unroll
                for (int c4 = 0; c4 < 16; ++c4) { const f32x4 v = pp[c4]; acc += v.x * pwr[4 * c4] + v.y * pwr[4 * c4 + 1] + v.z * pwr[4 * c4 + 2] + v.w * pwr[4 * c4 + 3]; }
                Y[((size_t)b * SEQ + t0 + tl) * 1024 + gi * 64 + lane] = (bf16)f2bf(acc * psc); } }
    }
}

__device__ __forceinline__ void attn_phase(const Args& a, unsigned char* lds, int vcu, int G) {
    const int lane = ltid() & 63;
    const float s1 = wave_sum(a.in[16][lane] * a.in[17][lane]), s2 = wave_sum(a.in[18][lane] * a.in[19][lane]);
    const float lam = expf(s1) - expf(s2) + 0.2f;
    const bf16* Q = (const bf16*)(a.ws + WS_Q); const bf16* KA = (const bf16*)(a.ws + WS_K); const bf16* VA = (const bf16*)(a.ws + WS_V); bf16* Y = (bf16*)(a.ws + WS_Y);
    const int per = 768 / G;
    for (int i = 0; i < per; ++i) { const int u = vcu * per + i, bh = u >> 5, qb = u & 31, b = bh / 6, h = bh - b * 6;
        att::attn_unit(Q + ((size_t)b * SEQ + qb * 128) * 768 + h * 128, KA + (size_t)b * TKV * 768 + h * 128, VA + (size_t)b * TKV * 768 + h * 128,
                       Y + ((size_t)b * SEQ + qb * 128) * 1024 + 256 + h * 128, a.in[20], lam, (char*)lds); }
}

__device__ __forceinline__ void spatial_phase(const Args& a, unsigned char* lds, int vcu, int G) {
    const int tid = ltid(), lane = tid & 63, wave = tid >> 6, r32 = lane & 31, hi = lane >> 5;
    const bf16* VT = (const bf16*)(a.ws + WS_VT); bf16* U = (bf16*)(a.ws + WS_U);
    const float* lng = a.in[22]; const float* lnb = a.in[23]; const float* sgw = a.in[24]; const float* sgb = a.in[25];
    constexpr int TROW = 272;
    unsigned char* T = lds;
    float* red = (float*)lds;
    float* scr = (float*)(lds + 69632) + wave * (32 * 68);
    float* stats = (float*)(lds + 69632 + 69632);
    for (int un = vcu; un < 256; un += G) {
        const int chunk = un >> 1, half = un & 1; const size_t tok0 = (size_t)chunk * 128;
        __syncthreads();
        { const int slot = tid & 15, cg = tid >> 4; float s[8], q[8];
#pragma unroll
            for (int e = 0; e < 8; ++e) { s[e] = 0.f; q[e] = 0.f; }
#pragma unroll 4
            for (int i = 0; i < 64; ++i) { const int c = cg + 32 * i; const v4u w = *(const v4u*)(VT + (size_t)c * MTOK + tok0 + slot * 8);
                float x[8]; x[0] = bflo(w.x); x[1] = bfhi(w.x); x[2] = bflo(w.y); x[3] = bfhi(w.y); x[4] = bflo(w.z); x[5] = bfhi(w.z); x[6] = bflo(w.w); x[7] = bfhi(w.w);
#pragma unroll
                for (int e = 0; e < 8; ++e) { s[e] += x[e]; q[e] += x[e] * x[e]; } }
#pragma unroll
            for (int e = 0; e < 8; ++e) { red[(cg * 128 + slot * 8 + e) * 2] = s[e]; red[(cg * 128 + slot * 8 + e) * 2 + 1] = q[e]; } }
        __syncthreads();
        if (tid < 128) { float s = 0.f, q = 0.f;
            for (int cg = 0; cg < 32; ++cg) { s += red[(cg * 128 + tid) * 2]; q += red[(cg * 128 + tid) * 2 + 1]; }
            const float mean = s * (1.f / 2048.f), var = fmaxf(q * (1.f / 2048.f) - mean * mean, 0.f);
            stats[tid * 2] = mean; stats[tid * 2 + 1] = rsqrtf(var + 1e-6f); }
        __syncthreads();
        for (int gq = 0; gq < 4; ++gq) { const int g = half * 4 + gq;
            if (gq) __syncthreads();
            { const int slot = tid & 15, cr = tid >> 4; float mu[8], rs[8];
#pragma unroll
                for (int e = 0; e < 8; ++e) { mu[e] = stats[(slot * 8 + e) * 2]; rs[e] = stats[(slot * 8 + e) * 2 + 1]; }
#pragma unroll
                for (int i = 0; i < 8; ++i) { const int cl = cr + 32 * i, c = g * 256 + cl; const v4u w = *(const v4u*)(VT + (size_t)c * MTOK + tok0 + slot * 8);
                    const float lg = lng[c], lb = lnb[c];
                    float x[8]; x[0] = bflo(w.x); x[1] = bfhi(w.x); x[2] = bflo(w.y); x[3] = bfhi(w.y); x[4] = bflo(w.z); x[5] = bfhi(w.z); x[6] = bflo(w.w); x[7] = bfhi(w.w);
#pragma unroll
                    for (int e = 0; e < 8; ++e) x[e] = (x[e] - mu[e]) * rs[e] * lg + lb;
                    v4u o; o.x = pk2(x[0], x[1]); o.y = pk2(x[2], x[3]); o.z = pk2(x[4], x[5]); o.w = pk2(x[6], x[7]);
                    *(v4u*)(T + cl * TROW + slot * 16) = o; } }
            __syncthreads();
            const int mb = (wave & 3) * 32, ch = (wave >> 2) * 128;
            bf16x8 af[8];
            { const float* wrow = sgw + ((size_t)g * 128 + mb + r32) * 128 + hi * 8;
#pragma unroll
                for (int ks = 0; ks < 8; ++ks) { const f32x4 w0 = *(const f32x4*)(wrow + ks * 16), w1 = *(const f32x4*)(wrow + ks * 16 + 4);
                    v4u p; p.x = pk2(w0.x, w0.y); p.y = pk2(w0.z, w0.w); p.z = pk2(w1.x, w1.y); p.w = pk2(w1.z, w1.w); af[ks] = __builtin_bit_cast(bf16x8, p); } }
            f32x16 o[4];
#pragma unroll
            for (int d0 = 0; d0 < 4; ++d0) { o[d0] = f32x16{};
#pragma unroll
                for (int ks = 0; ks < 8; ++ks) { const bf16x8 bfr = *(const bf16x8*)(T + (ch + d0 * 32 + r32) * TROW + (16 * ks + 8 * hi) * 2);
                    o[d0] = __builtin_amdgcn_mfma_f32_32x32x16_bf16(af[ks], bfr, o[d0], 0, 0, 0); } }
            float bias[16];
#pragma unroll
            for (int r = 0; r < 16; ++r) bias[r] = sgb[g * 128 + mb + att::crow(r, hi)];
#pragma unroll
            for (int p = 0; p < 2; ++p) {
#pragma unroll
                for (int dd = 0; dd < 2; ++dd)
#pragma unroll
                    for (int r = 0; r < 16; ++r) scr[att::crow(r, hi) * 68 + dd * 32 + r32] = o[2 * p + dd][r] + bias[r];
                LDS_WAIT(); asm volatile("" ::: "memory");
#pragma unroll
                for (int qq = 0; qq < 4; ++qq) { const int row = (lane >> 3) + 8 * qq, c8 = (lane & 7) * 8;
                    const f32x4 m0 = *(const f32x4*)(scr + row * 68 + c8), m1 = *(const f32x4*)(scr + row * 68 + c8 + 4);
                    bf16* up = U + (tok0 + mb + row) * 2048 + g * 256 + ch + p * 64 + c8; const v4u w = *(const v4u*)up;
                    v4u ov; ov.x = pk2(bflo(w.x) * m0.x, bfhi(w.x) * m0.y); ov.y = pk2(bflo(w.y) * m0.z, bfhi(w.y) * m0.w);
                    ov.z = pk2(bflo(w.z) * m1.x, bfhi(w.z) * m1.y); ov.w = pk2(bflo(w.w) * m1.z, bfhi(w.w) * m1.w);
                    *(v4u*)up = ov; }
                LDS_WAIT(); asm volatile("" ::: "memory");
            }
        }
    }
}


#if MK_DEBUG
__device__ __forceinline__ float bfr(float f) { return __builtin_bit_cast(float, f2bf(f) << 16); }
__device__ __forceinline__ float bf2f(bf16 v) { return __builtin_bit_cast(float, (unsigned)v << 16); }
__device__ __forceinline__ void rec(float* res, int st, float got, float want) { float e = fabsf(got - want) / (fabsf(want) + 0.1f); if (!(e == e) || e > 1e30f) e = 0.77f; else e = fminf(e, 0.6f); atomicMax((unsigned*)res + st, __float_as_uint(e)); }
__device__ __forceinline__ unsigned hsh(unsigned s) { s ^= s >> 16; s *= 0x7feb352du; s ^= s >> 15; s *= 0x846ca68bu; s ^= s >> 16; return s; }
__global__ void chk_mod(Args a, float* res) {
    const int i = blockIdx.x * 256 + threadIdx.x; if (i >= 2 * 5 * 6144) return; const int l = i / (5 * 6144), r = (i / 6144) % 5, n = i % 6144;
    float s = 0.f; for (int k = 0; k < 1024; ++k) { const float c = r < 4 ? a.in[1][r * 1024 + k] : a.in[3][k]; s += (c / (1.f + expf(-c))) * a.in[4][((size_t)l * 1024 + k) * 6144 + n]; }
    s += a.in[5][l * 6144 + n]; rec(res, 0, ((const float*)(a.ws + WS_MOD))[i], s);
}
__global__ void chk_wt(const float* W, int K, int N, const bf16* WT, float* res, int st) {
    const unsigned h = hsh(blockIdx.x * 256 + threadIdx.x + 77u * st); const int k = h % K, n = (h >> 12) % N;
    rec(res, st, bf2f(WT[(size_t)n * K + k]), bfr(W[(size_t)k * N + n]));
}
__global__ void chk_norm(const float* src, const float* g, const float* modrow_sh, const float* modrow_sc, int bstride, const bf16* dst, int nrows, int rows_per_b, float* res, int st, int row_base = 0) {
    __shared__ float red[256]; const unsigned h = hsh(blockIdx.x + 1000u * st); const int row = row_base + h % nrows; const int b = rows_per_b ? row / rows_per_b : 0; const int t = threadIdx.x;
    float s = 0.f; for (int k = t; k < 1024; k += 256) { const float v = src[(size_t)row * 1024 + k]; s += v * v; } red[t] = s; __syncthreads();
    for (int o = 128; o > 0; o >>= 1) { if (t < o) red[t] += red[t + o]; __syncthreads(); }
    const float rstd = rsqrtf(red[0] / 1024.f + 1e-6f);
    for (int k = t; k < 1024; k += 256) { const float want = src[(size_t)row * 1024 + k] * rstd * g[k] * (1.f + modrow_sc[(size_t)b * bstride + k]) + modrow_sh[(size_t)b * bstride + k]; rec(res, st, bf2f(dst[(size_t)row * 1024 + k]), want); }
}
__device__ __forceinline__ float dotbf(const bf16* A, const bf16* B, int K) { float s = 0.f; for (int k = 0; k < K; ++k) s += bf2f(A[k]) * bf2f(B[k]); return s; }
__global__ void chk_gemm1(Args a, float* res) {
    const unsigned h = hsh(blockIdx.x * 256 + threadIdx.x); int row = h % 17408; int col = (h >> 15) % 2560;
    if (row >= 16384) { col = 1024 + (h >> 15) % 1536; }
    const bf16* XN = (const bf16*)(a.ws + WS_XN); const bf16* WT = (const bf16*)(a.ws + WS_WIN);
    const float want = dotbf(XN + (size_t)row * 1024, WT + (size_t)col * 1024, 1024); float got;
    if (row < 16384) { const int b = row >> 12, t = row & 4095; const size_t kv = (size_t)b * TKV + 256 + t;
        if (col < 256) got = bf2f(((const bf16*)(a.ws + WS_POOL))[(size_t)row * 256 + col]);
        else if (col < 1024) got = bf2f(((const bf16*)(a.ws + WS_Q))[(size_t)row * 768 + col - 256]);
        else if (col < 1792) got = bf2f(((const bf16*)(a.ws + WS_K))[kv * 768 + col - 1024]);
        else got = bf2f(((const bf16*)(a.ws + WS_V))[kv * 768 + col - 1792]);
    } else { const int rc = row - 16384, b = rc >> 8, j = rc & 255; const size_t kv = (size_t)b * TKV + j;
        if (col < 1792) got = bf2f(((const bf16*)(a.ws + WS_K))[kv * 768 + col - 1024]); else got = bf2f(((const bf16*)(a.ws + WS_V))[kv * 768 + col - 1792]); }
    rec(res, 3, got, want);
}
__global__ void chk_qk(Args a, float* res) {
    __shared__ float raw[64]; __shared__ float red[64]; const unsigned h = hsh(blockIdx.x + 4242u); const int d = threadIdx.x;
    int row = h % 17408; const int hg = (h >> 16) % 12; int isq = (h >> 24) & 1; if (row >= 16384) isq = 0;
    const bf16* XN = (const bf16*)(a.ws + WS_XN); const bf16* WT = (const bf16*)(a.ws + WS_WIN);
    const int col = (isq ? 256 : 1024) + hg * 64 + d;
    raw[d] = bfr(dotbf(XN + (size_t)row * 1024, WT + (size_t)col * 1024, 1024)); red[d] = raw[d] * raw[d]; __syncthreads();
    for (int o = 32; o > 0; o >>= 1) { if (d < o) red[d] += red[d + o]; __syncthreads(); }
    const float rstd = rsqrtf(red[0] / 64.f + 1e-6f); const float* gam = isq ? a.in[14] : a.in[15];
    float y = raw[d] * rstd * gam[d]; __syncthreads(); red[d] = y; __syncthreads();
    float want = y; size_t off;
    if (row < 16384) { const int t = row & 4095, pr = d >> 1; const float pos = (float)(pr < 16 ? (t >> 6) : (t & 63)); const float inv = powf(10000.f, -(float)(pr & 15) / 16.f); const float ang = pos * inv;
        const float cs = cosf(ang), sn = sinf(ang), x0 = red[2 * pr], x1 = red[2 * pr + 1]; want = (d & 1) ? x0 * sn + x1 * cs : x0 * cs - x1 * sn;
        off = isq ? (size_t)row * 768 + hg * 64 + d : ((size_t)(row >> 12) * TKV + 256 + t) * 768 + hg * 64 + d;
    } else { const int rc = row - 16384; off = ((size_t)(rc >> 8) * TKV + (rc & 255)) * 768 + hg * 64 + d; }
    const bf16* buf = isq ? (const bf16*)(a.ws + WS_Q) : (const bf16*)(a.ws + WS_K);
    rec(res, 4, bf2f(buf[off]), want);
}
__global__ void chk_pool(Args a, float* res) {
    const unsigned h = hsh(blockIdx.x * 256 + threadIdx.x + 999u); const int row = h % 16384, gi = (h >> 14) & 3, d = (h >> 16) & 63; const int b = row >> 12, t = row & 4095, hw = 1 << gi;
    const bf16* PI = (const bf16*)(a.ws + WS_POOL); const int lo = max(t - hw, 0), hi = min(t + hw, 4096); float acc = 0.f;
    for (int c = 0; c < 64; ++c) { float s = 0.f; for (int j = lo; j < hi; ++j) s += bf2f(PI[((size_t)b * 4096 + j) * 256 + gi * 64 + c]);
        const float pooled = s / (float)(hi - lo) - bf2f(PI[(size_t)row * 256 + gi * 64 + c]); acc += pooled * a.in[12][gi * 4096 + c * 64 + d]; }
    rec(res, 5, bf2f(((const bf16*)(a.ws + WS_Y))[(size_t)row * 1024 + gi * 64 + d]), acc * a.in[13][gi * 64 + d]);
}
__global__ void chk_attn(Args a, float* res) {
    __shared__ float s1[TKV], s2[TKV]; __shared__ float red[256]; __shared__ float ov[128];
    const unsigned hh = hsh(blockIdx.x + 31337u); const int row = hh % 16384, h = (hh >> 14) % 6, b = row >> 12, t = threadIdx.x;
    const bf16* Q = (const bf16*)(a.ws + WS_Q) + (size_t)row * 768 + h * 128; const bf16* KA = (const bf16*)(a.ws + WS_K) + (size_t)b * TKV * 768 + h * 128; const bf16* VA = (const bf16*)(a.ws + WS_V) + (size_t)b * TKV * 768 + h * 128;
    float l1 = 0.f, l2 = 0.f; for (int i = 0; i < 64; ++i) { l1 += a.in[16][i] * a.in[17][i]; l2 += a.in[18][i] * a.in[19][i]; } const float lam = expf(l1) - expf(l2) + 0.2f;
    for (int k = t; k < TKV; k += 256) { float x1 = 0.f, x2 = 0.f; for (int d = 0; d < 64; ++d) { x1 += bf2f(Q[d]) * bf2f(KA[(size_t)k * 768 + d]); x2 += bf2f(Q[64 + d]) * bf2f(KA[(size_t)k * 768 + 64 + d]); } s1[k] = x1 * 0.125f; s2[k] = x2 * 0.125f; }
    __syncthreads();
    float m1 = -1e30f, m2 = -1e30f; for (int k = t; k < TKV; k += 256) { m1 = fmaxf(m1, s1[k]); m2 = fmaxf(m2, s2[k]); }
    red[t] = m1; __syncthreads(); for (int o = 128; o > 0; o >>= 1) { if (t < o) red[t] = fmaxf(red[t], red[t + o]); __syncthreads(); } m1 = red[0]; __syncthreads();
    red[t] = m2; __syncthreads(); for (int o = 128; o > 0; o >>= 1) { if (t < o) red[t] = fmaxf(red[t], red[t + o]); __syncthreads(); } m2 = red[0]; __syncthreads();
    float z1 = 0.f, z2 = 0.f; for (int k = t; k < TKV; k += 256) { s1[k] = expf(s1[k] - m1); s2[k] = expf(s2[k] - m2); z1 += s1[k]; z2 += s2[k]; }
    red[t] = z1; __syncthreads(); for (int o = 128; o > 0; o >>= 1) { if (t < o) red[t] += red[t + o]; __syncthreads(); } z1 = red[0]; __syncthreads();
    red[t] = z2; __syncthreads(); for (int o = 128; o > 0; o >>= 1) { if (t < o) red[t] += red[t + o]; __syncthreads(); } z2 = red[0]; __syncthreads();
    if (t < 128) { float o = 0.f; for (int k = 0; k < TKV; ++k) o += (s1[k] / z1 - lam * s2[k] / z2) * bf2f(VA[(size_t)k * 768 + t]); ov[t] = o; red[t] = o * o; } else red[t] = 0.f;
    __syncthreads(); for (int o = 128; o > 0; o >>= 1) { if (t < o) red[t] += red[t + o]; __syncthreads(); }
    if (t < 128) { const float want = ov[t] * rsqrtf(red[0] / 128.f + 1e-6f) * a.in[20][t] * 0.8f; rec(res, 6, bf2f(((const bf16*)(a.ws + WS_Y))[(size_t)row * 1024 + 256 + h * 128 + t]), want); }
}
__global__ void chk_res(const bf16* A, const bf16* WT, int K, const float* basebuf, const float* gate, const float* out, float* res, int st, int nrows) {
    const unsigned h = hsh(blockIdx.x * 256 + threadIdx.x + 555u * st); const int row = h % nrows, col = (h >> 13) % 1024;
    const float want = basebuf[(size_t)row * 1024 + col] + gate[(size_t)(row >> 12) * 6144 + col] * dotbf(A + (size_t)row * K, WT + (size_t)col * K, K);
    rec(res, st, out[(size_t)row * 1024 + col], want);
}
__global__ void chk_act(const bf16* A, const bf16* WT, int K, int N, const bf16* O, int ldo, int act, int transposed, float* res, int st) {
    const unsigned h = hsh(blockIdx.x * 256 + threadIdx.x + 333u * st); const int row = h % 16384, col = (h >> 14) % N;
    float v = dotbf(A + (size_t)row * K, WT + (size_t)col * K, K); if (act == 2) { v = fmaxf(v, 0.f); v *= v; } else if (act == 1) v = 0.5f * v * (1.f + erff(v * 0.70710678f));
    rec(res, st, bf2f(transposed ? O[(size_t)col * ldo + row] : O[(size_t)row * ldo + col]), v);
}
__global__ void chk_copy(const float* src, float* dst, size_t n4) { for (size_t i = blockIdx.x * 256ull + threadIdx.x; i < n4; i += gridDim.x * 256ull) ((f32x4*)dst)[i] = ((const f32x4*)src)[i]; }
__global__ void chk_final(float* res, float* out, int nst) {
    for (int i = 0; i < nst; ++i) { const float e = res[i]; if (e > 0.08f) { float m = fminf(fmaxf(e * 10.f, 1.0f), 9.9f); float v = m; for (int j = 0; j < 4 + i; ++j) v *= 10.f; out[0] = v; return; } }
}
__global__ void simple_norm(const float* src, const float* g, const float* sh, const float* sc, int bstride, bf16* dst) {
    __shared__ float red[256]; const int row = blockIdx.x, b = row >> 12, t = threadIdx.x;
    float s = 0.f; for (int k = t; k < 1024; k += 256) { const float v = src[(size_t)row * 1024 + k]; s += v * v; } red[t] = s; __syncthreads();
    for (int o = 128; o > 0; o >>= 1) { if (t < o) red[t] += red[t + o]; __syncthreads(); }
    const float rstd = rsqrtf(red[0] / 1024.f + 1e-6f);
    for (int k = t; k < 1024; k += 256) dst[(size_t)row * 1024 + k] = (bf16)f2bf(src[(size_t)row * 1024 + k] * rstd * g[k] * (1.f + sc[(size_t)b * bstride + k]) + sh[(size_t)b * bstride + k]);
}
__global__ void chk_final2(float* res, float* out) { int mask = 0; for (int i = 0; i < 8; ++i) if (res[20 + i] < 0.08f) mask |= 1 << i; out[0] = (float)(mask + 1) * 1e6f; }
#endif

template <int PH> __device__ __forceinline__ void run_phase(const Args& a, unsigned char* lds, int vcu, int G, int bx) {
    unsigned char* ws = a.ws;
    float* mod = (float*)(ws + WS_MOD);
    bf16* XN = (bf16*)(ws + WS_XN);
    if constexpr (PH == 0) p0_prep(a, lds, vcu, G);
    else if constexpr (PH == 1)  norm_phase(a.in[0], a.in[6],        mod,            0,    1024, XN, a.in[2], vcu, G);
    else if constexpr (PH == 6)  norm_phase(a.out,   a.in[7],        mod,            3072, 4096, XN, nullptr, vcu, G);
    else if constexpr (PH == 9)  norm_phase(a.out,   a.in[6] + 1024, mod + 5 * MODW, 0,    1024, XN, nullptr, vcu, G);
    else if constexpr (PH == 13) norm_phase(a.out,   a.in[7] + 1024, mod + 5 * MODW, 3072, 4096, XN, nullptr, vcu, G);
    else if constexpr (PH == 2) {
        pg8::Gemm g{XN, (const bf16*)(ws + WS_WIN), 17408, 2560, 1024}; pg8::OrderQKV S; S.init(G, bx);
        pg8::EpiRoute E{(bf16*)(ws + WS_POOL), (bf16*)(ws + WS_Q), (bf16*)(ws + WS_K), (bf16*)(ws + WS_V)};
        pg8::gemm_phase<pg8::EpiRoute, pg8::OrderQKV, true, true>((LAS unsigned char*)lds, g, S, E);
    }
    else if constexpr (PH == 3) qknorm_pool_phase(a, lds, vcu, G);
    else if constexpr (PH == 4) attn_phase(a, lds, vcu, G);
    else if constexpr (PH == 5 || PH == 8 || PH == 12 || PH == 15) {
        pg8::Gemm g; const float* base; const float* gate;
        if constexpr (PH == 5)       { g = pg8::Gemm{(const bf16*)(ws + WS_Y),  (const bf16*)(ws + WS_WOUT),  MTOK, 1024, 1024}; base = a.in[0]; gate = mod + 2048; }
        else if constexpr (PH == 8)  { g = pg8::Gemm{(const bf16*)(ws + WS_HB), (const bf16*)(ws + WS_W2),    MTOK, 1024, 4096}; base = a.out;   gate = mod + 5120; }
        else if constexpr (PH == 12) { g = pg8::Gemm{(const bf16*)(ws + WS_U),  (const bf16*)(ws + WS_ODOUT), MTOK, 1024, 2048}; base = a.out;   gate = mod + 5 * MODW + 2048; }
        else                         { g = pg8::Gemm{(const bf16*)(ws + WS_HB), (const bf16*)(ws + WS_W2) + (size_t)1024 * 4096, MTOK, 1024, 4096}; base = a.out; gate = mod + 5 * MODW + 5120; }
        pg8::StaticOrder S; S.init(g.M, g.N, G, bx);
        pg8::EpiRes E{base, a.out, gate};
        pg8::gemm_phase<pg8::EpiRes, pg8::StaticOrder, true, true>((LAS unsigned char*)lds, g, S, E);
    }
    else if constexpr (PH == 7 || PH == 14) {
        pg8::Gemm g{XN, (const bf16*)(ws + WS_W1) + (PH == 14 ? (size_t)4096 * 1024 : 0), MTOK, FF, 1024}; pg8::EpiAct E{(bf16*)(ws + WS_HB), FF, 2};
        pg8::StaticOrder S; S.init(g.M, g.N, G, bx);
        pg8::gemm_phase<pg8::EpiAct, pg8::StaticOrder, true, true>((LAS unsigned char*)lds, g, S, E);
    }
    else if constexpr (PH == 10) {
        { pg8::Gemm g{XN, (const bf16*)(ws + WS_ODIN), MTOK, 2048, 1024}; pg8::EpiAct E{(bf16*)(ws + WS_U), 2048, 1};
          pg8::StaticOrder S; S.init(g.M, g.N, G, bx);
          pg8::gemm_phase<pg8::EpiAct, pg8::StaticOrder, true, true>((LAS unsigned char*)lds, g, S, E); }
        { pg8::Gemm g{(const bf16*)(ws + WS_ODIN) + (size_t)2048 * 1024, XN, 2048, MTOK, 1024}; pg8::EpiAct E{(bf16*)(ws + WS_VT), MTOK, 1};
          pg8::StaticOrder S; S.init(g.M, g.N, G, bx);
          pg8::gemm_phase<pg8::EpiAct, pg8::StaticOrder, true, true>((LAS unsigned char*)lds, g, S, E); }
    }
    else if constexpr (PH == 11) spatial_phase(a, lds, vcu, G);
}
__global__ void __launch_bounds__(NTHR) fwd_megakernel(Args a) {
    extern __shared__ __attribute__((aligned(16))) unsigned char lds[];
    const int G = gridDim.x, bx = blockIdx.x;
    const int vcu = (G % 8 == 0) ? (bx % 8) * (G / 8) + bx / 8 : bx;
#define PHASE(k) if (a.ph_lo <= (k) && (k) < a.ph_hi) { run_phase<k>(a, lds, vcu, G, bx); if ((k) + 1 < a.ph_hi) cg::this_grid().sync(); }
    PHASE(0) PHASE(1) PHASE(2) PHASE(3) PHASE(4) PHASE(5) PHASE(6) PHASE(7) PHASE(8) PHASE(9) PHASE(10) PHASE(11) PHASE(12) PHASE(13) PHASE(14) PHASE(15)
#undef PHASE
}

extern "C" void kernel_launch(void* const* d_in, const int* in_sizes, int n_in, void* d_out, int out_size, void* d_ws, size_t ws_size, hipStream_t stream) {
    static int grid = 0;
    if (grid == 0) {
        if (n_in != 27 || in_sizes[0] != MTOK * DM || out_size != MTOK * DM || ws_size < WS_END) { fprintf(stderr, "kernel_launch: unexpected shapes (n_in %d, in0 %d, out %d, ws %zu)\n", n_in, n_in > 0 ? in_sizes[0] : -1, out_size, ws_size); grid = -1; return; }
        if (hipFuncSetAttribute((const void*)fwd_megakernel, hipFuncAttributeMaxDynamicSharedMemorySize, LDS_BYTES) != hipSuccess) { fprintf(stderr, "kernel_launch: hipFuncSetAttribute failed\n"); grid = -1; return; }
        int dev = 0, cus = 0, per_cu = 0;
        (void)hipGetDevice(&dev); (void)hipDeviceGetAttribute(&cus, hipDeviceAttributeMultiprocessorCount, dev);
        (void)hipOccupancyMaxActiveBlocksPerMultiprocessor(&per_cu, (const void*)fwd_megakernel, NTHR, LDS_BYTES);
        if (per_cu < 1 || cus < 256) fprintf(stderr, "kernel_launch: note: occupancy query %d blocks/CU, %d CUs\n", per_cu, cus);
        (void)hipGetLastError();
        grid = 256;
    }
    if (grid < 0) return;
    Args a{};
    for (int i = 0; i < 27; ++i) a.in[i] = (const float*)d_in[i];
    a.out = (float*)d_out; a.ws = (unsigned char*)d_ws;
#if MK_MULTI
#if MK_DEBUG
    float* res = (float*)d_ws; (void)hipMemsetAsync(res, 0, 256, stream);
    unsigned char* ws = (unsigned char*)d_ws; float* mod = (float*)(ws + WS_MOD); float* snap = (float*)(ws + 220 * MiB);
#endif
    for (int ph = 0; ph < NPH_RUN; ++ph) { a.ph_lo = ph; a.ph_hi = ph + 1;
#if MK_DEBUG
        if (ph == 8 || ph == 12 || ph == 15) hipLaunchKernelGGL(chk_copy, dim3(2048), dim3(256), 0, stream, (const float*)d_out, snap, (size_t)8192 * 1024 / 4);
#endif
#if MK_DEBUG
        if (ph == 6 && MK_SIMPLE6) hipLaunchKernelGGL(simple_norm, dim3(16384), dim3(256), 0, stream, (const float*)d_out, a.in[7], (const float*)(mod + 3072), (const float*)(mod + 4096), 6144, (bf16*)(ws + WS_XN)); else
#endif
        hipLaunchKernelGGL(fwd_megakernel, dim3(grid), dim3(NTHR), LDS_BYTES, stream, a);
#if MK_DEBUG
        if (ph == 0) { hipLaunchKernelGGL(chk_mod, dim3(240), dim3(256), 0, stream, a, res);
            hipLaunchKernelGGL(chk_wt, dim3(16), dim3(256), 0, stream, a.in[10], 1024, 2560, (const bf16*)(ws + WS_WIN), res, 1);
            hipLaunchKernelGGL(chk_wt, dim3(16), dim3(256), 0, stream, a.in[11], 1024, 1024, (const bf16*)(ws + WS_WOUT), res, 1);
            hipLaunchKernelGGL(chk_wt, dim3(16), dim3(256), 0, stream, a.in[8], 1024, 4096, (const bf16*)(ws + WS_W1), res, 1);
            hipLaunchKernelGGL(chk_wt, dim3(16), dim3(256), 0, stream, a.in[8] + 1024 * 4096, 1024, 4096, (const bf16*)(ws + WS_W1) + 4096 * 1024, res, 1);
            hipLaunchKernelGGL(chk_wt, dim3(16), dim3(256), 0, stream, a.in[9], 4096, 1024, (const bf16*)(ws + WS_W2), res, 1);
            hipLaunchKernelGGL(chk_wt, dim3(16), dim3(256), 0, stream, a.in[9] + 1024 * 4096, 4096, 1024, (const bf16*)(ws + WS_W2) + 4096 * 1024, res, 1);
            hipLaunchKernelGGL(chk_wt, dim3(16), dim3(256), 0, stream, a.in[21], 1024, 4096, (const bf16*)(ws + WS_ODIN), res, 1);
            hipLaunchKernelGGL(chk_wt, dim3(16), dim3(256), 0, stream, a.in[26], 2048, 1024, (const bf16*)(ws + WS_ODOUT), res, 1); }
        if (ph == 1) { hipLaunchKernelGGL(chk_norm, dim3(128), dim3(256), 0, stream, a.in[0], a.in[6], (const float*)mod, (const float*)(mod + 1024), 6144, (const bf16*)(ws + WS_XN), 16384, 4096, res, 2);
            hipLaunchKernelGGL(chk_norm, dim3(64), dim3(256), 0, stream, a.in[2], a.in[6], (const float*)(mod + 4 * 6144), (const float*)(mod + 4 * 6144 + 1024), 0, (const bf16*)(ws + WS_XN) + (size_t)16384 * 1024, 1024, 0, res, 2); }
        if (ph == 2) hipLaunchKernelGGL(chk_gemm1, dim3(32), dim3(256), 0, stream, a, res);
        if (ph == 3) { hipLaunchKernelGGL(chk_qk, dim3(512), dim3(64), 0, stream, a, res); hipLaunchKernelGGL(chk_pool, dim3(16), dim3(256), 0, stream, a, res); }
        if (ph == 4) hipLaunchKernelGGL(chk_attn, dim3(96), dim3(256), 0, stream, a, res);
        if (ph == 5) hipLaunchKernelGGL(chk_res, dim3(16), dim3(256), 0, stream, (const bf16*)(ws + WS_Y), (const bf16*)(ws + WS_WOUT), 1024, a.in[0], (const float*)(mod + 2048), (const float*)d_out, res, 7, 16384);
        if (ph == 6) hipLaunchKernelGGL(chk_norm, dim3(128), dim3(256), 0, stream, (const float*)d_out, a.in[7], (const float*)(mod + 3072), (const float*)(mod + 4096), 6144, (const bf16*)(ws + WS_XN), 16384, 4096, res, 8);
        if (ph == 7) hipLaunchKernelGGL(chk_act, dim3(16), dim3(256), 0, stream, (const bf16*)(ws + WS_XN), (const bf16*)(ws + WS_W1), 1024, 4096, (const bf16*)(ws + WS_HB), 4096, 2, 0, res, 9);
        if (ph == 8) hipLaunchKernelGGL(chk_res, dim3(16), dim3(256), 0, stream, (const bf16*)(ws + WS_HB), (const bf16*)(ws + WS_W2), 4096, (const float*)snap, (const float*)(mod + 5120), (const float*)d_out, res, 10, 8192);
        if (ph == 9) hipLaunchKernelGGL(chk_norm, dim3(128), dim3(256), 0, stream, (const float*)d_out, a.in[6] + 1024, (const float*)(mod + 5 * 6144), (const float*)(mod + 5 * 6144 + 1024), 6144, (const bf16*)(ws + WS_XN), 16384, 4096, res, 11);
        if (ph == 10) { hipLaunchKernelGGL(chk_act, dim3(16), dim3(256), 0, stream, (const bf16*)(ws + WS_XN), (const bf16*)(ws + WS_ODIN), 1024, 2048, (const bf16*)(ws + WS_U), 2048, 1, 0, res, 12);
            hipLaunchKernelGGL(chk_act, dim3(16), dim3(256), 0, stream, (const bf16*)(ws + WS_XN), (const bf16*)(ws + WS_ODIN) + (size_t)2048 * 1024, 1024, 2048, (const bf16*)(ws + WS_VT), 16384, 1, 1, res, 13); }
#endif
    }
#if MK_DEBUG
    if (NPH_RUN == 16) hipLaunchKernelGGL(chk_final, dim3(1), dim3(1), 0, stream, res, (float*)d_out, 14);
#endif
#else
    a.ph_lo = 0; a.ph_hi = NPH;
    void* args[] = {&a};
    hipError_t e = hipLaunchCooperativeKernel((const void*)fwd_megakernel, dim3(grid), dim3(NTHR), args, LDS_BYTES, stream);
    if (e != hipSuccess) fprintf(stderr, "kernel_launch: cooperative launch failed: %s\n", hipGetErrorString(e));
#endif
}
```

```cpp
#include <hip/hip_runtime.h>
#include <hip/hip_cooperative_groups.h>
#include <cstdio>
#include <cstdint>
namespace cg = cooperative_groups;
__device__ __forceinline__ int ltid() { int t = threadIdx.x; asm volatile("" : "+v"(t)); return t; }
namespace pg8 {
#define PG8_LAS __attribute__((address_space(3)))
typedef unsigned short bf16_t;
typedef short bf16x8 __attribute__((ext_vector_type(8)));
typedef float f32x4 __attribute__((ext_vector_type(4)));
typedef unsigned u32x4 __attribute__((ext_vector_type(4)));
constexpr int BM = 256, BK = 64, HALF = 128, HTB = HALF * BK * 2  , STAGE_BYTES = 8 * HTB, NXCD = 8, WGM = 8;

__host__ __device__ __forceinline__ int lds_byte(int r, int c) { const int st = (r >> 4) * 2 + (c >> 5), rr = r & 15, cc = c & 31, ob = rr * 64 + cc * 2; return st * 1024 + (ob ^ (((ob >> 9) & 1) << 5)); }
__host__ __device__ __forceinline__ void stage_rc(int b, int& R, int& C) { const int st = b / 1024, sb = b % 1024, swz = sb ^ (((sb >> 9) & 1) << 5); R = (st >> 1) * 16 + swz / 64; C = (st & 1) * 32 + (swz % 64) / 2; }
__host__ __device__ __forceinline__ int perm32(int rho) { const int n = rho >> 4, i = rho & 15; return 8 * (i >> 2) + 4 * n + (i & 3); }

struct Unit { int pm, pn; };
struct Gemm { const bf16_t* A; const bf16_t* Bt; int M, N, K; };

struct StaticOrder {
    int nM, nN, nwg, G, c;
    __host__ __device__ void init(int M, int N, int G_, int c_) { nM = M / BM; nN = N / BM; nwg = nM * nN; G = G_; c = c_; }
    __host__ __device__ bool next(int i, Unit& u) const {
        const long L = (long)i * G + c; if (L >= nwg) return false;
        int wgid = (int)L; { const int q = nwg / NXCD, r = nwg % NXCD, xcd = wgid % NXCD, off = wgid / NXCD; wgid = (xcd < r ? xcd * (q + 1) : r * (q + 1) + (xcd - r) * q) + off; }
        const int nig = WGM * nN, gid = wgid / nig, fm = gid * WGM, gsz = (nM - fm) < WGM ? (nM - fm) : WGM;
        u.pm = fm + ((wgid % nig) % gsz); u.pn = (wgid % nig) / gsz; return true;
    }
    __device__ __forceinline__ void a_ready(const Unit&) const {}
    __device__ __forceinline__ void done(const Unit&) const {}
};

__device__ __forceinline__ unsigned cvt_pk_bf16(float lo, float hi) { unsigned r; asm volatile("v_cvt_pk_bf16_f32 %0, %1, %2" : "=v"(r) : "v"(lo), "v"(hi)); return r; }
typedef float f32x2 __attribute__((ext_vector_type(2)));
__device__ __forceinline__ f32x2 gelu_pk(f32x2 v) {
    const f32x2 av = __builtin_elementwise_abs(v), d = av * 0.2316418882f + 1.0f;
    f32x2 t; t.x = __builtin_amdgcn_rcpf(d.x); t.y = __builtin_amdgcn_rcpf(d.y);
    f32x2 q = t * 0.5307027145f + (-0.7265760135f); q = q * t + 0.7107068705f; q = q * t + (-0.142248368f); q = q * t + 0.127414796f; q = q * t;
    const f32x2 s = (v * v) * (-0.72134752044f);
    f32x2 e; e.x = __builtin_amdgcn_exp2f(s.x); e.y = __builtin_amdgcn_exp2f(s.y);
    const f32x2 m = v * (q * e), r = v - m;
    f32x2 o; o.x = v.x < 0.f ? m.x : r.x; o.y = v.y < 0.f ? m.y : r.y; return o;
}


struct EpiAct {
    static constexpr bool PERM = true, AFTER_DRAIN = false;
    bf16_t* O; int ldc; int act;
    __device__ __forceinline__ void operator()(const f32x4 (&acc)[2][2][4][2], const Unit& u, int wr, int wc, int fr, int fq) const {
        const int row0 = u.pm * BM + wr * 64 + fr; const int col0 = u.pn * BM + wc * 32 + 8 * fq;
#pragma unroll
        for (int ai = 0; ai < 2; ++ai)
#pragma unroll
            for (int m = 0; m < 4; ++m) { bf16_t* rowp = O + (size_t)(row0 + ai * HALF + m * 16) * ldc + col0;
#pragma unroll
                for (int bj = 0; bj < 2; ++bj) { f32x4 v0 = acc[ai][bj][m][0], v1 = acc[ai][bj][m][1];
                    if (act == 1) { f32x2 a = gelu_pk((f32x2){v0[0], v0[1]}), b = gelu_pk((f32x2){v0[2], v0[3]}), c = gelu_pk((f32x2){v1[0], v1[1]}), d = gelu_pk((f32x2){v1[2], v1[3]});
                        v0 = (f32x4){a.x, a.y, b.x, b.y}; v1 = (f32x4){c.x, c.y, d.x, d.y}; }
                    else if (act == 2) {
#pragma unroll
                        for (int e = 0; e < 4; ++e) { const float a = fmaxf(v0[e], 0.f), b = fmaxf(v1[e], 0.f); v0[e] = a * a; v1[e] = b * b; } }
                    u32x4 w; w.x = cvt_pk_bf16(v0[0], v0[1]); w.y = cvt_pk_bf16(v0[2], v0[3]); w.z = cvt_pk_bf16(v1[0], v1[1]); w.w = cvt_pk_bf16(v1[2], v1[3]);
                    *(u32x4*)(rowp + bj * HALF) = w; } }
    }
};
struct EpiRoute {
    static constexpr bool PERM = true, AFTER_DRAIN = false;
    bf16_t *pool, *q, *k, *v;
    __device__ __forceinline__ void operator()(const f32x4 (&acc)[2][2][4][2], const Unit& u, int wr, int wc, int fr, int fq) const {
        const int pm = u.pm, pn = u.pn; bf16_t* base; int ld, colt; long rowbase;
        if (pm < 64) { const int b = pm >> 4; const long lat = (long)pm * 256, kvrow = (long)b * 4352 + 256 + (pm & 15) * 256;
            if (pn == 0)     { base = pool; ld = 256; colt = 0;              rowbase = lat; }
            else if (pn < 4) { base = q;    ld = 768; colt = (pn - 1) * 256; rowbase = lat; }
            else if (pn < 7) { base = k;    ld = 768; colt = (pn - 4) * 256; rowbase = kvrow; }
            else             { base = v;    ld = 768; colt = (pn - 7) * 256; rowbase = kvrow; }
        } else { const int b = pm - 64; rowbase = (long)b * 4352; ld = 768;
            if (pn < 7) { base = k; colt = (pn - 4) * 256; } else { base = v; colt = (pn - 7) * 256; } }
        const long row0 = rowbase + wr * 64 + fr; const int col0 = colt + wc * 32 + 8 * fq;
#pragma unroll
        for (int ai = 0; ai < 2; ++ai)
#pragma unroll
            for (int m = 0; m < 4; ++m) { bf16_t* rowp = base + (size_t)(row0 + ai * HALF + m * 16) * ld + col0;
#pragma unroll
                for (int bj = 0; bj < 2; ++bj) { const f32x4 v0 = acc[ai][bj][m][0], v1 = acc[ai][bj][m][1];
                    u32x4 w; w.x = cvt_pk_bf16(v0[0], v0[1]); w.y = cvt_pk_bf16(v0[2], v0[3]); w.z = cvt_pk_bf16(v1[0], v1[1]); w.w = cvt_pk_bf16(v1[2], v1[3]);
                    *(u32x4*)(rowp + bj * HALF) = w; } }
    }
};
struct EpiRes {
    static constexpr bool PERM = false, AFTER_DRAIN = false;
    const float* base; float* out; const float* gate;
    __device__ __forceinline__ void operator()(const f32x4 (&acc)[2][2][4][2], const Unit& u, int wr, int wc, int fr, int fq) const {
        const int col0 = u.pn * BM + wc * 32 + 4 * fq; const float* gp = gate + (size_t)(u.pm >> 4) * 6144 + col0;
        f32x4 gv[2][2];
#pragma unroll
        for (int bj = 0; bj < 2; ++bj)
#pragma unroll
            for (int n = 0; n < 2; ++n) gv[bj][n] = *(const f32x4*)(gp + bj * HALF + n * 16);
#pragma unroll
        for (int ai = 0; ai < 2; ++ai)
#pragma unroll
            for (int m = 0; m < 4; ++m) { const size_t off = (size_t)(u.pm * BM + ai * HALF + wr * 64 + m * 16 + fr) * 1024 + col0;
#pragma unroll
                for (int bj = 0; bj < 2; ++bj)
#pragma unroll
                    for (int n = 0; n < 2; ++n) { const f32x4 bs = *(const f32x4*)(base + off + bj * HALF + n * 16);
                        *(f32x4*)(out + off + bj * HALF + n * 16) = bs + gv[bj][n] * acc[ai][bj][m][n]; }
                if (m & 1) asm volatile("" ::: "memory"); }
    }
};
struct OrderQKV {
    StaticOrder so;
    __host__ __device__ void init(int G_, int c_) { so.init(16384, 2560, G_, c_); }
    __host__ __device__ bool next(int i, Unit& u) const {
        const long L = (long)i * so.G + so.c; if (L < so.nwg) return so.next(i, u);
        const int e = (int)(L - so.nwg); if (e >= 24) return false; u.pm = 64 + e / 6; u.pn = 4 + e % 6; return true; }
    __device__ __forceinline__ void a_ready(const Unit&) const {}
    __device__ __forceinline__ void done(const Unit&) const {}
};

template <class Epi, class Sched, bool ALIGN_EPI = false, bool SP2 = false>
__device__ __forceinline__ void gemm_phase(PG8_LAS unsigned char* lds, const Gemm g, const Sched& S, const Epi& E) {
    const int tid = ltid(), wid = __builtin_amdgcn_readfirstlane(tid >> 6), lane = tid & 63, wr = wid >> 2, wc = wid & 3, fr = lane & 15, fq = lane >> 4;
    const int K = g.K, nt = K / BK;
    unsigned voffA[2], voffB[2];
#pragma unroll
    for (int i = 0; i < 2; ++i) { int R, C; stage_rc(tid * 16 + i * 8192, R, C); const int Rb = Epi::PERM ? ((R & ~31) + perm32(R & 31)) : R;
        voffA[i] = (unsigned)(R * K + C) * 2u; voffB[i] = (unsigned)(Rb * K + C) * 2u; }
    const size_t kstep = (size_t)(BK * 2);
    const size_t hstep = (size_t)HALF * K * 2;
    const size_t tstep = 2 * hstep;
    const unsigned ldsw = (unsigned)wid * 1024u;
    const int aoff = lds_byte(wr * 64 + fr, fq * 8), boff = lds_byte(wc * 32 + fr, fq * 8);
#define PG8_SA(b, h) (((b) * 2 + (h)) * HTB)
#define PG8_SB(b, h) ((4 + (b) * 2 + (h)) * HTB)
#define PG8_STAGE(bufoff, gbase, voff) do { _Pragma("unroll") for (int _i = 0; _i < 2; ++_i) \
        __builtin_amdgcn_global_load_lds((const unsigned*)((const char*)(gbase) + (voff)[_i]), (PG8_LAS unsigned*)(lds + (bufoff) + ldsw + _i * 8192), 16, 0, 0); } while (0)
#define PG8_LDA(dst, b, h) do { _Pragma("unroll") for (int m = 0; m < 4; ++m) _Pragma("unroll") for (int k = 0; k < 2; ++k) dst[m][k] = *(const PG8_LAS bf16x8*)(lds + PG8_SA(b, h) + aoff + m * 2048 + k * 1024); } while (0)
#define PG8_LDB(dst, b, h) do { _Pragma("unroll") for (int n = 0; n < 2; ++n) _Pragma("unroll") for (int k = 0; k < 2; ++k) dst[n][k] = *(const PG8_LAS bf16x8*)(lds + PG8_SB(b, h) + boff + n * 2048 + k * 1024); } while (0)
#define PG8_MMA(ai, bj, At, Bt) do { __builtin_amdgcn_s_setprio(1); _Pragma("unroll") for (int m = 0; m < 4; ++m) _Pragma("unroll") for (int n = 0; n < 2; ++n) _Pragma("unroll") for (int k = 0; k < 2; ++k) \
        acc[ai][bj][m][n] = __builtin_amdgcn_mfma_f32_16x16x32_bf16(Bt[n][k], At[m][k], acc[ai][bj][m][n], 0, 0, 0); __builtin_amdgcn_s_setprio(0); } while (0)
#define PG8_WAIT_V(n) asm volatile("s_waitcnt vmcnt(" #n ")" ::: "memory")
#define PG8_WAIT_L(n) asm volatile("s_waitcnt lgkmcnt(" #n ")" ::: "memory")
#define PG8_BAR __builtin_amdgcn_s_barrier()
#define PG8_SCHED __builtin_amdgcn_sched_barrier(0)
    Unit cur, nxt; int ui = 0;
    if (!S.next(0, cur)) return;
    f32x4 acc[2][2][4][2];
#pragma unroll
    for (int a = 0; a < 2; ++a)
#pragma unroll
        for (int b = 0; b < 2; ++b)
#pragma unroll
            for (int m = 0; m < 4; ++m)
#pragma unroll
                for (int n = 0; n < 2; ++n) acc[a][b][m][n] = (f32x4){0.f, 0.f, 0.f, 0.f};
    bf16x8 At[4][2], B0[2][2], B1[2][2];
    const char* cA = (const char*)g.A + (size_t)cur.pm * tstep; const char* cB = (const char*)g.Bt + (size_t)cur.pn * tstep;
    S.a_ready(cur);
    if constexpr (SP2) {
        PG8_STAGE(PG8_SB(0, 0), cB, voffB); PG8_STAGE(PG8_SB(0, 1), cB + hstep, voffB); PG8_STAGE(PG8_SA(0, 0), cA, voffA); PG8_STAGE(PG8_SA(0, 1), cA + hstep, voffA);
        if (wr == 1) PG8_BAR;
        PG8_WAIT_V(2); PG8_BAR;
        PG8_STAGE(PG8_SB(1, 0), cB + kstep, voffB); PG8_STAGE(PG8_SA(1, 0), cA + kstep, voffA); PG8_STAGE(PG8_SB(1, 1), cB + hstep + kstep, voffB);
        PG8_WAIT_V(6); PG8_BAR;
    } else {
        PG8_STAGE(PG8_SB(0, 0), cB, voffB); PG8_STAGE(PG8_SA(0, 0), cA, voffA); PG8_STAGE(PG8_SB(0, 1), cB + hstep, voffB); PG8_STAGE(PG8_SA(0, 1), cA + hstep, voffA);
        if (wr == 1) PG8_BAR;
        PG8_WAIT_V(4); PG8_BAR;
        PG8_STAGE(PG8_SB(1, 0), cB + kstep, voffB); PG8_STAGE(PG8_SA(1, 0), cA + kstep, voffA); PG8_STAGE(PG8_SB(1, 1), cB + hstep + kstep, voffB);
        PG8_WAIT_V(6); PG8_BAR;
    }
    for (;;) {
        const bool has_next = S.next(ui + 1, nxt);
        const char* nA = has_next ? (const char*)g.A + (size_t)nxt.pm * tstep : cA; const char* nB = has_next ? (const char*)g.Bt + (size_t)nxt.pn * tstep : cB;
        for (int t = 0; t < nt; t += 2) {
            const bool last = (t == nt - 2);
            const char* a1 = cA + (size_t)(t + 1) * kstep;
            const char* a2 = last ? nA : cA + (size_t)(t + 2) * kstep; const char* b2 = last ? nB : cB + (size_t)(t + 2) * kstep;
            const char* a3 = a2 + kstep; const char* b3 = b2 + kstep;
            if (last && has_next) S.a_ready(nxt);
            if constexpr (SP2) {
            PG8_LDB(B0, 0, 0); PG8_LDB(B1, 0, 1); PG8_SCHED; PG8_LDA(At, 0, 0); PG8_STAGE(PG8_SA(1, 1), a1 + hstep, voffA);
            PG8_WAIT_V(8); PG8_WAIT_L(0); PG8_BAR; PG8_MMA(0, 0, At, B0); PG8_MMA(0, 1, At, B1); PG8_BAR; PG8_SCHED;
            PG8_LDA(At, 0, 1); PG8_STAGE(PG8_SB(0, 0), b2, voffB); PG8_STAGE(PG8_SB(0, 1), b2 + hstep, voffB); PG8_STAGE(PG8_SA(0, 0), a2, voffA);
            PG8_WAIT_V(8); PG8_WAIT_L(0); PG8_BAR; PG8_MMA(1, 0, At, B0); PG8_MMA(1, 1, At, B1); PG8_BAR; PG8_SCHED;
            PG8_LDB(B0, 1, 0); PG8_LDB(B1, 1, 1); PG8_SCHED; PG8_LDA(At, 1, 0); PG8_STAGE(PG8_SA(0, 1), a2 + hstep, voffA);
            PG8_WAIT_V(8); PG8_WAIT_L(0); PG8_BAR; PG8_MMA(0, 0, At, B0); PG8_MMA(0, 1, At, B1); PG8_BAR; PG8_SCHED;
            PG8_LDA(At, 1, 1); PG8_STAGE(PG8_SB(1, 0), b3, voffB); PG8_STAGE(PG8_SB(1, 1), b3 + hstep, voffB); PG8_STAGE(PG8_SA(1, 0), a3, voffA);
            PG8_WAIT_V(8); PG8_WAIT_L(0); PG8_BAR; PG8_MMA(1, 0, At, B0); PG8_MMA(1, 1, At, B1); PG8_BAR; PG8_SCHED;
            } else {
            PG8_LDB(B0, 0, 0); PG8_SCHED; PG8_LDA(At, 0, 0); PG8_STAGE(PG8_SA(1, 1), a1 + hstep, voffA);
            PG8_WAIT_L(8); PG8_BAR; PG8_WAIT_L(0); PG8_MMA(0, 0, At, B0); PG8_BAR; PG8_SCHED;
            PG8_LDB(B1, 0, 1); PG8_STAGE(PG8_SB(0, 0), b2, voffB);
            PG8_BAR; PG8_WAIT_L(0); PG8_MMA(0, 1, At, B1); PG8_BAR;
            PG8_LDA(At, 0, 1); PG8_STAGE(PG8_SA(0, 0), a2, voffA);
            PG8_BAR; PG8_WAIT_L(0); PG8_MMA(1, 0, At, B0); PG8_BAR; PG8_SCHED;
            PG8_STAGE(PG8_SB(0, 1), b2 + hstep, voffB);
            PG8_WAIT_V(6); PG8_BAR; PG8_MMA(1, 1, At, B1); PG8_BAR;
            PG8_LDB(B0, 1, 0); PG8_SCHED; PG8_LDA(At, 1, 0); PG8_STAGE(PG8_SA(0, 1), a2 + hstep, voffA);
            PG8_WAIT_L(8); PG8_BAR; PG8_WAIT_L(0); PG8_MMA(0, 0, At, B0); PG8_BAR; PG8_SCHED;
            PG8_LDB(B1, 1, 1); PG8_STAGE(PG8_SB(1, 0), b3, voffB);
            PG8_BAR; PG8_WAIT_L(0); PG8_MMA(0, 1, At, B1); PG8_BAR;
            PG8_LDA(At, 1, 1); PG8_STAGE(PG8_SA(1, 0), a3, voffA);
            PG8_BAR; PG8_WAIT_L(0); PG8_MMA(1, 0, At, B0); PG8_BAR; PG8_SCHED;
            PG8_STAGE(PG8_SB(1, 1), b3 + hstep, voffB);
            PG8_WAIT_V(6); PG8_BAR; PG8_MMA(1, 1, At, B1); PG8_BAR;
            }
        }
        if constexpr (ALIGN_EPI) { if (wr == 0) PG8_BAR; }
        if constexpr (!Epi::AFTER_DRAIN) { E(acc, cur, wr, wc, fr, fq); S.done(cur); }
        if (!has_next) break;
#pragma unroll
        for (int a = 0; a < 2; ++a)
#pragma unroll
            for (int b = 0; b < 2; ++b)
#pragma unroll
                for (int m = 0; m < 4; ++m)
#pragma unroll
                    for (int n = 0; n < 2; ++n) acc[a][b][m][n] = (f32x4){0.f, 0.f, 0.f, 0.f};
        cur = nxt; cA = nA; cB = nB; ++ui;
        if constexpr (ALIGN_EPI) { if (wr == 1) PG8_BAR; }
    }
    PG8_WAIT_V(0);
    if constexpr (!ALIGN_EPI) { if (wr == 0) PG8_BAR; }
    PG8_BAR;
    if constexpr (Epi::AFTER_DRAIN) { E.fused(acc, cur, wr, wc, fr, fq, lds, wid, lane); S.done(cur); }
#undef PG8_SA
#undef PG8_SB
#undef PG8_STAGE
#undef PG8_LDA
#undef PG8_LDB
#undef PG8_MMA
#undef PG8_WAIT_V
#undef PG8_WAIT_L
#undef PG8_BAR
#undef PG8_SCHED
}
}

namespace att {
using bf16x8 = __attribute__((ext_vector_type(8))) short;
using s16x4  = __attribute__((ext_vector_type(4))) short;
using f32x16 = __attribute__((ext_vector_type(16))) float;
using u32x4  = __attribute__((ext_vector_type(4))) unsigned;
typedef unsigned short bf16;
constexpr int NW = 8, QBLK = 32, KVBLK = 64, LDQ = 768, LDK = 768, LDY = 1024, SEQK = 4352;
constexpr float SCALE = 0.125f, THR = 8.f;
constexpr int SDEPTH = 2;
constexpr size_t SHM_V = KVBLK * 128 * 2, SHM_K = KVBLK * 128 * 2, SHM_ATTN = 2 * SHM_V + 2 * SHM_K + NW * 64 * 4;
#define KSWZ(row, colB) ((row) * 256 + ((colB) ^ (((row) & 7) << 4)))
#define SBAR() __builtin_amdgcn_sched_barrier(0)
__device__ __forceinline__ int crow(int r, int hi) { return (r & 3) + 8 * (r >> 2) + 4 * hi; }
__device__ __forceinline__ unsigned cvtpk(float lo, float hi) { unsigned r; asm volatile("v_cvt_pk_bf16_f32 %0, %1, %2" : "=v"(r) : "v"(lo), "v"(hi)); return r; }
__device__ __forceinline__ unsigned short f2bf(float f) { unsigned u = __builtin_bit_cast(unsigned, f); return (unsigned short)((u + 0x7fffu + ((u >> 16) & 1u)) >> 16); }

__device__ __forceinline__ void partialSM(f32x16& p0, f32x16& p1, float& m_reg, float& mn, float& alpha) {
  constexpr float C = SCALE * 1.4426950408889634f;
  float pmax = p0[0];
#pragma unroll
  for (int r = 1; r < 16; ++r) pmax = fmaxf(pmax, p0[r]);
#pragma unroll
  for (int r = 0; r < 16; ++r) pmax = fmaxf(pmax, p1[r]);
  { auto rr = __builtin_amdgcn_permlane32_swap(__float_as_uint(pmax), __float_as_uint(pmax), false, false);
    pmax = fmaxf(__uint_as_float(rr[0]), __uint_as_float(rr[1])); }
  if (__builtin_expect(__all(pmax - m_reg <= THR / SCALE), 1)) { mn = m_reg; alpha = 1.f; }
  else { mn = fmaxf(m_reg, pmax); alpha = __builtin_amdgcn_exp2f((m_reg - mn) * C); m_reg = mn; }
  float mnC = -mn * C;
#pragma unroll
  for (int r = 0; r < 16; ++r) p0[r] = fmaf(p0[r], C, mnC);
#pragma unroll
  for (int r = 0; r < 16; ++r) p1[r] = fmaf(p1[r], C, mnC);
#pragma unroll
  for (int r = 0; r < 16; ++r) p0[r] = __builtin_amdgcn_exp2f(p0[r]);
}
__device__ __forceinline__ void finishSM(f32x16& p0, f32x16& p1, float alpha, float& l_reg, bf16x8& pa0, bf16x8& pa1, bf16x8& pa2, bf16x8& pa3) {
#pragma unroll
  for (int r = 0; r < 16; ++r) p1[r] = __builtin_amdgcn_exp2f(p1[r]);
  float ps = 0;
#pragma unroll
  for (int r = 0; r < 16; ++r) ps += p0[r];
#pragma unroll
  for (int r = 0; r < 16; ++r) ps += p1[r];
  { auto rr = __builtin_amdgcn_permlane32_swap(__float_as_uint(ps), __float_as_uint(ps), false, false);
    ps = __uint_as_float(rr[0]) + __uint_as_float(rr[1]); }
  l_reg = l_reg * alpha + ps;
#define PK4(P, BASE, OUT) do { unsigned a0 = cvtpk(P[BASE + 0], P[BASE + 1]), a1 = cvtpk(P[BASE + 2], P[BASE + 3]);   \
    unsigned b0 = cvtpk(P[BASE + 4], P[BASE + 5]), b1 = cvtpk(P[BASE + 6], P[BASE + 7]);                              \
    auto r0 = __builtin_amdgcn_permlane32_swap(a0, b0, false, false); auto r1 = __builtin_amdgcn_permlane32_swap(a1, b1, false, false); \
    u32x4 w = {r0[0], r1[0], r0[1], r1[1]}; OUT = *reinterpret_cast<bf16x8*>(&w); } while (0)
  PK4(p0, 0, pa0); PK4(p0, 8, pa1); PK4(p1, 0, pa2); PK4(p1, 8, pa3);
#undef PK4
}
__device__ __forceinline__ void qkt(f32x16& p0, f32x16& p1, const bf16* Ks, const bf16x8* qr, int r32, int hi, int comp) {
  p0 = f32x16{}; p1 = f32x16{};
#pragma unroll
  for (int d0 = 0; d0 < 4; ++d0) { int cb = (comp * 64 + d0 * 16 + hi * 8) * 2;
    bf16x8 b0 = *reinterpret_cast<const bf16x8*>((const char*)Ks + KSWZ(r32, cb));
    bf16x8 b1 = *reinterpret_cast<const bf16x8*>((const char*)Ks + KSWZ(32 + r32, cb));
    p0 = __builtin_amdgcn_mfma_f32_32x32x16_bf16(b0, qr[d0], p0, 0, 0, 0);
    p1 = __builtin_amdgcn_mfma_f32_32x32x16_bf16(b1, qr[d0], p1, 0, 0, 0); }
}
__device__ __forceinline__ int v_st(int k, int c) { const int kk = (k & ~0xC) | ((k & 4) << 1) | ((k & 8) >> 1); return ((kk >> 3) * 4 + (c >> 5)) * 512 + ((kk & 7) * 32 + (c & 31)) * 2; }
__device__ __forceinline__ int v_rd_base(int lane) { return ((lane & 3) << 3) | (((lane >> 2) & 3) << 6) | (((lane >> 4) & 1) << 5) | (((lane >> 5) & 1) << 8); }
constexpr int v_rd_off(int d0, int ks, int half) { return d0 * 512 + ks * 4096 + half * 2048; }
template <int OFF> __device__ __forceinline__ s16x4 tr_read(int vb) {
  s16x4 r; asm volatile("ds_read_b64_tr_b16 %0, %1 offset:%2" : "=&v"(r) : "v"(vb), "i"(OFF) : "memory"); return r;
}
template <int D0> __device__ __forceinline__ void pv_one(f32x16& od, int vb, bf16x8 pa0, bf16x8 pa1, bf16x8 pa2, bf16x8 pa3) {
  const s16x4 l0 = tr_read<v_rd_off(D0, 0, 0)>(vb), h0 = tr_read<v_rd_off(D0, 0, 1)>(vb), l1 = tr_read<v_rd_off(D0, 1, 0)>(vb), h1 = tr_read<v_rd_off(D0, 1, 1)>(vb);
  const s16x4 l2 = tr_read<v_rd_off(D0, 2, 0)>(vb), h2 = tr_read<v_rd_off(D0, 2, 1)>(vb), l3 = tr_read<v_rd_off(D0, 3, 0)>(vb), h3 = tr_read<v_rd_off(D0, 3, 1)>(vb);
  asm volatile("s_waitcnt lgkmcnt(0)" ::: "memory"); SBAR();
#define PK(L, H) (bf16x8){L[0], L[1], L[2], L[3], H[0], H[1], H[2], H[3]}
  od = __builtin_amdgcn_mfma_f32_32x32x16_bf16(pa0, PK(l0, h0), od, 0, 0, 0);
  od = __builtin_amdgcn_mfma_f32_32x32x16_bf16(pa1, PK(l1, h1), od, 0, 0, 0);
  od = __builtin_amdgcn_mfma_f32_32x32x16_bf16(pa2, PK(l2, h2), od, 0, 0, 0);
  od = __builtin_amdgcn_mfma_f32_32x32x16_bf16(pa3, PK(l3, h3), od, 0, 0, 0);
#undef PK
}
__device__ __forceinline__ void pv_d0(f32x16* o, int vb, bf16x8 pa0, bf16x8 pa1, bf16x8 pa2, bf16x8 pa3) {
  pv_one<0>(o[0], vb, pa0, pa1, pa2, pa3); pv_one<1>(o[1], vb, pa0, pa1, pa2, pa3); pv_one<2>(o[2], vb, pa0, pa1, pa2, pa3); pv_one<3>(o[3], vb, pa0, pa1, pa2, pa3);
}

__device__ __forceinline__ void attn_unit(const bf16* __restrict__ Qb, const bf16* __restrict__ Kh, const bf16* __restrict__ Vh, bf16* __restrict__ Yb,
                                          const float* __restrict__ subg, float lam, char* lds) {
  const int tid = ltid(), wid = tid >> 6, lane = tid & 63, r32 = lane & 31, hi = lane >> 5;
  const int comp = wid >> 2, wq = wid & 3;
  bf16* V_lds = (bf16*)lds; bf16* K_lds = (bf16*)(lds + 2 * SHM_V);
  float* ws = (float*)(lds + 2 * SHM_V + 2 * SHM_K) + wid * 64; float* li_l = ws; float* al_l = ws + 32;
  float m_reg = -1e30f, l_reg = 0; f32x16 o[4] = {}; bf16x8 qr[4];
  const bf16* Qw = Qb + (long)(wq * QBLK + r32) * LDQ + comp * 64 + hi * 8;
#pragma unroll
  for (int d0 = 0; d0 < 4; ++d0) qr[d0] = *reinterpret_cast<const bf16x8*>(Qw + d0 * 16);
  const int sr = tid >> 4, sc = (tid & 15) * 8, vst0 = v_st(sr, sc), vst1 = v_st(32 + sr, sc);
  const int vb0 = (int)(uintptr_t)V_lds + v_rd_base(lane);
  struct { bf16x8 vs0, vs1, ks0, ks1; } sr_[SDEPTH];
#define SLOAD(i, k0) do { sr_[i].vs0 = *reinterpret_cast<const bf16x8*>(&Vh[(long)((k0) + sr) * LDK + sc]); sr_[i].vs1 = *reinterpret_cast<const bf16x8*>(&Vh[(long)((k0) + 32 + sr) * LDK + sc]); \
    sr_[i].ks0 = *reinterpret_cast<const bf16x8*>(&Kh[(long)((k0) + sr) * LDK + sc]); sr_[i].ks1 = *reinterpret_cast<const bf16x8*>(&Kh[(long)((k0) + 32 + sr) * LDK + sc]); } while (0)
#define SWRITE(b, i) do { *(bf16x8*)((char*)V_lds + (b) * SHM_V + vst0) = sr_[i].vs0;          \
    *(bf16x8*)((char*)V_lds + (b) * SHM_V + vst1) = sr_[i].vs1; int kc = sc * 2;               \
    *(bf16x8*)((char*)K_lds + (b) * SHM_K + KSWZ(sr, kc)) = sr_[i].ks0;                       \
    *(bf16x8*)((char*)K_lds + (b) * SHM_K + KSWZ(32 + sr, kc)) = sr_[i].ks1; } while (0)
#define SWAIT() do { asm volatile("s_waitcnt vmcnt(4)" ::: "memory"); } while (0)
#define RESC(a) do { if (__any((a) < 1.f)) { if (hi == 0) al_l[r32] = (a); asm volatile("s_waitcnt lgkmcnt(0)" ::: "memory"); \
    _Pragma("unroll") for (int d = 0; d < 4; ++d) _Pragma("unroll") for (int r = 0; r < 16; ++r) o[d][r] *= al_l[crow(r, hi)]; } } while (0)
  f32x16 pA0, pA1, pB0, pB1; float mnA, mnB, alA, alB; bf16x8 pa0, pa1, pa2, pa3; constexpr int NT = SEQK / KVBLK;
  constexpr int SE = 0, SO = SDEPTH - 1;
  SLOAD(SE, 0); asm volatile("s_waitcnt vmcnt(0)" ::: "memory"); SWRITE(0, SE); __syncthreads();
  qkt(pA0, pA1, K_lds, qr, r32, hi, comp); partialSM(pA0, pA1, m_reg, mnA, alA);
  SLOAD(SO, KVBLK); if (2 < NT) SLOAD(SE, 2 * KVBLK);
  SWAIT(); SWRITE(1, SO); __syncthreads();
  for (int j = 1; j + 1 < NT; j += 2) {
    SBAR(); qkt(pB0, pB1, (bf16*)((char*)K_lds + SHM_K), qr, r32, hi, comp);
    finishSM(pA0, pA1, alA, l_reg, pa0, pa1, pa2, pa3); SBAR();
    SLOAD(SO, (j + SDEPTH) * KVBLK); SBAR();
    pv_d0(o, vb0, pa0, pa1, pa2, pa3); partialSM(pB0, pB1, m_reg, mnB, alB);
    __syncthreads(); SWAIT(); SWRITE(0, SE);
    RESC(alB); __syncthreads();
    SBAR(); qkt(pA0, pA1, K_lds, qr, r32, hi, comp);
    finishSM(pB0, pB1, alB, l_reg, pa0, pa1, pa2, pa3); SBAR();
    if (j + 3 < NT) SLOAD(SE, (j + 1 + SDEPTH) * KVBLK); SBAR();
    pv_d0(o, vb0 + (int)SHM_V, pa0, pa1, pa2, pa3); partialSM(pA0, pA1, m_reg, mnA, alA);
    __syncthreads(); SWAIT(); SWRITE(1, SO);
    RESC(alA); __syncthreads();
  }
  SBAR(); qkt(pB0, pB1, (bf16*)((char*)K_lds + SHM_K), qr, r32, hi, comp);
  finishSM(pA0, pA1, alA, l_reg, pa0, pa1, pa2, pa3); SBAR();
  pv_d0(o, vb0, pa0, pa1, pa2, pa3); partialSM(pB0, pB1, m_reg, mnB, alB);
  __syncthreads(); RESC(alB);
  finishSM(pB0, pB1, alB, l_reg, pa0, pa1, pa2, pa3); SBAR();
  pv_d0(o, vb0 + (int)SHM_V, pa0, pa1, pa2, pa3);
  if (hi == 0) li_l[r32] = l_reg; asm volatile("s_waitcnt lgkmcnt(0)" ::: "memory");
  float rli[16];
#pragma unroll
  for (int r = 0; r < 16; ++r) rli[r] = __builtin_amdgcn_rcpf(li_l[crow(r, hi)]);
  __syncthreads();
  float* X = (float*)lds + wq * 4096;
  if (comp == 1) {
#pragma unroll
    for (int d0 = 0; d0 < 4; ++d0)
#pragma unroll
      for (int r = 0; r < 16; ++r) X[(d0 * 16 + r) * 64 + lane] = o[d0][r] * rli[r] * lam;
  }
  __syncthreads();
  if (comp == 0) {
    float ss[16];
#pragma unroll
    for (int r = 0; r < 16; ++r) ss[r] = 0.f;
#pragma unroll
    for (int d0 = 0; d0 < 4; ++d0)
#pragma unroll
      for (int r = 0; r < 16; ++r) { const float d = o[d0][r] * rli[r] - X[(d0 * 16 + r) * 64 + lane]; o[d0][r] = d; ss[r] += d * d; }
#pragma unroll
    for (int r = 0; r < 16; ++r) {
#pragma unroll
      for (int off = 1; off < 32; off <<= 1) ss[r] += __shfl_xor(ss[r], off);
    }
    float g4[4];
#pragma unroll
    for (int d0 = 0; d0 < 4; ++d0) g4[d0] = subg[d0 * 32 + r32] * 0.8f;
#pragma unroll
    for (int r = 0; r < 16; ++r) { const float rs = rsqrtf(ss[r] * (1.f / 128.f) + 1e-6f); bf16* yrow = Yb + (long)(wq * QBLK + crow(r, hi)) * LDY;
#pragma unroll
      for (int d0 = 0; d0 < 4; ++d0) yrow[d0 * 32 + r32] = f2bf(o[d0][r] * rs * g4[d0]); }
  }
  __syncthreads();
#undef SLOAD
#undef SWRITE
#undef SWAIT
#undef RESC
}
#undef SBAR
}


#ifndef MK_DEBUG
#define MK_DEBUG 0
#endif
#ifndef MK_SIMPLE6
#define MK_SIMPLE6 0
#endif
#ifndef NPH_RUN
#define NPH_RUN 16
#endif
#ifndef PHMASK
#define PHMASK 0xFFFF
#endif
#define PHM(k) ((PHMASK >> (k)) & 1)
#ifndef MK_MULTI
#define MK_MULTI 0
#endif
#define LAS __attribute__((address_space(3)))
#define GAS __attribute__((address_space(1)))
typedef unsigned short bf16;
typedef unsigned v4u __attribute__((ext_vector_type(4)));
typedef unsigned v2u __attribute__((ext_vector_type(2)));
typedef float f32x4 __attribute__((ext_vector_type(4)));
typedef short bf16x8 __attribute__((ext_vector_type(8)));
typedef float f32x16 __attribute__((ext_vector_type(16)));
#define LDS_WAIT() asm volatile("s_waitcnt lgkmcnt(0)" ::: "memory")
constexpr int NWAVES = 8, NTHR = 512, NPH = 16;
constexpr int SEQ = 4096, DM = 1024, MTOK = 16384, TKV = 4352, FF = 4096, MODW = 6144;
constexpr size_t MiB = 1u << 20;
constexpr size_t WS_MOD = 1 * MiB, WS_WIN = 2 * MiB, WS_WOUT = 7 * MiB, WS_W1 = 9 * MiB, WS_W2 = 25 * MiB, WS_ODIN = 41 * MiB, WS_ODOUT = 49 * MiB;
constexpr size_t WS_XN = 56 * MiB;
constexpr size_t WS_Q = 92 * MiB, WS_K = 116 * MiB, WS_V = 142 * MiB, WS_POOL = 168 * MiB, WS_Y = 176 * MiB;
constexpr size_t WS_HB = 92 * MiB;
constexpr size_t WS_U = 92 * MiB, WS_VT = 156 * MiB;
constexpr size_t WS_END = 220 * MiB;
constexpr int LDS_BYTES = 147456;

__device__ __forceinline__ unsigned f2bf(float f) { unsigned u = __builtin_bit_cast(unsigned, f); return (u + 0x7fffu + ((u >> 16) & 1u)) >> 16; }
__device__ __forceinline__ unsigned pk2(float lo, float hi) { return f2bf(lo) | (f2bf(hi) << 16); }
__device__ __forceinline__ float bflo(unsigned w) { return __builtin_bit_cast(float, w << 16); }
__device__ __forceinline__ float bfhi(unsigned w) { return __builtin_bit_cast(float, w & 0xffff0000u); }
__device__ __forceinline__ float wave_sum(float v) {
#pragma unroll
    for (int o = 1; o < 64; o <<= 1) v += __shfl_xor(v, o);
    return v;
}

struct Args { const float* in[27]; float* out; unsigned char* ws; int ph_lo, ph_hi; };

__device__ __forceinline__ void p0_transpose_item(const float* W, int K, int N, bf16* WT, LAS float* scr, int item, int lane) {
    const int nblk = N / 32, kb = item / nblk, nb = item % nblk, k0 = 64 * kb, n0 = 32 * nb;
#pragma unroll 8
    for (int i = 0; i < 32; ++i) { const int kk = 2 * i + (lane >> 5); scr[kk * 33 + (lane & 31)] = W[(size_t)(k0 + kk) * N + n0 + (lane & 31)]; }
    LDS_WAIT(); asm volatile("" ::: "memory");
    const int c = lane & 7;
#pragma unroll
    for (int j = 0; j < 4; ++j) { const int n = (lane >> 3) + 8 * j; const LAS float* s = scr + (8 * c) * 33 + n;
        v4u o; o.x = pk2(s[0 * 33], s[1 * 33]); o.y = pk2(s[2 * 33], s[3 * 33]); o.z = pk2(s[4 * 33], s[5 * 33]); o.w = pk2(s[6 * 33], s[7 * 33]);
        *(v4u*)(WT + (size_t)(n0 + n) * K + k0 + 8 * c) = o; }
    LDS_WAIT(); asm volatile("" ::: "memory");
}
__device__ __forceinline__ void p0_prep(const Args& a, unsigned char* ldsg, int vcu, int G) {
    LAS unsigned char* lds = (LAS unsigned char*)ldsg;
    const int tid = ltid(), lane = tid & 63, wave = tid >> 6;
    float* mod = (float*)(a.ws + WS_MOD);
    for (int item = blockIdx.x; item < 192; item += G) {
        LAS float* sin_ = (LAS float*)lds;
        for (int i = tid; i < 5 * 1024; i += NTHR) { const int r = i >> 10, k = i & 1023; const float c = r < 4 ? a.in[1][r * 1024 + k] : a.in[3][k]; sin_[i] = c / (1.f + __expf(-c)); }
        __syncthreads();
        const int l = item / 96, cb = item % 96;
        const float* W = a.in[4] + (size_t)l * 1024 * MODW + cb * 64 + lane;
        float acc[5] = {0.f, 0.f, 0.f, 0.f, 0.f};
        const int k0 = wave * 128;
#pragma unroll 8
        for (int kk = 0; kk < 128; ++kk) { const int k = k0 + kk; const float w = W[(size_t)k * MODW];
#pragma unroll
            for (int r = 0; r < 5; ++r) acc[r] += sin_[r * 1024 + k] * w; }
        LAS float* red = (LAS float*)(lds + 20480);
#pragma unroll
        for (int r = 0; r < 5; ++r) red[(wave * 5 + r) * 64 + lane] = acc[r];
        __syncthreads();
        if (tid < 320) { const int r = tid >> 6, col = tid & 63; float s = 0.f;
#pragma unroll
            for (int w = 0; w < 8; ++w) s += red[(w * 5 + r) * 64 + col];
            s += a.in[5][l * MODW + cb * 64 + col]; mod[(size_t)(l * 5 + r) * MODW + cb * 64 + col] = s; }
        __syncthreads();
    }
    LAS float* scr = (LAS float*)(lds + 32768 + wave * 8448);
    const int gw = vcu * NWAVES + wave, NGW = G * NWAVES;
    constexpr int I_WIN = 16 * 80, I_WOUT = 16 * 32, I_W1 = 16 * 128, I_W2 = 64 * 32, I_ODIN = 16 * 128, I_ODOUT = 32 * 32;
    constexpr int NITEMS = I_WIN + I_WOUT + 2 * I_W1 + 2 * I_W2 + I_ODIN + I_ODOUT;
    for (int it = gw; it < NITEMS; it += NGW) {
        int r = it;
        if (r < I_WIN) { p0_transpose_item(a.in[10], 1024, 2560, (bf16*)(a.ws + WS_WIN), scr, r, lane); continue; } r -= I_WIN;
        if (r < I_WOUT) { p0_transpose_item(a.in[11], 1024, 1024, (bf16*)(a.ws + WS_WOUT), scr, r, lane); continue; } r -= I_WOUT;
        if (r < 2 * I_W1) { const int l = r / I_W1; p0_transpose_item(a.in[8] + (size_t)l * 1024 * 4096, 1024, 4096, (bf16*)(a.ws + WS_W1) + (size_t)l * 4096 * 1024, scr, r % I_W1, lane); continue; } r -= 2 * I_W1;
        if (r < 2 * I_W2) { const int l = r / I_W2; p0_transpose_item(a.in[9] + (size_t)l * 4096 * 1024, 4096, 1024, (bf16*)(a.ws + WS_W2) + (size_t)l * 1024 * 4096, scr, r % I_W2, lane); continue; } r -= 2 * I_W2;
        if (r < I_ODIN) { p0_transpose_item(a.in[21], 1024, 4096, (bf16*)(a.ws + WS_ODIN), scr, r, lane); continue; } r -= I_ODIN;
        p0_transpose_item(a.in[26], 2048, 1024, (bf16*)(a.ws + WS_ODOUT), scr, r, lane);
    }
}

__device__ __forceinline__ void norm_row(const float* xrow, bf16* orow, const f32x4 (&gs)[4], const f32x4 (&sh)[4], int lane) {
    const f32x4* xr = (const f32x4*)xrow + lane;
    f32x4 v[4]; float s2 = 0.f;
#pragma unroll
    for (int j = 0; j < 4; ++j) { v[j] = xr[64 * j]; s2 += (v[j].x * v[j].x + v[j].y * v[j].y) + (v[j].z * v[j].z + v[j].w * v[j].w); }
    const float rstd = rsqrtf(wave_sum(s2) * (1.f / 1024.f) + 1e-6f);
    unsigned long long* o8 = (unsigned long long*)orow + lane;
#pragma unroll
    for (int j = 0; j < 4; ++j) { const f32x4 y = v[j] * rstd * gs[j] + sh[j];
        o8[64 * j] = (unsigned long long)pk2(y.x, y.y) | ((unsigned long long)pk2(y.z, y.w) << 32); }
}
__device__ __forceinline__ void load_mod(const float* g, const float* shp, const float* scp, f32x4 (&gs)[4], f32x4 (&sh)[4], int lane) {
#pragma unroll
    for (int j = 0; j < 4; ++j) { const int idx = 4 * lane + 256 * j; const f32x4 gv = *(const f32x4*)(g + idx), sv = *(const f32x4*)(scp + idx); gs[j] = gv * (sv + 1.0f); sh[j] = *(const f32x4*)(shp + idx); }
}
__device__ __forceinline__ void norm_phase(const float* src, const float* g, const float* modl, int sh_off, int sc_off, bf16* dst, const float* ctx, int vcu, int G) {
    const int tid = ltid(), lane = tid & 63, wave = tid >> 6;
    for (int rb = vcu; rb < 256; rb += G) {
        const int b = rb >> 6; f32x4 gs[4], sh[4];
        load_mod(g, modl + (size_t)b * MODW + sh_off, modl + (size_t)b * MODW + sc_off, gs, sh, lane);
        for (int rr = 0; rr < 8; ++rr) { const size_t row = (size_t)rb * 64 + wave * 8 + rr; norm_row(src + row * 1024, dst + row * 1024, gs, sh, lane); }
        if (ctx && wave < 4) {
            load_mod(g, modl + (size_t)4 * MODW + sh_off, modl + (size_t)4 * MODW + sc_off, gs, sh, lane);
            const size_t row = (size_t)rb * 4 + wave; norm_row(ctx + row * 1024, dst + ((size_t)MTOK + row) * 1024, gs, sh, lane);
        }
    }
}

__device__ __forceinline__ void qknorm_pool_phase(const Args& a, unsigned char* lds, int vcu, int G) {
    const int tid = ltid(), lane = tid & 63, wave = tid >> 6;
    float2* tab = (float2*)lds;
    for (int i = tid; i < 1024; i += NTHR) { const int pos = i >> 4, f = i & 15; const float inv = powf(10000.0f, -(float)f / 16.0f); const float ang = (float)pos * inv; float s, c; sincosf(ang, &s, &c); tab[i] = make_float2(c, s); }
    __syncthreads();
    bf16* Q = (bf16*)(a.ws + WS_Q); bf16* KA = (bf16*)(a.ws + WS_K);
    const float* qg = a.in[14]; const float* kg = a.in[15];
    constexpr int NGQ = MTOK * 12, NGC = 1024 * 12, NITEM = (2 * NGQ + NGC) * 8;
    const int part = tid & 7;
    for (int idx = vcu * NTHR + tid; idx < NITEM; idx += G * NTHR) {
        int gi = idx >> 3; bf16* p; const float* gam; bool rope = true; int t = 0;
        if (gi < NGQ) { const int row = gi / 12, hg = gi - row * 12; p = Q + (size_t)row * 768 + hg * 64; gam = qg; t = row & 4095; }
        else if (gi < 2 * NGQ) { gi -= NGQ; const int row = gi / 12, hg = gi - row * 12; t = row & 4095; p = KA + ((size_t)(row >> 12) * TKV + 256 + t) * 768 + hg * 64; gam = kg; }
        else { gi -= 2 * NGQ; const int row = gi / 12, hg = gi - row * 12; p = KA + ((size_t)(row >> 8) * TKV + (row & 255)) * 768 + hg * 64; gam = kg; rope = false; }
        p += part * 8;
        const v4u w = *(const v4u*)p; float x[8];
        x[0] = bflo(w.x); x[1] = bfhi(w.x); x[2] = bflo(w.y); x[3] = bfhi(w.y); x[4] = bflo(w.z); x[5] = bfhi(w.z); x[6] = bflo(w.w); x[7] = bfhi(w.w);
        float ss = 0.f;
#pragma unroll
        for (int e = 0; e < 8; ++e) ss += x[e] * x[e];
        ss += __shfl_xor(ss, 1); ss += __shfl_xor(ss, 2); ss += __shfl_xor(ss, 4);
        const float rstd = rsqrtf(ss * (1.f / 64.f) + 1e-6f);
        const f32x4 g0 = *(const f32x4*)(gam + part * 8), g1 = *(const f32x4*)(gam + part * 8 + 4);
        x[0] *= rstd * g0.x; x[1] *= rstd * g0.y; x[2] *= rstd * g0.z; x[3] *= rstd * g0.w; x[4] *= rstd * g1.x; x[5] *= rstd * g1.y; x[6] *= rstd * g1.z; x[7] *= rstd * g1.w;
        if (rope) { const int pos = part < 4 ? (t >> 6) : (t & 63); const float2* tp = tab + pos * 16 + (part & 3) * 4;
#pragma unroll
            for (int pr = 0; pr < 4; ++pr) { const float2 cs = tp[pr]; const float x0 = x[2 * pr], x1 = x[2 * pr + 1]; x[2 * pr] = x0 * cs.x - x1 * cs.y; x[2 * pr + 1] = x0 * cs.y + x1 * cs.x; } }
        v4u o; o.x = pk2(x[0], x[1]); o.y = pk2(x[2], x[3]); o.z = pk2(x[4], x[5]); o.w = pk2(x[6], x[7]);
        *(v4u*)p = o;
    }
    bf16* in_ = (bf16*)(lds + 8192);
    float* pooled = (float*)(lds + 8192 + 40960);
    const bf16* PI = (const bf16*)(a.ws + WS_POOL); bf16* Y = (bf16*)(a.ws + WS_Y);
    const float* pw = a.in[12]; const float* pscale = a.in[13];
    for (int tb = vcu; tb < 256; tb += G) {
        const int b = tb >> 6, t0 = (tb & 63) * 64;
        __syncthreads();
#pragma unroll
        for (int ps = 0; ps < 5; ++ps) { const int row = ps * 16 + (tid >> 5), c8 = (tid & 31) * 8, t = t0 - 8 + row;
            v4u w = {0u, 0u, 0u, 0u}; if (t >= 0 && t < SEQ) w = *(const v4u*)(PI + ((size_t)b * SEQ + t) * 256 + c8);
            *(v4u*)(in_ + row * 256 + c8) = w; }
        __syncthreads();
        { const int c = tid & 255, th = tid >> 8, hw = 1 << (c >> 6);
            for (int tt = 0; tt < 32; ++tt) { const int tl = th * 32 + tt, t = t0 + tl; const int lo = max(t - hw, 0), hi = min(t + hw, SEQ);
                float s = 0.f; for (int j = lo; j < hi; ++j) s += bflo((unsigned)in_[(j - t0 + 8) * 256 + c]);
                pooled[tl * 256 + c] = s / (float)(hi - lo) - bflo((unsigned)in_[(tl + 8) * 256 + c]); } }
        __syncthreads();
        { const int gi = wave & 3, th = wave >> 2; float pwr[64];
#pragma unroll
            for (int c = 0; c < 64; ++c) pwr[c] = pw[gi * 4096 + c * 64 + lane];
            const float psc = pscale[gi * 64 + lane];
            for (int tt = 0; tt < 32; ++tt) { const int tl = th * 32 + tt; const f32x4* pp = (const f32x4*)(pooled + tl * 256 + gi * 64); float acc = 0.f;
#pragma unroll
                for (int c4 = 0; c4 < 16; ++c4) { const f32x4 v = pp[c4]; acc += v.x * pwr[4 * c4] + v.y * pwr[4 * c4 + 1] + v.z * pwr[4 * c4 + 2] + v.w * pwr[4 * c4 + 3]; }
                Y[((size_t)b * SEQ + t0 + tl) * 1024 + gi * 64 + lane] = (bf16)f2bf(acc * psc); } }
    }
}

__device__ __forceinline__ void attn_phase(const Args& a, unsigned char* lds, int vcu, int G) {
    const int lane = ltid() & 63;
    const float s1 = wave_sum(a.in[16][lane] * a.in[17][lane]), s2 = wave_sum(a.in[18][lane] * a.in[19][lane]);
    const float lam = expf(s1) - expf(s2) + 0.2f;
    const bf16* Q = (const bf16*)(a.ws + WS_Q); const bf16* KA = (const bf16*)(a.ws + WS_K); const bf16* VA = (const bf16*)(a.ws + WS_V); bf16* Y = (bf16*)(a.ws + WS_Y);
    const int per = 768 / G;
    for (int i = 0; i < per; ++i) { const int u = vcu * per + i, bh = u >> 5, qb = u & 31, b = bh / 6, h = bh - b * 6;
        att::attn_unit(Q + ((size_t)b * SEQ + qb * 128) * 768 + h * 128, KA + (size_t)b * TKV * 768 + h * 128, VA + (size_t)b * TKV * 768 + h * 128,
                       Y + ((size_t)b * SEQ + qb * 128) * 1024 + 256 + h * 128, a.in[20], lam, (char*)lds); }
}

__device__ __forceinline__ void spatial_phase(const Args& a, unsigned char* lds, int vcu, int G) {
    const int tid = ltid(), lane = tid & 63, wave = tid >> 6, r32 = lane & 31, hi = lane >> 5;
    const bf16* VT = (const bf16*)(a.ws + WS_VT); bf16* U = (bf16*)(a.ws + WS_U);
    const float* lng = a.in[22]; const float* lnb = a.in[23]; const float* sgw = a.in[24]; const float* sgb = a.in[25];
    constexpr int TROW = 272;
    unsigned char* T = lds;
    float* red = (float*)lds;
    float* scr = (float*)(lds + 69632) + wave * (32 * 68);
    float* stats = (float*)(lds + 69632 + 69632);
    for (int un = vcu; un < 256; un += G) {
        const int chunk = un >> 1, half = un & 1; const size_t tok0 = (size_t)chunk * 128;
        __syncthreads();
        { const int slot = tid & 15, cg = tid >> 4; float s[8], q[8];
#pragma unroll
            for (int e = 0; e < 8; ++e) { s[e] = 0.f; q[e] = 0.f; }
#pragma unroll 4
            for (int i = 0; i < 64; ++i) { const int c = cg + 32 * i; const v4u w = *(const v4u*)(VT + (size_t)c * MTOK + tok0 + slot * 8);
                float x[8]; x[0] = bflo(w.x); x[1] = bfhi(w.x); x[2] = bflo(w.y); x[3] = bfhi(w.y); x[4] = bflo(w.z); x[5] = bfhi(w.z); x[6] = bflo(w.w); x[7] = bfhi(w.w);
#pragma unroll
                for (int e = 0; e < 8; ++e) { s[e] += x[e]; q[e] += x[e] * x[e]; } }
#pragma unroll
            for (int e = 0; e < 8; ++e) { red[(cg * 128 + slot * 8 + e) * 2] = s[e]; red[(cg * 128 + slot * 8 + e) * 2 + 1] = q[e]; } }
        __syncthreads();
        if (tid < 128) { float s = 0.f, q = 0.f;
            for (int cg = 0; cg < 32; ++cg) { s += red[(cg * 128 + tid) * 2]; q += red[(cg * 128 + tid) * 2 + 1]; }
            const float mean = s * (1.f / 2048.f), var = fmaxf(q * (1.f / 2048.f) - mean * mean, 0.f);
            stats[tid * 2] = mean; stats[tid * 2 + 1] = rsqrtf(var + 1e-6f); }
        __syncthreads();
        for (int gq = 0; gq < 4; ++gq) { const int g = half * 4 + gq;
            if (gq) __syncthreads();
            { const int slot = tid & 15, cr = tid >> 4; float mu[8], rs[8];
#pragma unroll
                for (int e = 0; e < 8; ++e) { mu[e] = stats[(slot * 8 + e) * 2]; rs[e] = stats[(slot * 8 + e) * 2 + 1]; }
#pragma unroll
                for (int i = 0; i < 8; ++i) { const int cl = cr + 32 * i, c = g * 256 + cl; const v4u w = *(const v4u*)(VT + (size_t)c * MTOK + tok0 + slot * 8);
                    const float lg = lng[c], lb = lnb[c];
                    float x[8]; x[0] = bflo(w.x); x[1] = bfhi(w.x); x[2] = bflo(w.y); x[3] = bfhi(w.y); x[4] = bflo(w.z); x[5] = bfhi(w.z); x[6] = bflo(w.w); x[7] = bfhi(w.w);
#pragma unroll
                    for (int e = 0; e < 8; ++e) x[e] = (x[e] - mu[e]) * rs[e] * lg + lb;
                    v4u o; o.x = pk2(x[0], x[1]); o.y = pk2(x[2], x[3]); o.z = pk2(x[4], x[5]); o.w = pk2(x[6], x[7]);
                    *(v4u*)(T + cl * TROW + slot * 16) = o; } }
            __syncthreads();
            const int mb = (wave & 3) * 32, ch = (wave >> 2) * 128;
            bf16x8 af[8];
            { const float* wrow = sgw + ((size_t)g * 128 + mb + r32) * 128 + hi * 8;
#pragma unroll
                for (int ks = 0; ks < 8; ++ks) { const f32x4 w0 = *(const f32x4*)(wrow + ks * 16), w1 = *(const f32x4*)(wrow + ks * 16 + 4);
                    v4u p; p.x = pk2(w0.x, w0.y); p.y = pk2(w0.z, w0.w); p.z = pk2(w1.x, w1.y); p.w = pk2(w1.z, w1.w); af[ks] = __builtin_bit_cast(bf16x8, p); } }
            f32x16 o[4];
#pragma unroll
            for (int d0 = 0; d0 < 4; ++d0) { o[d0] = f32x16{};
#pragma unroll
                for (int ks = 0; ks < 8; ++ks) { const bf16x8 bfr = *(const bf16x8*)(T + (ch + d0 * 32 + r32) * TROW + (16 * ks + 8 * hi) * 2);
                    o[d0] = __builtin_amdgcn_mfma_f32_32x32x16_bf16(af[ks], bfr, o[d0], 0, 0, 0); } }
            float bias[16];
#pragma unroll
            for (int r = 0; r < 16; ++r) bias[r] = sgb[g * 128 + mb + att::crow(r, hi)];
#pragma unroll
            for (int p = 0; p < 2; ++p) {
#pragma unroll
                for (int dd = 0; dd < 2; ++dd)
#pragma unroll
                    for (int r = 0; r < 16; ++r) scr[att::crow(r, hi) * 68 + dd * 32 + r32] = o[2 * p + dd][r] + bias[r];
                LDS_WAIT(); asm volatile("" ::: "memory");
#pragma unroll
                for (int qq = 0; qq < 4; ++qq) { const int row = (lane >> 3) + 8 * qq, c8 = (lane & 7) * 8;
                    const f32x4 m0 = *(const f32x4*)(scr + row * 68 + c8), m1 = *(const f32x4*)(scr + row * 68 + c8 + 4);
                    bf16* up = U + (tok0 + mb + row) * 2048 + g * 256 + ch + p * 64 + c8; const v4u w = *(const v4u*)up;
                    v4u ov; ov.x = pk2(bflo(w.x) * m0.x, bfhi(w.x) * m0.y); ov.y = pk2(bflo(w.y) * m0.z, bfhi(w.y) * m0.w);
                    ov.z = pk2(bflo(w.z) * m1.x, bfhi(w.z) * m1.y); ov.w = pk2(bflo(w.w) * m1.z, bfhi(w.w) * m1.w);
                    *(v4u*)up = ov; }
                LDS_WAIT(); asm volatile("" ::: "memory");
            }
        }
    }
}


#if MK_DEBUG
__device__ __forceinline__ float bfr(float f) { return __builtin_bit_cast(float, f2bf(f) << 16); }
__device__ __forceinline__ float bf2f(bf16 v) { return __builtin_bit_cast(float, (unsigned)v << 16); }
__device__ __forceinline__ void rec(float* res, int st, float got, float want) { float e = fabsf(got - want) / (fabsf(want) + 0.1f); if (!(e == e) || e > 1e30f) e = 0.77f; else e = fminf(e, 0.6f); atomicMax((unsigned*)res + st, __float_as_uint(e)); }
__device__ __forceinline__ unsigned hsh(unsigned s) { s ^= s >> 16; s *= 0x7feb352du; s ^= s >> 15; s *= 0x846ca68bu; s ^= s >> 16; return s; }
__global__ void chk_mod(Args a, float* res) {
    const int i = blockIdx.x * 256 + threadIdx.x; if (i >= 2 * 5 * 6144) return; const int l = i / (5 * 6144), r = (i / 6144) % 5, n = i % 6144;
    float s = 0.f; for (int k = 0; k < 1024; ++k) { const float c = r < 4 ? a.in[1][r * 1024 + k] : a.in[3][k]; s += (c / (1.f + expf(-c))) * a.in[4][((size_t)l * 1024 + k) * 6144 + n]; }
    s += a.in[5][l * 6144 + n]; rec(res, 0, ((const float*)(a.ws + WS_MOD))[i], s);
}
__global__ void chk_wt(const float* W, int K, int N, const bf16* WT, float* res, int st) {
    const unsigned h = hsh(blockIdx.x * 256 + threadIdx.x + 77u * st); const int k = h % K, n = (h >> 12) % N;
    rec(res, st, bf2f(WT[(size_t)n * K + k]), bfr(W[(size_t)k * N + n]));
}
__global__ void chk_norm(const float* src, const float* g, const float* modrow_sh, const float* modrow_sc, int bstride, const bf16* dst, int nrows, int rows_per_b, float* res, int st, int row_base = 0) {
    __shared__ float red[256]; const unsigned h = hsh(blockIdx.x + 1000u * st); const int row = row_base + h % nrows; const int b = rows_per_b ? row / rows_per_b : 0; const int t = threadIdx.x;
    float s = 0.f; for (int k = t; k < 1024; k += 256) { const float v = src[(size_t)row * 1024 + k]; s += v * v; } red[t] = s; __syncthreads();
    for (int o = 128; o > 0; o >>= 1) { if (t < o) red[t] += red[t + o]; __syncthreads(); }
    const float rstd = rsqrtf(red[0] / 1024.f + 1e-6f);
    for (int k = t; k < 1024; k += 256) { const float want = src[(size_t)row * 1024 + k] * rstd * g[k] * (1.f + modrow_sc[(size_t)b * bstride + k]) + modrow_sh[(size_t)b * bstride + k]; rec(res, st, bf2f(dst[(size_t)row * 1024 + k]), want); }
}
__device__ __forceinline__ float dotbf(const bf16* A, const bf16* B, int K) { float s = 0.f; for (int k = 0; k < K; ++k) s += bf2f(A[k]) * bf2f(B[k]); return s; }
__global__ void chk_gemm1(Args a, float* res) {
    const unsigned h = hsh(blockIdx.x * 256 + threadIdx.x); int row = h % 17408; int col = (h >> 15) % 2560;
    if (row >= 16384) { col = 1024 + (h >> 15) % 1536; }
    const bf16* XN = (const bf16*)(a.ws + WS_XN); const bf16* WT = (const bf16*)(a.ws + WS_WIN);
    const float want = dotbf(XN + (size_t)row * 1024, WT + (size_t)col * 1024, 1024); float got;
    if (row < 16384) { const int b = row >> 12, t = row & 4095; const size_t kv = (size_t)b * TKV + 256 + t;
        if (col < 256) got = bf2f(((const bf16*)(a.ws + WS_POOL))[(size_t)row * 256 + col]);
        else if (col < 1024) got = bf2f(((const bf16*)(a.ws + WS_Q))[(size_t)row * 768 + col - 256]);
        else if (col < 1792) got = bf2f(((const bf16*)(a.ws + WS_K))[kv * 768 + col - 1024]);
        else got = bf2f(((const bf16*)(a.ws + WS_V))[kv * 768 + col - 1792]);
    } else { const int rc = row - 16384, b = rc >> 8, j = rc & 255; const size_t kv = (size_t)b * TKV + j;
        if (col < 1792) got = bf2f(((const bf16*)(a.ws + WS_K))[kv * 768 + col - 1024]); else got = bf2f(((const bf16*)(a.ws + WS_V))[kv * 768 + col - 1792]); }
    rec(res, 3, got, want);
}
__global__ void chk_qk(Args a, float* res) {
    __shared__ float raw[64]; __shared__ float red[64]; const unsigned h = hsh(blockIdx.x + 4242u); const int d = threadIdx.x;
    int row = h % 17408; const int hg = (h >> 16) % 12; int isq = (h >> 24) & 1; if (row >= 16384) isq = 0;
    const bf16* XN = (const bf16*)(a.ws + WS_XN); const bf16* WT = (const bf16*)(a.ws + WS_WIN);
    const int col = (isq ? 256 : 1024) + hg * 64 + d;
    raw[d] = bfr(dotbf(XN + (size_t)row * 1024, WT + (size_t)col * 1024, 1024)); red[d] = raw[d] * raw[d]; __syncthreads();
    for (int o = 32; o > 0; o >>= 1) { if (d < o) red[d] += red[d + o]; __syncthreads(); }
    const float rstd = rsqrtf(red[0] / 64.f + 1e-6f); const float* gam = isq ? a.in[14] : a.in[15];
    float y = raw[d] * rstd * gam[d]; __syncthreads(); red[d] = y; __syncthreads();
    float want = y; size_t off;
    if (row < 16384) { const int t = row & 4095, pr = d >> 1; const float pos = (float)(pr < 16 ? (t >> 6) : (t & 63)); const float inv = powf(10000.f, -(float)(pr & 15) / 16.f); const float ang = pos * inv;
        const float cs = cosf(ang), sn = sinf(ang), x0 = red[2 * pr], x1 = red[2 * pr + 1]; want = (d & 1) ? x0 * sn + x1 * cs : x0 * cs - x1 * sn;
        off = isq ? (size_t)row * 768 + hg * 64 + d : ((size_t)(row >> 12) * TKV + 256 + t) * 768 + hg * 64 + d;
    } else { const int rc = row - 16384; off = ((size_t)(rc >> 8) * TKV + (rc & 255)) * 768 + hg * 64 + d; }
    const bf16* buf = isq ? (const bf16*)(a.ws + WS_Q) : (const bf16*)(a.ws + WS_K);
    rec(res, 4, bf2f(buf[off]), want);
}
__global__ void chk_pool(Args a, float* res) {
    const unsigned h = hsh(blockIdx.x * 256 + threadIdx.x + 999u); const int row = h % 16384, gi = (h >> 14) & 3, d = (h >> 16) & 63; const int b = row >> 12, t = row & 4095, hw = 1 << gi;
    const bf16* PI = (const bf16*)(a.ws + WS_POOL); const int lo = max(t - hw, 0), hi = min(t + hw, 4096); float acc = 0.f;
    for (int c = 0; c < 64; ++c) { float s = 0.f; for (int j = lo; j < hi; ++j) s += bf2f(PI[((size_t)b * 4096 + j) * 256 + gi * 64 + c]);
        const float pooled = s / (float)(hi - lo) - bf2f(PI[(size_t)row * 256 + gi * 64 + c]); acc += pooled * a.in[12][gi * 4096 + c * 64 + d]; }
    rec(res, 5, bf2f(((const bf16*)(a.ws + WS_Y))[(size_t)row * 1024 + gi * 64 + d]), acc * a.in[13][gi * 64 + d]);
}
__global__ void chk_attn(Args a, float* res) {
    __shared__ float s1[TKV], s2[TKV]; __shared__ float red[256]; __shared__ float ov[128];
    const unsigned hh = hsh(blockIdx.x + 31337u); const int row = hh % 16384, h = (hh >> 14) % 6, b = row >> 12, t = threadIdx.x;
    const bf16* Q = (const bf16*)(a.ws + WS_Q) + (size_t)row * 768 + h * 128; const bf16* KA = (const bf16*)(a.ws + WS_K) + (size_t)b * TKV * 768 + h * 128; const bf16* VA = (const bf16*)(a.ws + WS_V) + (size_t)b * TKV * 768 + h * 128;
    float l1 = 0.f, l2 = 0.f; for (int i = 0; i < 64; ++i) { l1 += a.in[16][i] * a.in[17][i]; l2 += a.in[18][i] * a.in[19][i]; } const float lam = expf(l1) - expf(l2) + 0.2f;
    for (int k = t; k < TKV; k += 256) { float x1 = 0.f, x2 = 0.f; for (int d = 0; d < 64; ++d) { x1 += bf2f(Q[d]) * bf2f(KA[(size_t)k * 768 + d]); x2 += bf2f(Q[64 + d]) * bf2f(KA[(size_t)k * 768 + 64 + d]); } s1[k] = x1 * 0.125f; s2[k] = x2 * 0.125f; }
    __syncthreads();
    float m1 = -1e30f, m2 = -1e30f; for (int k = t; k < TKV; k += 256) { m1 = fmaxf(m1, s1[k]); m2 = fmaxf(m2, s2[k]); }
    red[t] = m1; __syncthreads(); for (int o = 128; o > 0; o >>= 1) { if (t < o) red[t] = fmaxf(red[t], red[t + o]); __syncthreads(); } m1 = red[0]; __syncthreads();
    red[t] = m2; __syncthreads(); for (int o = 128; o > 0; o >>= 1) { if (t < o) red[t] = fmaxf(red[t], red[t + o]); __syncthreads(); } m2 = red[0]; __syncthreads();
    float z1 = 0.f, z2 = 0.f; for (int k = t; k < TKV; k += 256) { s1[k] = expf(s1[k] - m1); s2[k] = expf(s2[k] - m2); z1 += s1[k]; z2 += s2[k]; }
    red[t] = z1; __syncthreads(); for (int o = 128; o > 0; o >>= 1) { if (t < o) red[t] += red[t + o]; __syncthreads(); } z1 = red[0]; __syncthreads();
    red[t] = z2; __syncthreads(); for (int o = 128; o > 0; o >>= 1) { if (t < o) red[t] += red[t + o]; __syncthreads(); } z2 = red[0]; __syncthreads();
    if (t < 128) { float o = 0.f; for (int k = 0; k < TKV; ++k) o += (s1[k] / z1 - lam * s2[k] / z2) * bf2f(VA[(size_t)k * 768 + t]); ov[t] = o; red[t] = o * o; } else red[t] = 0.f;
    __syncthreads(); for (int o = 128; o > 0; o >>= 1) { if (t < o) red[t] += red[t + o]; __syncthreads(); }
    if (t < 128) { const float want = ov[t] * rsqrtf(red[0] / 128.f + 1e-6f) * a.in[20][t] * 0.8f; rec(res, 6, bf2f(((const bf16*)(a.ws + WS_Y))[(size_t)row * 1024 + 256 + h * 128 + t]), want); }
}
__global__ void chk_res(const bf16* A, const bf16* WT, int K, const float* basebuf, const float* gate, const float* out, float* res, int st, int nrows) {
    const unsigned h = hsh(blockIdx.x * 256 + threadIdx.x + 555u * st); const int row = h % nrows, col = (h >> 13) % 1024;
    const float want = basebuf[(size_t)row * 1024 + col] + gate[(size_t)(row >> 12) * 6144 + col] * dotbf(A + (size_t)row * K, WT + (size_t)col * K, K);
    rec(res, st, out[(size_t)row * 1024 + col], want);
}
__global__ void chk_act(const bf16* A, const bf16* WT, int K, int N, const bf16* O, int ldo, int act, int transposed, float* res, int st) {
    const unsigned h = hsh(blockIdx.x * 256 + threadIdx.x + 333u * st); const int row = h % 16384, col = (h >> 14) % N;
    float v = dotbf(A + (size_t)row * K, WT + (size_t)col * K, K); if (act == 2) { v = fmaxf(v, 0.f); v *= v; } else if (act == 1) v = 0.5f * v * (1.f + erff(v * 0.70710678f));
    rec(res, st, bf2f(transposed ? O[(size_t)col * ldo + row] : O[(size_t)row * ldo + col]), v);
}
__global__ void chk_copy(const float* src, float* dst, size_t n4) { for (size_t i = blockIdx.x * 256ull + threadIdx.x; i < n4; i += gridDim.x * 256ull) ((f32x4*)dst)[i] = ((const f32x4*)src)[i]; }
__global__ void chk_final(float* res, float* out, int nst) {
    for (int i = 0; i < nst; ++i) { const float e = res[i]; if (e > 0.08f) { float m = fminf(fmaxf(e * 10.f, 1.0f), 9.9f); float v = m; for (int j = 0; j < 4 + i; ++j) v *= 10.f; out[0] = v; return; } }
}
__global__ void simple_norm(const float* src, const float* g, const float* sh, const float* sc, int bstride, bf16* dst) {
    __shared__ float red[256]; const int row = blockIdx.x, b = row >> 12, t = threadIdx.x;
    float s = 0.f; for (int k = t; k < 1024; k += 256) { const float v = src[(size_t)row * 1024 + k]; s += v * v; } red[t] = s; __syncthreads();
    for (int o = 128; o > 0; o >>= 1) { if (t < o) red[t] += red[t + o]; __syncthreads(); }
    const float rstd = rsqrtf(red[0] / 1024.f + 1e-6f);
    for (int k = t; k < 1024; k += 256) dst[(size_t)row * 1024 + k] = (bf16)f2bf(src[(size_t)row * 1024 + k] * rstd * g[k] * (1.f + sc[(size_t)b * bstride + k]) + sh[(size_t)b * bstride + k]);
}
__global__ void chk_final2(float* res, float* out) { int mask = 0; for (int i = 0; i < 8; ++i) if (res[20 + i] < 0.08f) mask |= 1 << i; out[0] = (float)(mask + 1) * 1e6f; }
#endif

#define XB_TMO      128
#define XB_XCNT(j)  (256  + 64 * (j))
#define XB_XSUB(j)  (1280 + 64 * (j))
#define XB_XGEN(j)  (2304 + 64 * (j))
#define XB_TOP      3328
#define XB_TOPGEN   3392
#define XCD_BAR_WORDS 3456
#define XB_SPIN_CAP (1u << 18)

__device__ __forceinline__ unsigned xb_ld(unsigned* p)              { return __hip_atomic_load(p, __ATOMIC_RELAXED, __HIP_MEMORY_SCOPE_AGENT); }
__device__ __forceinline__ unsigned xb_add(unsigned* p, unsigned v) { return __hip_atomic_fetch_add(p, v, __ATOMIC_RELAXED, __HIP_MEMORY_SCOPE_AGENT); }
__device__ __forceinline__ unsigned xb_xcc_id() { return (unsigned)__builtin_amdgcn_s_getreg((3 << 11) | 20) & 0xFu; }
#define XB_SPIN(cond, bar) do { unsigned _sp = 0; while (cond) { __builtin_amdgcn_s_sleep(1); \
    if ((++_sp & 255u) == 0u) { if (xb_ld(&(bar)[XB_TMO])) break; if (_sp > XB_SPIN_CAP) { atomicAdd(&(bar)[XB_TMO], 1u); break; } } } } while (0)

struct XcdBarrier {
    unsigned* bar; unsigned x;
    volatile LAS unsigned* st;
};

__device__ __forceinline__ XcdBarrier xcd_barrier_post(unsigned* bar, volatile LAS unsigned* st) {
    XcdBarrier b; b.bar = bar; b.x = xb_xcc_id(); b.st = st;
    if (threadIdx.x == 0) (void)xb_add(&bar[XB_XCNT(b.x)], 1u);
    return b;
}
__device__ __forceinline__ void xcd_barrier_complete(unsigned* bar, unsigned x, unsigned& nloc, unsigned& nx) {
    const unsigned G = gridDim.x * gridDim.y * gridDim.z;
    unsigned sum, cnt, mine, sp = 0u;
    for (;;) {
        sum = 0u; cnt = 0u; mine = 0u;
#pragma unroll
        for (unsigned j = 0; j < 16; ++j) { const unsigned c = xb_ld(&bar[XB_XCNT(j)]); sum += c; cnt += (c > 0u) ? 1u : 0u; mine = (j == x) ? c : mine; }
        if (sum == G) break;
        __builtin_amdgcn_s_sleep(1);
        if ((++sp & 255u) == 0u) { if (xb_ld(&bar[XB_TMO])) break; if (sp > XB_SPIN_CAP) { atomicAdd(&bar[XB_TMO], 1u); break; } }
    }
    nloc = mine > 0u ? mine : 1u; nx = cnt > 0u ? cnt : 1u;
}

__device__ __forceinline__ void xcd_barrier(const XcdBarrier& b) {
    asm volatile("s_waitcnt vmcnt(0)" ::: "memory");
    __syncthreads();
    if (threadIdx.x == 0) {
        unsigned* bar = b.bar;
        __builtin_amdgcn_s_waitcnt(0);
        unsigned nloc = b.st[0], nx = b.st[1];
        if (nloc == 0u) { xcd_barrier_complete(bar, b.x, nloc, nx); b.st[0] = nloc; b.st[1] = nx; }
        const unsigned old = xb_add(&bar[XB_XSUB(b.x)], 1u);
        const unsigned gen = old / nloc;
        if (old + 1u == (gen + 1u) * nloc) {
            __builtin_amdgcn_fence(__ATOMIC_RELEASE, "agent");
            asm volatile("s_waitcnt vmcnt(0)" ::: "memory");
            const unsigned og = xb_add(&bar[XB_TOP], 1u);
            const unsigned tg = og / nx;
            if (og + 1u == (tg + 1u) * nx) xb_add(&bar[XB_TOPGEN], 1u);
            else XB_SPIN(xb_ld(&bar[XB_TOPGEN]) == tg, bar);
            __builtin_amdgcn_fence(__ATOMIC_ACQUIRE, "agent");
            xb_add(&bar[XB_XGEN(b.x)], 1u);
            asm volatile("s_waitcnt vmcnt(0)" ::: "memory");
        } else {
            XB_SPIN(xb_ld(&bar[XB_XGEN(b.x)]) == gen, bar);
            __builtin_amdgcn_fence(__ATOMIC_ACQUIRE, "agent");
            asm volatile("s_waitcnt vmcnt(0)" ::: "memory");
        }
    }
    __syncthreads();
}

template <int PH> __device__ __forceinline__ void run_phase(const Args& a, unsigned char* lds, int vcu, int G, int bx) {
    unsigned char* ws = a.ws;
    float* mod = (float*)(ws + WS_MOD);
    bf16* XN = (bf16*)(ws + WS_XN);
    if constexpr (PH == 0) p0_prep(a, lds, vcu, G);
    else if constexpr (PH == 1)  norm_phase(a.in[0], a.in[6],        mod,            0,    1024, XN, a.in[2], vcu, G);
    else if constexpr (PH == 6)  norm_phase(a.out,   a.in[7],        mod,            3072, 4096, XN, nullptr, vcu, G);
    else if constexpr (PH == 9)  norm_phase(a.out,   a.in[6] + 1024, mod + 5 * MODW, 0,    1024, XN, nullptr, vcu, G);
    else if constexpr (PH == 13) norm_phase(a.out,   a.in[7] + 1024, mod + 5 * MODW, 3072, 4096, XN, nullptr, vcu, G);
    else if constexpr (PH == 2) {
        pg8::Gemm g{XN, (const bf16*)(ws + WS_WIN), 17408, 2560, 1024}; pg8::OrderQKV S; S.init(G, bx);
        pg8::EpiRoute E{(bf16*)(ws + WS_POOL), (bf16*)(ws + WS_Q), (bf16*)(ws + WS_K), (bf16*)(ws + WS_V)};
        pg8::gemm_phase<pg8::EpiRoute, pg8::OrderQKV, true, true>((LAS unsigned char*)lds, g, S, E);
    }
    else if constexpr (PH == 3) qknorm_pool_phase(a, lds, vcu, G);
    else if constexpr (PH == 4) { attn_phase(a, lds, vcu, G);
#ifdef PROBE_ATT2
        attn_phase(a, lds, vcu, G);
#endif
    }
    else if constexpr (PH == 5 || PH == 8 || PH == 12 || PH == 15) {
        pg8::Gemm g; const float* base; const float* gate;
        if constexpr (PH == 5)       { g = pg8::Gemm{(const bf16*)(ws + WS_Y),  (const bf16*)(ws + WS_WOUT),  MTOK, 1024, 1024}; base = a.in[0]; gate = mod + 2048; }
        else if constexpr (PH == 8)  { g = pg8::Gemm{(const bf16*)(ws + WS_HB), (const bf16*)(ws + WS_W2),    MTOK, 1024, 4096}; base = a.out;   gate = mod + 5120; }
        else if constexpr (PH == 12) { g = pg8::Gemm{(const bf16*)(ws + WS_U),  (const bf16*)(ws + WS_ODOUT), MTOK, 1024, 2048}; base = a.out;   gate = mod + 5 * MODW + 2048; }
        else                         { g = pg8::Gemm{(const bf16*)(ws + WS_HB), (const bf16*)(ws + WS_W2) + (size_t)1024 * 4096, MTOK, 1024, 4096}; base = a.out; gate = mod + 5 * MODW + 5120; }
        pg8::StaticOrder S; S.init(g.M, g.N, G, bx);
        pg8::EpiRes E{base, a.out, gate};
        pg8::gemm_phase<pg8::EpiRes, pg8::StaticOrder, true, true>((LAS unsigned char*)lds, g, S, E);
    }
    else if constexpr (PH == 7 || PH == 14) {
        pg8::Gemm g{XN, (const bf16*)(ws + WS_W1) + (PH == 14 ? (size_t)4096 * 1024 : 0), MTOK, FF, 1024}; pg8::EpiAct E{(bf16*)(ws + WS_HB), FF, 2};
        pg8::StaticOrder S; S.init(g.M, g.N, G, bx);
        pg8::gemm_phase<pg8::EpiAct, pg8::StaticOrder, true, true>((LAS unsigned char*)lds, g, S, E);
    }
    else if constexpr (PH == 10) {
        { pg8::Gemm g{XN, (const bf16*)(ws + WS_ODIN), MTOK, 2048, 1024}; pg8::EpiAct E{(bf16*)(ws + WS_U), 2048, 1};
          pg8::StaticOrder S; S.init(g.M, g.N, G, bx);
          pg8::gemm_phase<pg8::EpiAct, pg8::StaticOrder, true, true>((LAS unsigned char*)lds, g, S, E); }
        { pg8::Gemm g{(const bf16*)(ws + WS_ODIN) + (size_t)2048 * 1024, XN, 2048, MTOK, 1024}; pg8::EpiAct E{(bf16*)(ws + WS_VT), MTOK, 1};
          pg8::StaticOrder S; S.init(g.M, g.N, G, bx);
          pg8::gemm_phase<pg8::EpiAct, pg8::StaticOrder, true, true>((LAS unsigned char*)lds, g, S, E); }
    }
    else if constexpr (PH == 11) spatial_phase(a, lds, vcu, G);
}
constexpr int XBAR_LDS_OFF = LDS_BYTES - 64;
__global__ void __launch_bounds__(NTHR) fwd_megakernel(Args a) {
    extern __shared__ __attribute__((aligned(16))) unsigned char lds[];
    const int G = gridDim.x, bx = blockIdx.x;
    const int vcu = (G % 8 == 0) ? (bx % 8) * (G / 8) + bx / 8 : bx;
    volatile LAS unsigned* xst = (volatile LAS unsigned*)((LAS unsigned char*)lds + XBAR_LDS_OFF);
    if (threadIdx.x < 2) xst[threadIdx.x] = 0u;
    __syncthreads();
    XcdBarrier bar; bar.bar = (unsigned*)a.ws; bar.x = 0; bar.st = xst;
    const bool fused = (a.ph_hi - a.ph_lo) > 1;
    if (fused) bar = xcd_barrier_post((unsigned*)a.ws, xst);
    if (a.ph_hi > NPH) cg::this_grid().sync();
#define PHASE(k) if (a.ph_lo <= (k) && (k) < a.ph_hi) { run_phase<k>(a, lds, vcu, G, bx); if ((k) + 1 < a.ph_hi) xcd_barrier(bar); }
    PHASE(0) PHASE(1) PHASE(2) PHASE(3) PHASE(4) PHASE(5) PHASE(6) PHASE(7) PHASE(8) PHASE(9) PHASE(10) PHASE(11) PHASE(12) PHASE(13) PHASE(14) PHASE(15)
#undef PHASE
}

extern "C" void kernel_launch(void* const* d_in, const int* in_sizes, int n_in, void* d_out, int out_size, void* d_ws, size_t ws_size, hipStream_t stream) {
    static int grid = 0;
    if (grid == 0) {
        if (n_in != 27 || in_sizes[0] != MTOK * DM || out_size != MTOK * DM || ws_size < WS_END) { fprintf(stderr, "kernel_launch: unexpected shapes (n_in %d, in0 %d, out %d, ws %zu)\n", n_in, n_in > 0 ? in_sizes[0] : -1, out_size, ws_size); grid = -1; return; }
        if (hipFuncSetAttribute((const void*)fwd_megakernel, hipFuncAttributeMaxDynamicSharedMemorySize, LDS_BYTES) != hipSuccess) { fprintf(stderr, "kernel_launch: hipFuncSetAttribute failed\n"); grid = -1; return; }
        int dev = 0, cus = 0, per_cu = 0;
        (void)hipGetDevice(&dev); (void)hipDeviceGetAttribute(&cus, hipDeviceAttributeMultiprocessorCount, dev);
        (void)hipOccupancyMaxActiveBlocksPerMultiprocessor(&per_cu, (const void*)fwd_megakernel, NTHR, LDS_BYTES);
        if (per_cu < 1 || cus < 256) fprintf(stderr, "kernel_launch: note: occupancy query %d blocks/CU, %d CUs\n", per_cu, cus);
        (void)hipGetLastError();
        grid = 256;
    }
    if (grid < 0) return;
    Args a{};
    for (int i = 0; i < 27; ++i) a.in[i] = (const float*)d_in[i];
    a.out = (float*)d_out; a.ws = (unsigned char*)d_ws;
#if MK_MULTI
#if MK_DEBUG
    float* res = (float*)d_ws; (void)hipMemsetAsync(res, 0, 256, stream);
    unsigned char* ws = (unsigned char*)d_ws; float* mod = (float*)(ws + WS_MOD); float* snap = (float*)(ws + 220 * MiB);
#endif
    for (int ph = 0; ph < NPH_RUN; ++ph) { a.ph_lo = ph; a.ph_hi = ph + 1;
#if MK_DEBUG
        if (ph == 8 || ph == 12 || ph == 15) hipLaunchKernelGGL(chk_copy, dim3(2048), dim3(256), 0, stream, (const float*)d_out, snap, (size_t)8192 * 1024 / 4);
#endif
#if MK_DEBUG
        if (ph == 6 && MK_SIMPLE6) hipLaunchKernelGGL(simple_norm, dim3(16384), dim3(256), 0, stream, (const float*)d_out, a.in[7], (const float*)(mod + 3072), (const float*)(mod + 4096), 6144, (bf16*)(ws + WS_XN)); else
#endif
        hipLaunchKernelGGL(fwd_megakernel, dim3(grid), dim3(NTHR), LDS_BYTES, stream, a);
#if MK_DEBUG
        if (ph == 0) { hipLaunchKernelGGL(chk_mod, dim3(240), dim3(256), 0, stream, a, res);
            hipLaunchKernelGGL(chk_wt, dim3(16), dim3(256), 0, stream, a.in[10], 1024, 2560, (const bf16*)(ws + WS_WIN), res, 1);
            hipLaunchKernelGGL(chk_wt, dim3(16), dim3(256), 0, stream, a.in[11], 1024, 1024, (const bf16*)(ws + WS_WOUT), res, 1);
            hipLaunchKernelGGL(chk_wt, dim3(16), dim3(256), 0, stream, a.in[8], 1024, 4096, (const bf16*)(ws + WS_W1), res, 1);
            hipLaunchKernelGGL(chk_wt, dim3(16), dim3(256), 0, stream, a.in[8] + 1024 * 4096, 1024, 4096, (const bf16*)(ws + WS_W1) + 4096 * 1024, res, 1);
            hipLaunchKernelGGL(chk_wt, dim3(16), dim3(256), 0, stream, a.in[9], 4096, 1024, (const bf16*)(ws + WS_W2), res, 1);
            hipLaunchKernelGGL(chk_wt, dim3(16), dim3(256), 0, stream, a.in[9] + 1024 * 4096, 4096, 1024, (const bf16*)(ws + WS_W2) + 4096 * 1024, res, 1);
            hipLaunchKernelGGL(chk_wt, dim3(16), dim3(256), 0, stream, a.in[21], 1024, 4096, (const bf16*)(ws + WS_ODIN), res, 1);
            hipLaunchKernelGGL(chk_wt, dim3(16), dim3(256), 0, stream, a.in[26], 2048, 1024, (const bf16*)(ws + WS_ODOUT), res, 1); }
        if (ph == 1) { hipLaunchKernelGGL(chk_norm, dim3(128), dim3(256), 0, stream, a.in[0], a.in[6], (const float*)mod, (const float*)(mod + 1024), 6144, (const bf16*)(ws + WS_XN), 16384, 4096, res, 2);
            hipLaunchKernelGGL(chk_norm, dim3(64), dim3(256), 0, stream, a.in[2], a.in[6], (const float*)(mod + 4 * 6144), (const float*)(mod + 4 * 6144 + 1024), 0, (const bf16*)(ws + WS_XN) + (size_t)16384 * 1024, 1024, 0, res, 2); }
        if (ph == 2) hipLaunchKernelGGL(chk_gemm1, dim3(32), dim3(256), 0, stream, a, res);
        if (ph == 3) { hipLaunchKernelGGL(chk_qk, dim3(512), dim3(64), 0, stream, a, res); hipLaunchKernelGGL(chk_pool, dim3(16), dim3(256), 0, stream, a, res); }
        if (ph == 4) hipLaunchKernelGGL(chk_attn, dim3(96), dim3(256), 0, stream, a, res);
        if (ph == 5) hipLaunchKernelGGL(chk_res, dim3(16), dim3(256), 0, stream, (const bf16*)(ws + WS_Y), (const bf16*)(ws + WS_WOUT), 1024, a.in[0], (const float*)(mod + 2048), (const float*)d_out, res, 7, 16384);
        if (ph == 6) hipLaunchKernelGGL(chk_norm, dim3(128), dim3(256), 0, stream, (const float*)d_out, a.in[7], (const float*)(mod + 3072), (const float*)(mod + 4096), 6144, (const bf16*)(ws + WS_XN), 16384, 4096, res, 8);
        if (ph == 7) hipLaunchKernelGGL(chk_act, dim3(16), dim3(256), 0, stream, (const bf16*)(ws + WS_XN), (const bf16*)(ws + WS_W1), 1024, 4096, (const bf16*)(ws + WS_HB), 4096, 2, 0, res, 9);
        if (ph == 8) hipLaunchKernelGGL(chk_res, dim3(16), dim3(256), 0, stream, (const bf16*)(ws + WS_HB), (const bf16*)(ws + WS_W2), 4096, (const float*)snap, (const float*)(mod + 5120), (const float*)d_out, res, 10, 8192);
        if (ph == 9) hipLaunchKernelGGL(chk_norm, dim3(128), dim3(256), 0, stream, (const float*)d_out, a.in[6] + 1024, (const float*)(mod + 5 * 6144), (const float*)(mod + 5 * 6144 + 1024), 6144, (const bf16*)(ws + WS_XN), 16384, 4096, res, 11);
        if (ph == 10) { hipLaunchKernelGGL(chk_act, dim3(16), dim3(256), 0, stream, (const bf16*)(ws + WS_XN), (const bf16*)(ws + WS_ODIN), 1024, 2048, (const bf16*)(ws + WS_U), 2048, 1, 0, res, 12);
            hipLaunchKernelGGL(chk_act, dim3(16), dim3(256), 0, stream, (const bf16*)(ws + WS_XN), (const bf16*)(ws + WS_ODIN) + (size_t)2048 * 1024, 1024, 2048, (const bf16*)(ws + WS_VT), 16384, 1, 1, res, 13); }
#endif
    }
#if MK_DEBUG
    if (NPH_RUN == 16) hipLaunchKernelGGL(chk_final, dim3(1), dim3(1), 0, stream, res, (float*)d_out, 14);
#endif
#else
    a.ph_lo = 0; a.ph_hi = NPH;
    if (hipMemsetAsync(d_ws, 0, 16384, stream) != hipSuccess) { fprintf(stderr, "kernel_launch: memset of the barrier words failed\n"); return; }
    void* args[] = {&a};
    hipError_t e = hipLaunchCooperativeKernel((const void*)fwd_megakernel, dim3(grid), dim3(NTHR), args, LDS_BYTES, stream);
    if (e != hipSuccess) fprintf(stderr, "kernel_launch: cooperative launch failed: %s\n", hipGetErrorString(e));
#endif
}
```

```cpp
#include <hip/hip_runtime.h>
#include <hip/hip_cooperative_groups.h>
#include <cstdio>
#include <cstdint>
namespace cg = cooperative_groups;
__device__ __forceinline__ int ltid() { int t = threadIdx.x; asm volatile("" : "+v"(t)); return t; }
namespace pg8 {
#define PG8_LAS __attribute__((address_space(3)))
typedef unsigned short bf16_t;
typedef short bf16x8 __attribute__((ext_vector_type(8)));
typedef float f32x4 __attribute__((ext_vector_type(4)));
typedef unsigned u32x4 __attribute__((ext_vector_type(4)));
constexpr int BM = 256, BK = 64, HALF = 128, HTB = HALF * BK * 2  , STAGE_BYTES = 8 * HTB, NXCD = 8, WGM = 8;

__host__ __device__ __forceinline__ int lds_byte(int r, int c) { const int st = (r >> 4) * 2 + (c >> 5), rr = r & 15, cc = c & 31, ob = rr * 64 + cc * 2; return st * 1024 + (ob ^ (((ob >> 9) & 1) << 5)); }
__host__ __device__ __forceinline__ void stage_rc(int b, int& R, int& C) { const int st = b / 1024, sb = b % 1024, swz = sb ^ (((sb >> 9) & 1) << 5); R = (st >> 1) * 16 + swz / 64; C = (st & 1) * 32 + (swz % 64) / 2; }
__host__ __device__ __forceinline__ int perm32(int rho) { const int n = rho >> 4, i = rho & 15; return 8 * (i >> 2) + 4 * n + (i & 3); }

struct Unit { int pm, pn; };
struct Gemm { const bf16_t* A; const bf16_t* Bt; int M, N, K; };

struct StaticOrder {
    int nM, nN, nwg, G, c;
    __host__ __device__ void init(int M, int N, int G_, int c_) { nM = M / BM; nN = N / BM; nwg = nM * nN; G = G_; c = c_; }
    __host__ __device__ bool next(int i, Unit& u) const {
        const long L = (long)i * G + c; if (L >= nwg) return false;
        int wgid = (int)L; { const int q = nwg / NXCD, r = nwg % NXCD, xcd = wgid % NXCD, off = wgid / NXCD; wgid = (xcd < r ? xcd * (q + 1) : r * (q + 1) + (xcd - r) * q) + off; }
        const int nig = WGM * nN, gid = wgid / nig, fm = gid * WGM, gsz = (nM - fm) < WGM ? (nM - fm) : WGM;
        u.pm = fm + ((wgid % nig) % gsz); u.pn = (wgid % nig) / gsz; return true;
    }
    __device__ __forceinline__ void a_ready(const Unit&) const {}
    __device__ __forceinline__ void done(const Unit&) const {}
};

__device__ __forceinline__ unsigned cvt_pk_bf16(float lo, float hi) { unsigned r; asm volatile("v_cvt_pk_bf16_f32 %0, %1, %2" : "=v"(r) : "v"(lo), "v"(hi)); return r; }
typedef float f32x2 __attribute__((ext_vector_type(2)));
__device__ __forceinline__ f32x2 gelu_pk(f32x2 v) {
    const f32x2 av = __builtin_elementwise_abs(v), d = av * 0.2316418882f + 1.0f;
    f32x2 t; t.x = __builtin_amdgcn_rcpf(d.x); t.y = __builtin_amdgcn_rcpf(d.y);
    f32x2 q = t * 0.5307027145f + (-0.7265760135f); q = q * t + 0.7107068705f; q = q * t + (-0.142248368f); q = q * t + 0.127414796f; q = q * t;
    const f32x2 s = (v * v) * (-0.72134752044f);
    f32x2 e; e.x = __builtin_amdgcn_exp2f(s.x); e.y = __builtin_amdgcn_exp2f(s.y);
    const f32x2 m = v * (q * e), r = v - m;
    f32x2 o; o.x = v.x < 0.f ? m.x : r.x; o.y = v.y < 0.f ? m.y : r.y; return o;
}


struct EpiAct {
    static constexpr bool PERM = true, AFTER_DRAIN = false;
    bf16_t* O; int ldc; int act;
    __device__ __forceinline__ void operator()(const f32x4 (&acc)[2][2][4][2], const Unit& u, int wr, int wc, int fr, int fq) const {
        const int row0 = u.pm * BM + wr * 64 + fr; const int col0 = u.pn * BM + wc * 32 + 8 * fq;
#pragma unroll
        for (int ai = 0; ai < 2; ++ai)
#pragma unroll
            for (int m = 0; m < 4; ++m) { bf16_t* rowp = O + (size_t)(row0 + ai * HALF + m * 16) * ldc + col0;
#pragma unroll
                for (int bj = 0; bj < 2; ++bj) { f32x4 v0 = acc[ai][bj][m][0], v1 = acc[ai][bj][m][1];
                    if (act == 1) { f32x2 a = gelu_pk((f32x2){v0[0], v0[1]}), b = gelu_pk((f32x2){v0[2], v0[3]}), c = gelu_pk((f32x2){v1[0], v1[1]}), d = gelu_pk((f32x2){v1[2], v1[3]});
                        v0 = (f32x4){a.x, a.y, b.x, b.y}; v1 = (f32x4){c.x, c.y, d.x, d.y}; }
                    else if (act == 2) {
#pragma unroll
                        for (int e = 0; e < 4; ++e) { const float a = fmaxf(v0[e], 0.f), b = fmaxf(v1[e], 0.f); v0[e] = a * a; v1[e] = b * b; } }
                    u32x4 w; w.x = cvt_pk_bf16(v0[0], v0[1]); w.y = cvt_pk_bf16(v0[2], v0[3]); w.z = cvt_pk_bf16(v1[0], v1[1]); w.w = cvt_pk_bf16(v1[2], v1[3]);
                    *(u32x4*)(rowp + bj * HALF) = w; } }
    }
};
struct EpiRoute {
    static constexpr bool PERM = true, AFTER_DRAIN = false;
    bf16_t *pool, *q, *k, *v;
    __device__ __forceinline__ void operator()(const f32x4 (&acc)[2][2][4][2], const Unit& u, int wr, int wc, int fr, int fq) const {
        const int pm = u.pm, pn = u.pn; bf16_t* base; int ld, colt; long rowbase;
        if (pm < 64) { const int b = pm >> 4; const long lat = (long)pm * 256, kvrow = (long)b * 4352 + 256 + (pm & 15) * 256;
            if (pn == 0)     { base = pool; ld = 256; colt = 0;              rowbase = lat; }
            else if (pn < 4) { base = q;    ld = 768; colt = (pn - 1) * 256; rowbase = lat; }
            else if (pn < 7) { base = k;    ld = 768; colt = (pn - 4) * 256; rowbase = kvrow; }
            else             { base = v;    ld = 768; colt = (pn - 7) * 256; rowbase = kvrow; }
        } else { const int b = pm - 64; rowbase = (long)b * 4352; ld = 768;
            if (pn < 7) { base = k; colt = (pn - 4) * 256; } else { base = v; colt = (pn - 7) * 256; } }
        const long row0 = rowbase + wr * 64 + fr; const int col0 = colt + wc * 32 + 8 * fq;
#pragma unroll
        for (int ai = 0; ai < 2; ++ai)
#pragma unroll
            for (int m = 0; m < 4; ++m) { bf16_t* rowp = base + (size_t)(row0 + ai * HALF + m * 16) * ld + col0;
#pragma unroll
                for (int bj = 0; bj < 2; ++bj) { const f32x4 v0 = acc[ai][bj][m][0], v1 = acc[ai][bj][m][1];
                    u32x4 w; w.x = cvt_pk_bf16(v0[0], v0[1]); w.y = cvt_pk_bf16(v0[2], v0[3]); w.z = cvt_pk_bf16(v1[0], v1[1]); w.w = cvt_pk_bf16(v1[2], v1[3]);
                    *(u32x4*)(rowp + bj * HALF) = w; } }
    }
};
struct EpiRes {
    static constexpr bool PERM = false, AFTER_DRAIN = false;
    const float* base; float* out; const float* gate;
    __device__ __forceinline__ void operator()(const f32x4 (&acc)[2][2][4][2], const Unit& u, int wr, int wc, int fr, int fq) const {
        const int col0 = u.pn * BM + wc * 32 + 4 * fq; const float* gp = gate + (size_t)(u.pm >> 4) * 6144 + col0;
        f32x4 gv[2][2];
#pragma unroll
        for (int bj = 0; bj < 2; ++bj)
#pragma unroll
            for (int n = 0; n < 2; ++n) gv[bj][n] = *(const f32x4*)(gp + bj * HALF + n * 16);
#pragma unroll
        for (int ai = 0; ai < 2; ++ai)
#pragma unroll
            for (int m = 0; m < 4; ++m) { const size_t off = (size_t)(u.pm * BM + ai * HALF + wr * 64 + m * 16 + fr) * 1024 + col0;
#pragma unroll
                for (int bj = 0; bj < 2; ++bj)
#pragma unroll
                    for (int n = 0; n < 2; ++n) { const f32x4 bs = *(const f32x4*)(base + off + bj * HALF + n * 16);
                        *(f32x4*)(out + off + bj * HALF + n * 16) = bs + gv[bj][n] * acc[ai][bj][m][n]; }
                if (m & 1) asm volatile("" ::: "memory"); }
    }
};
struct OrderQKV {
    StaticOrder so;
    __host__ __device__ void init(int G_, int c_) { so.init(16384, 2560, G_, c_); }
    __host__ __device__ bool next(int i, Unit& u) const {
        const long L = (long)i * so.G + so.c; if (L < so.nwg) return so.next(i, u);
        const int e = (int)(L - so.nwg); if (e >= 24) return false; u.pm = 64 + e / 6; u.pn = 4 + e % 6; return true; }
    __device__ __forceinline__ void a_ready(const Unit&) const {}
    __device__ __forceinline__ void done(const Unit&) const {}
};

template <class Epi, class Sched, bool ALIGN_EPI = false, bool SP2 = false>
__device__ __forceinline__ void gemm_phase(PG8_LAS unsigned char* lds, const Gemm g, const Sched& S, const Epi& E) {
    const int tid = ltid(), wid = __builtin_amdgcn_readfirstlane(tid >> 6), lane = tid & 63, wr = wid >> 2, wc = wid & 3, fr = lane & 15, fq = lane >> 4;
    const int K = g.K, nt = K / BK;
    unsigned voffA[2], voffB[2];
#pragma unroll
    for (int i = 0; i < 2; ++i) { int R, C; stage_rc(tid * 16 + i * 8192, R, C); const int Rb = Epi::PERM ? ((R & ~31) + perm32(R & 31)) : R;
        voffA[i] = (unsigned)(R * K + C) * 2u; voffB[i] = (unsigned)(Rb * K + C) * 2u; }
    const size_t kstep = (size_t)(BK * 2);
    const size_t hstep = (size_t)HALF * K * 2;
    const size_t tstep = 2 * hstep;
    const unsigned ldsw = (unsigned)wid * 1024u;
    const int aoff = lds_byte(wr * 64 + fr, fq * 8), boff = lds_byte(wc * 32 + fr, fq * 8);
#define PG8_SA(b, h) (((b) * 2 + (h)) * HTB)
#define PG8_SB(b, h) ((4 + (b) * 2 + (h)) * HTB)
#define PG8_STAGE(bufoff, gbase, voff) do { _Pragma("unroll") for (int _i = 0; _i < 2; ++_i) \
        __builtin_amdgcn_global_load_lds((const unsigned*)((const char*)(gbase) + (voff)[_i]), (PG8_LAS unsigned*)(lds + (bufoff) + ldsw + _i * 8192), 16, 0, 0); } while (0)
#define PG8_LDA(dst, b, h) do { _Pragma("unroll") for (int m = 0; m < 4; ++m) _Pragma("unroll") for (int k = 0; k < 2; ++k) dst[m][k] = *(const PG8_LAS bf16x8*)(lds + PG8_SA(b, h) + aoff + m * 2048 + k * 1024); } while (0)
#define PG8_LDB(dst, b, h) do { _Pragma("unroll") for (int n = 0; n < 2; ++n) _Pragma("unroll") for (int k = 0; k < 2; ++k) dst[n][k] = *(const PG8_LAS bf16x8*)(lds + PG8_SB(b, h) + boff + n * 2048 + k * 1024); } while (0)
#define PG8_MMA(ai, bj, At, Bt) do { __builtin_amdgcn_s_setprio(1); _Pragma("unroll") for (int m = 0; m < 4; ++m) _Pragma("unroll") for (int n = 0; n < 2; ++n) _Pragma("unroll") for (int k = 0; k < 2; ++k) \
        acc[ai][bj][m][n] = __builtin_amdgcn_mfma_f32_16x16x32_bf16(Bt[n][k], At[m][k], acc[ai][bj][m][n], 0, 0, 0); __builtin_amdgcn_s_setprio(0); } while (0)
#define PG8_WAIT_V(n) asm volatile("s_waitcnt vmcnt(" #n ")" ::: "memory")
#define PG8_WAIT_L(n) asm volatile("s_waitcnt lgkmcnt(" #n ")" ::: "memory")
#define PG8_BAR __builtin_amdgcn_s_barrier()
#define PG8_SCHED __builtin_amdgcn_sched_barrier(0)
    Unit cur, nxt; int ui = 0;
    if (!S.next(0, cur)) return;
    f32x4 acc[2][2][4][2];
#pragma unroll
    for (int a = 0; a < 2; ++a)
#pragma unroll
        for (int b = 0; b < 2; ++b)
#pragma unroll
            for (int m = 0; m < 4; ++m)
#pragma unroll
                for (int n = 0; n < 2; ++n) acc[a][b][m][n] = (f32x4){0.f, 0.f, 0.f, 0.f};
    bf16x8 At[4][2], B0[2][2], B1[2][2];
    const char* cA = (const char*)g.A + (size_t)cur.pm * tstep; const char* cB = (const char*)g.Bt + (size_t)cur.pn * tstep;
    S.a_ready(cur);
    if constexpr (SP2) {
        PG8_STAGE(PG8_SB(0, 0), cB, voffB); PG8_STAGE(PG8_SB(0, 1), cB + hstep, voffB); PG8_STAGE(PG8_SA(0, 0), cA, voffA); PG8_STAGE(PG8_SA(0, 1), cA + hstep, voffA);
        if (wr == 1) PG8_BAR;
        PG8_WAIT_V(2); PG8_BAR;
        PG8_STAGE(PG8_SB(1, 0), cB + kstep, voffB); PG8_STAGE(PG8_SA(1, 0), cA + kstep, voffA); PG8_STAGE(PG8_SB(1, 1), cB + hstep + kstep, voffB);
        PG8_WAIT_V(6); PG8_BAR;
    } else {
        PG8_STAGE(PG8_SB(0, 0), cB, voffB); PG8_STAGE(PG8_SA(0, 0), cA, voffA); PG8_STAGE(PG8_SB(0, 1), cB + hstep, voffB); PG8_STAGE(PG8_SA(0, 1), cA + hstep, voffA);
        if (wr == 1) PG8_BAR;
        PG8_WAIT_V(4); PG8_BAR;
        PG8_STAGE(PG8_SB(1, 0), cB + kstep, voffB); PG8_STAGE(PG8_SA(1, 0), cA + kstep, voffA); PG8_STAGE(PG8_SB(1, 1), cB + hstep + kstep, voffB);
        PG8_WAIT_V(6); PG8_BAR;
    }
    for (;;) {
        const bool has_next = S.next(ui + 1, nxt);
        const char* nA = has_next ? (const char*)g.A + (size_t)nxt.pm * tstep : cA; const char* nB = has_next ? (const char*)g.Bt + (size_t)nxt.pn * tstep : cB;
        for (int t = 0; t < nt; t += 2) {
            const bool last = (t == nt - 2);
            const char* a1 = cA + (size_t)(t + 1) * kstep;
            const char* a2 = last ? nA : cA + (size_t)(t + 2) * kstep; const char* b2 = last ? nB : cB + (size_t)(t + 2) * kstep;
            const char* a3 = a2 + kstep; const char* b3 = b2 + kstep;
            if (last && has_next) S.a_ready(nxt);
            if constexpr (SP2) {
            PG8_LDB(B0, 0, 0); PG8_LDB(B1, 0, 1); PG8_SCHED; PG8_LDA(At, 0, 0); PG8_STAGE(PG8_SA(1, 1), a1 + hstep, voffA);
            PG8_WAIT_V(8); PG8_WAIT_L(0); PG8_BAR; PG8_MMA(0, 0, At, B0); PG8_MMA(0, 1, At, B1); PG8_BAR; PG8_SCHED;
            PG8_LDA(At, 0, 1); PG8_STAGE(PG8_SB(0, 0), b2, voffB); PG8_STAGE(PG8_SB(0, 1), b2 + hstep, voffB); PG8_STAGE(PG8_SA(0, 0), a2, voffA);
            PG8_WAIT_V(8); PG8_WAIT_L(0); PG8_BAR; PG8_MMA(1, 0, At, B0); PG8_MMA(1, 1, At, B1); PG8_BAR; PG8_SCHED;
            PG8_LDB(B0, 1, 0); PG8_LDB(B1, 1, 1); PG8_SCHED; PG8_LDA(At, 1, 0); PG8_STAGE(PG8_SA(0, 1), a2 + hstep, voffA);
            PG8_WAIT_V(8); PG8_WAIT_L(0); PG8_BAR; PG8_MMA(0, 0, At, B0); PG8_MMA(0, 1, At, B1); PG8_BAR; PG8_SCHED;
            PG8_LDA(At, 1, 1); PG8_STAGE(PG8_SB(1, 0), b3, voffB); PG8_STAGE(PG8_SB(1, 1), b3 + hstep, voffB); PG8_STAGE(PG8_SA(1, 0), a3, voffA);
            PG8_WAIT_V(8); PG8_WAIT_L(0); PG8_BAR; PG8_MMA(1, 0, At, B0); PG8_MMA(1, 1, At, B1); PG8_BAR; PG8_SCHED;
            } else {
            PG8_LDB(B0, 0, 0); PG8_SCHED; PG8_LDA(At, 0, 0); PG8_STAGE(PG8_SA(1, 1), a1 + hstep, voffA);
            PG8_WAIT_L(8); PG8_BAR; PG8_WAIT_L(0); PG8_MMA(0, 0, At, B0); PG8_BAR; PG8_SCHED;
            PG8_LDB(B1, 0, 1); PG8_STAGE(PG8_SB(0, 0), b2, voffB);
            PG8_BAR; PG8_WAIT_L(0); PG8_MMA(0, 1, At, B1); PG8_BAR;
            PG8_LDA(At, 0, 1); PG8_STAGE(PG8_SA(0, 0), a2, voffA);
            PG8_BAR; PG8_WAIT_L(0); PG8_MMA(1, 0, At, B0); PG8_BAR; PG8_SCHED;
            PG8_STAGE(PG8_SB(0, 1), b2 + hstep, voffB);
            PG8_WAIT_V(6); PG8_BAR; PG8_MMA(1, 1, At, B1); PG8_BAR;
            PG8_LDB(B0, 1, 0); PG8_SCHED; PG8_LDA(At, 1, 0); PG8_STAGE(PG8_SA(0, 1), a2 + hstep, voffA);
            PG8_WAIT_L(8); PG8_BAR; PG8_WAIT_L(0); PG8_MMA(0, 0, At, B0); PG8_BAR; PG8_SCHED;
            PG8_LDB(B1, 1, 1); PG8_STAGE(PG8_SB(1, 0), b3, voffB);
            PG8_BAR; PG8_WAIT_L(0); PG8_MMA(0, 1, At, B1); PG8_BAR;
            PG8_LDA(At, 1, 1); PG8_STAGE(PG8_SA(1, 0), a3, voffA);
            PG8_BAR; PG8_WAIT_L(0); PG8_MMA(1, 0, At, B0); PG8_BAR; PG8_SCHED;
            PG8_STAGE(PG8_SB(1, 1), b3 + hstep, voffB);
            PG8_WAIT_V(6); PG8_BAR; PG8_MMA(1, 1, At, B1); PG8_BAR;
            }
        }
        if constexpr (ALIGN_EPI) { if (wr == 0) PG8_BAR; }
        if constexpr (!Epi::AFTER_DRAIN) { E(acc, cur, wr, wc, fr, fq); S.done(cur); }
        if (!has_next) break;
#pragma unroll
        for (int a = 0; a < 2; ++a)
#pragma unroll
            for (int b = 0; b < 2; ++b)
#pragma unroll
                for (int m = 0; m < 4; ++m)
#pragma unroll
                    for (int n = 0; n < 2; ++n) acc[a][b][m][n] = (f32x4){0.f, 0.f, 0.f, 0.f};
        cur = nxt; cA = nA; cB = nB; ++ui;
        if constexpr (ALIGN_EPI) { if (wr == 1) PG8_BAR; }
    }
    PG8_WAIT_V(0);
    if constexpr (!ALIGN_EPI) { if (wr == 0) PG8_BAR; }
    PG8_BAR;
    if constexpr (Epi::AFTER_DRAIN) { E.fused(acc, cur, wr, wc, fr, fq, lds, wid, lane); S.done(cur); }
#undef PG8_SA
#undef PG8_SB
#undef PG8_STAGE
#undef PG8_LDA
#undef PG8_LDB
#undef PG8_MMA
#undef PG8_WAIT_V
#undef PG8_WAIT_L
#undef PG8_BAR
#undef PG8_SCHED
}
}

namespace att {
using bf16x8 = __attribute__((ext_vector_type(8))) short;
using s16x4  = __attribute__((ext_vector_type(4))) short;
using f32x16 = __attribute__((ext_vector_type(16))) float;
using u32x4  = __attribute__((ext_vector_type(4))) unsigned;
typedef unsigned short bf16;
constexpr int NW = 8, QBLK = 32, KVBLK = 64, LDQ = 768, LDK = 768, LDY = 1024, SEQK = 4352;
constexpr float SCALE = 0.125f, THR = 8.f;
constexpr int SDEPTH = 2;
constexpr size_t SHM_V = KVBLK * 128 * 2, SHM_K = KVBLK * 128 * 2, SHM_ATTN = 2 * SHM_V + 2 * SHM_K + NW * 64 * 4;
#define KSWZ(row, colB) ((row) * 256 + ((colB) ^ (((row) & 7) << 4)))
#define SBAR() __builtin_amdgcn_sched_barrier(0)
__device__ __forceinline__ int crow(int r, int hi) { return (r & 3) + 8 * (r >> 2) + 4 * hi; }
__device__ __forceinline__ unsigned cvtpk(float lo, float hi) { unsigned r; asm volatile("v_cvt_pk_bf16_f32 %0, %1, %2" : "=v"(r) : "v"(lo), "v"(hi)); return r; }
__device__ __forceinline__ unsigned short f2bf(float f) { unsigned u = __builtin_bit_cast(unsigned, f); return (unsigned short)((u + 0x7fffu + ((u >> 16) & 1u)) >> 16); }

__device__ __forceinline__ void partialSM(f32x16& p0, f32x16& p1, float& m_reg, float& mn, float& alpha) {
  constexpr float C = SCALE * 1.4426950408889634f;
  float pmax = p0[0];
#pragma unroll
  for (int r = 1; r < 16; ++r) pmax = fmaxf(pmax, p0[r]);
#pragma unroll
  for (int r = 0; r < 16; ++r) pmax = fmaxf(pmax, p1[r]);
  { auto rr = __builtin_amdgcn_permlane32_swap(__float_as_uint(pmax), __float_as_uint(pmax), false, false);
    pmax = fmaxf(__uint_as_float(rr[0]), __uint_as_float(rr[1])); }
  if (__builtin_expect(__all(pmax - m_reg <= THR / SCALE), 1)) { mn = m_reg; alpha = 1.f; }
  else { mn = fmaxf(m_reg, pmax); alpha = __builtin_amdgcn_exp2f((m_reg - mn) * C); m_reg = mn; }
  float mnC = -mn * C;
#pragma unroll
  for (int r = 0; r < 16; ++r) p0[r] = fmaf(p0[r], C, mnC);
#pragma unroll
  for (int r = 0; r < 16; ++r) p1[r] = fmaf(p1[r], C, mnC);
#pragma unroll
  for (int r = 0; r < 16; ++r) p0[r] = __builtin_amdgcn_exp2f(p0[r]);
}
__device__ __forceinline__ void partialSM_fixed(f32x16& p0, f32x16& p1, float mBC) {
  constexpr float C = SCALE * 1.4426950408889634f;
#pragma unroll
  for (int r = 0; r < 16; ++r) p0[r] = fmaf(p0[r], C, mBC);
#pragma unroll
  for (int r = 0; r < 16; ++r) p1[r] = fmaf(p1[r], C, mBC);
#pragma unroll
  for (int r = 0; r < 16; ++r) p0[r] = __builtin_amdgcn_exp2f(p0[r]);
}
__device__ __forceinline__ void finishSM(f32x16& p0, f32x16& p1, float alpha, float& l_reg, bf16x8& pa0, bf16x8& pa1, bf16x8& pa2, bf16x8& pa3) {
#pragma unroll
  for (int r = 0; r < 16; ++r) p1[r] = __builtin_amdgcn_exp2f(p1[r]);
  float ps = 0;
#pragma unroll
  for (int r = 0; r < 16; ++r) ps += p0[r];
#pragma unroll
  for (int r = 0; r < 16; ++r) ps += p1[r];
  { auto rr = __builtin_amdgcn_permlane32_swap(__float_as_uint(ps), __float_as_uint(ps), false, false);
    ps = __uint_as_float(rr[0]) + __uint_as_float(rr[1]); }
  l_reg = l_reg * alpha + ps;
#define PK4(P, BASE, OUT) do { unsigned a0 = cvtpk(P[BASE + 0], P[BASE + 1]), a1 = cvtpk(P[BASE + 2], P[BASE + 3]);   \
    unsigned b0 = cvtpk(P[BASE + 4], P[BASE + 5]), b1 = cvtpk(P[BASE + 6], P[BASE + 7]);                              \
    auto r0 = __builtin_amdgcn_permlane32_swap(a0, b0, false, false); auto r1 = __builtin_amdgcn_permlane32_swap(a1, b1, false, false); \
    u32x4 w = {r0[0], r1[0], r0[1], r1[1]}; OUT = *reinterpret_cast<bf16x8*>(&w); } while (0)
  PK4(p0, 0, pa0); PK4(p0, 8, pa1); PK4(p1, 0, pa2); PK4(p1, 8, pa3);
#undef PK4
}
__device__ __forceinline__ void qkt(f32x16& p0, f32x16& p1, const bf16* Ks, const bf16x8* qr, int r32, int hi, int comp) {
  p0 = f32x16{}; p1 = f32x16{};
#pragma unroll
  for (int d0 = 0; d0 < 4; ++d0) { int cb = (comp * 64 + d0 * 16 + hi * 8) * 2;
    bf16x8 b0 = *reinterpret_cast<const bf16x8*>((const char*)Ks + KSWZ(r32, cb));
    bf16x8 b1 = *reinterpret_cast<const bf16x8*>((const char*)Ks + KSWZ(32 + r32, cb));
    p0 = __builtin_amdgcn_mfma_f32_32x32x16_bf16(b0, qr[d0], p0, 0, 0, 0);
    p1 = __builtin_amdgcn_mfma_f32_32x32x16_bf16(b1, qr[d0], p1, 0, 0, 0); }
}
__device__ __forceinline__ int v_st(int k, int c) { const int kk = (k & ~0xC) | ((k & 4) << 1) | ((k & 8) >> 1); return ((kk >> 3) * 4 + (c >> 5)) * 512 + ((kk & 7) * 32 + (c & 31)) * 2; }
__device__ __forceinline__ int v_rd_base(int lane) { return ((lane & 3) << 3) | (((lane >> 2) & 3) << 6) | (((lane >> 4) & 1) << 5) | (((lane >> 5) & 1) << 8); }
constexpr int v_rd_off(int d0, int ks, int half) { return d0 * 512 + ks * 4096 + half * 2048; }
template <int OFF> __device__ __forceinline__ s16x4 tr_read(int vb) {
  s16x4 r; asm volatile("ds_read_b64_tr_b16 %0, %1 offset:%2" : "=&v"(r) : "v"(vb), "i"(OFF) : "memory"); return r;
}
template <int D0> __device__ __forceinline__ void pv_one(f32x16& od, int vb, bf16x8 pa0, bf16x8 pa1, bf16x8 pa2, bf16x8 pa3) {
  const s16x4 l0 = tr_read<v_rd_off(D0, 0, 0)>(vb), h0 = tr_read<v_rd_off(D0, 0, 1)>(vb), l1 = tr_read<v_rd_off(D0, 1, 0)>(vb), h1 = tr_read<v_rd_off(D0, 1, 1)>(vb);
  const s16x4 l2 = tr_read<v_rd_off(D0, 2, 0)>(vb), h2 = tr_read<v_rd_off(D0, 2, 1)>(vb), l3 = tr_read<v_rd_off(D0, 3, 0)>(vb), h3 = tr_read<v_rd_off(D0, 3, 1)>(vb);
  asm volatile("s_waitcnt lgkmcnt(0)" ::: "memory"); SBAR();
#define PK(L, H) (bf16x8){L[0], L[1], L[2], L[3], H[0], H[1], H[2], H[3]}
  od = __builtin_amdgcn_mfma_f32_32x32x16_bf16(pa0, PK(l0, h0), od, 0, 0, 0);
  od = __builtin_amdgcn_mfma_f32_32x32x16_bf16(pa1, PK(l1, h1), od, 0, 0, 0);
  od = __builtin_amdgcn_mfma_f32_32x32x16_bf16(pa2, PK(l2, h2), od, 0, 0, 0);
  od = __builtin_amdgcn_mfma_f32_32x32x16_bf16(pa3, PK(l3, h3), od, 0, 0, 0);
#undef PK
}
__device__ __forceinline__ void pv_d0(f32x16* o, int vb, bf16x8 pa0, bf16x8 pa1, bf16x8 pa2, bf16x8 pa3) {
  pv_one<0>(o[0], vb, pa0, pa1, pa2, pa3); pv_one<1>(o[1], vb, pa0, pa1, pa2, pa3); pv_one<2>(o[2], vb, pa0, pa1, pa2, pa3); pv_one<3>(o[3], vb, pa0, pa1, pa2, pa3);
}

template <bool FIXED> __device__ __forceinline__ void attn_unit(const bf16* __restrict__ Qb, const bf16* __restrict__ Kh, const bf16* __restrict__ Vh, bf16* __restrict__ Yb,
                                          const float* __restrict__ subg, float lam, float mBC, char* lds) {
  const int tid = ltid(), wid = tid >> 6, lane = tid & 63, r32 = lane & 31, hi = lane >> 5;
  const int comp = wid >> 2, wq = wid & 3;
  bf16* V_lds = (bf16*)lds; bf16* K_lds = (bf16*)(lds + 2 * SHM_V);
  float* ws = (float*)(lds + 2 * SHM_V + 2 * SHM_K) + wid * 64; float* li_l = ws; float* al_l = ws + 32;
  float m_reg = -1e30f, l_reg = 0; f32x16 o[4] = {}; bf16x8 qr[4];
  const bf16* Qw = Qb + (long)(wq * QBLK + r32) * LDQ + comp * 64 + hi * 8;
#pragma unroll
  for (int d0 = 0; d0 < 4; ++d0) qr[d0] = *reinterpret_cast<const bf16x8*>(Qw + d0 * 16);
  const int sr = tid >> 4, sc = (tid & 15) * 8, vst0 = v_st(sr, sc), vst1 = v_st(32 + sr, sc);
  const int vb0 = (int)(uintptr_t)V_lds + v_rd_base(lane);
  struct { bf16x8 vs0, vs1, ks0, ks1; } sr_[SDEPTH];
#define SLOAD(i, k0) do { sr_[i].vs0 = *reinterpret_cast<const bf16x8*>(&Vh[(long)((k0) + sr) * LDK + sc]); sr_[i].vs1 = *reinterpret_cast<const bf16x8*>(&Vh[(long)((k0) + 32 + sr) * LDK + sc]); \
    sr_[i].ks0 = *reinterpret_cast<const bf16x8*>(&Kh[(long)((k0) + sr) * LDK + sc]); sr_[i].ks1 = *reinterpret_cast<const bf16x8*>(&Kh[(long)((k0) + 32 + sr) * LDK + sc]); } while (0)
#define SWRITE(b, i) do { *(bf16x8*)((char*)V_lds + (b) * SHM_V + vst0) = sr_[i].vs0;          \
    *(bf16x8*)((char*)V_lds + (b) * SHM_V + vst1) = sr_[i].vs1; int kc = sc * 2;               \
    *(bf16x8*)((char*)K_lds + (b) * SHM_K + KSWZ(sr, kc)) = sr_[i].ks0;                       \
    *(bf16x8*)((char*)K_lds + (b) * SHM_K + KSWZ(32 + sr, kc)) = sr_[i].ks1; } while (0)
#define SWAIT() do { asm volatile("s_waitcnt vmcnt(4)" ::: "memory"); } while (0)
#define PSM(P0, P1, MN, AL) do { if constexpr (FIXED) { partialSM_fixed(P0, P1, mBC); AL = 1.f; } else partialSM(P0, P1, m_reg, MN, AL); } while (0)
#define RESC(a) do { if constexpr (!FIXED) if (__any((a) < 1.f)) { if (hi == 0) al_l[r32] = (a); asm volatile("s_waitcnt lgkmcnt(0)" ::: "memory"); \
    _Pragma("unroll") for (int d = 0; d < 4; ++d) _Pragma("unroll") for (int r = 0; r < 16; ++r) o[d][r] *= al_l[crow(r, hi)]; } } while (0)
  f32x16 pA0, pA1, pB0, pB1; float mnA, mnB, alA, alB; bf16x8 pa0, pa1, pa2, pa3; constexpr int NT = SEQK / KVBLK;
  constexpr int SE = 0, SO = SDEPTH - 1;
  SLOAD(SE, 0); asm volatile("s_waitcnt vmcnt(0)" ::: "memory"); SWRITE(0, SE); __syncthreads();
  qkt(pA0, pA1, K_lds, qr, r32, hi, comp); PSM(pA0, pA1, mnA, alA);
  SLOAD(SO, KVBLK); if (2 < NT) SLOAD(SE, 2 * KVBLK);
  SWAIT(); SWRITE(1, SO); __syncthreads();
  for (int j = 1; j + 1 < NT; j += 2) {
    SBAR(); qkt(pB0, pB1, (bf16*)((char*)K_lds + SHM_K), qr, r32, hi, comp);
    finishSM(pA0, pA1, alA, l_reg, pa0, pa1, pa2, pa3); SBAR();
    SLOAD(SO, (j + SDEPTH) * KVBLK); SBAR();
    pv_d0(o, vb0, pa0, pa1, pa2, pa3); PSM(pB0, pB1, mnB, alB);
    __syncthreads(); SWAIT(); SWRITE(0, SE);
    RESC(alB); __syncthreads();
    SBAR(); qkt(pA0, pA1, K_lds, qr, r32, hi, comp);
    finishSM(pB0, pB1, alB, l_reg, pa0, pa1, pa2, pa3); SBAR();
    if (j + 3 < NT) SLOAD(SE, (j + 1 + SDEPTH) * KVBLK); SBAR();
    pv_d0(o, vb0 + (int)SHM_V, pa0, pa1, pa2, pa3); PSM(pA0, pA1, mnA, alA);
    __syncthreads(); SWAIT(); SWRITE(1, SO);
    RESC(alA); __syncthreads();
  }
  SBAR(); qkt(pB0, pB1, (bf16*)((char*)K_lds + SHM_K), qr, r32, hi, comp);
  finishSM(pA0, pA1, alA, l_reg, pa0, pa1, pa2, pa3); SBAR();
  pv_d0(o, vb0, pa0, pa1, pa2, pa3); PSM(pB0, pB1, mnB, alB);
  __syncthreads(); RESC(alB);
  finishSM(pB0, pB1, alB, l_reg, pa0, pa1, pa2, pa3); SBAR();
  pv_d0(o, vb0 + (int)SHM_V, pa0, pa1, pa2, pa3);
  if (hi == 0) li_l[r32] = l_reg; asm volatile("s_waitcnt lgkmcnt(0)" ::: "memory");
  float rli[16];
#pragma unroll
  for (int r = 0; r < 16; ++r) rli[r] = __builtin_amdgcn_rcpf(li_l[crow(r, hi)]);
  __syncthreads();
  float* X = (float*)lds + wq * 4096;
  if (comp == 1) {
#pragma unroll
    for (int d0 = 0; d0 < 4; ++d0)
#pragma unroll
      for (int r = 0; r < 16; ++r) X[(d0 * 16 + r) * 64 + lane] = o[d0][r] * rli[r] * lam;
  }
  __syncthreads();
  if (comp == 0) {
    float ss[16];
#pragma unroll
    for (int r = 0; r < 16; ++r) ss[r] = 0.f;
#pragma unroll
    for (int d0 = 0; d0 < 4; ++d0)
#pragma unroll
      for (int r = 0; r < 16; ++r) { const float d = o[d0][r] * rli[r] - X[(d0 * 16 + r) * 64 + lane]; o[d0][r] = d; ss[r] += d * d; }
#pragma unroll
    for (int r = 0; r < 16; ++r) {
#pragma unroll
      for (int off = 1; off < 32; off <<= 1) ss[r] += __shfl_xor(ss[r], off);
    }
    float g4[4];
#pragma unroll
    for (int d0 = 0; d0 < 4; ++d0) g4[d0] = subg[d0 * 32 + r32] * 0.8f;
#pragma unroll
    for (int r = 0; r < 16; ++r) { const float rs = rsqrtf(ss[r] * (1.f / 128.f) + 1e-6f); bf16* yrow = Yb + (long)(wq * QBLK + crow(r, hi)) * LDY;
#pragma unroll
      for (int d0 = 0; d0 < 4; ++d0) yrow[d0 * 32 + r32] = f2bf(o[d0][r] * rs * g4[d0]); }
  }
  __syncthreads();
#undef SLOAD
#undef SWRITE
#undef SWAIT
#undef RESC
#undef PSM
}
#undef SBAR
}


#ifndef MK_DEBUG
#define MK_DEBUG 0
#endif
#define PROBE_XB
#ifndef MK_SIMPLE6
#define MK_SIMPLE6 0
#endif
#ifndef NPH_RUN
#define NPH_RUN 16
#endif
#ifndef PHMASK
#define PHMASK 0xFFFF
#endif
#define PHM(k) ((PHMASK >> (k)) & 1)
#ifndef MK_MULTI
#define MK_MULTI 0
#endif
#define LAS __attribute__((address_space(3)))
#define GAS __attribute__((address_space(1)))
typedef unsigned short bf16;
typedef unsigned v4u __attribute__((ext_vector_type(4)));
typedef unsigned v2u __attribute__((ext_vector_type(2)));
typedef float f32x4 __attribute__((ext_vector_type(4)));
typedef short bf16x8 __attribute__((ext_vector_type(8)));
typedef float f32x16 __attribute__((ext_vector_type(16)));
#define LDS_WAIT() asm volatile("s_waitcnt lgkmcnt(0)" ::: "memory")
constexpr int NWAVES = 8, NTHR = 512, NPH = 16;
constexpr int SEQ = 4096, DM = 1024, MTOK = 16384, TKV = 4352, FF = 4096, MODW = 6144;
constexpr size_t MiB = 1u << 20;
constexpr size_t WS_MOD = 1 * MiB, WS_WIN = 2 * MiB, WS_WOUT = 7 * MiB, WS_W1 = 9 * MiB, WS_W2 = 25 * MiB, WS_ODIN = 41 * MiB, WS_ODOUT = 49 * MiB;
constexpr size_t WS_XN = 56 * MiB;
constexpr size_t WS_Q = 92 * MiB, WS_K = 116 * MiB, WS_V = 142 * MiB, WS_POOL = 168 * MiB, WS_Y = 176 * MiB;
constexpr size_t WS_HB = 92 * MiB;
constexpr size_t WS_U = 92 * MiB, WS_VT = 156 * MiB;
constexpr size_t WS_END = 220 * MiB;
constexpr int LDS_BYTES = 147456;

__device__ __forceinline__ unsigned f2bf(float f) { unsigned u = __builtin_bit_cast(unsigned, f); return (u + 0x7fffu + ((u >> 16) & 1u)) >> 16; }
__device__ __forceinline__ unsigned pk2(float lo, float hi) { return f2bf(lo) | (f2bf(hi) << 16); }
__device__ __forceinline__ float bflo(unsigned w) { return __builtin_bit_cast(float, w << 16); }
__device__ __forceinline__ float bfhi(unsigned w) { return __builtin_bit_cast(float, w & 0xffff0000u); }
__device__ __forceinline__ float wave_sum(float v) {
#pragma unroll
    for (int o = 1; o < 64; o <<= 1) v += __shfl_xor(v, o);
    return v;
}

struct Args { const float* in[27]; float* out; unsigned char* ws; int ph_lo, ph_hi; };

__device__ __forceinline__ void p0_transpose_item(const float* W, int K, int N, bf16* WT, LAS float* scr, int item, int lane) {
    const int nblk = N / 32, kb = item / nblk, nb = item % nblk, k0 = 64 * kb, n0 = 32 * nb;
#pragma unroll 8
    for (int i = 0; i < 32; ++i) { const int kk = 2 * i + (lane >> 5); scr[kk * 33 + (lane & 31)] = W[(size_t)(k0 + kk) * N + n0 + (lane & 31)]; }
    LDS_WAIT(); asm volatile("" ::: "memory");
    const int c = lane & 7;
#pragma unroll
    for (int j = 0; j < 4; ++j) { const int n = (lane >> 3) + 8 * j; const LAS float* s = scr + (8 * c) * 33 + n;
        v4u o; o.x = pk2(s[0 * 33], s[1 * 33]); o.y = pk2(s[2 * 33], s[3 * 33]); o.z = pk2(s[4 * 33], s[5 * 33]); o.w = pk2(s[6 * 33], s[7 * 33]);
        *(v4u*)(WT + (size_t)(n0 + n) * K + k0 + 8 * c) = o; }
    LDS_WAIT(); asm volatile("" ::: "memory");
}
__device__ __forceinline__ void p0_prep(const Args& a, unsigned char* ldsg, int vcu, int G) {
    LAS unsigned char* lds = (LAS unsigned char*)ldsg;
    const int tid = ltid(), lane = tid & 63, wave = tid >> 6;
    float* mod = (float*)(a.ws + WS_MOD);
    for (int item = blockIdx.x; item < 192; item += G) {
        LAS float* sin_ = (LAS float*)lds;
        for (int i = tid; i < 5 * 1024; i += NTHR) { const int r = i >> 10, k = i & 1023; const float c = r < 4 ? a.in[1][r * 1024 + k] : a.in[3][k]; sin_[i] = c / (1.f + __expf(-c)); }
        __syncthreads();
        const int l = item / 96, cb = item % 96;
        const float* W = a.in[4] + (size_t)l * 1024 * MODW + cb * 64 + lane;
        float acc[5] = {0.f, 0.f, 0.f, 0.f, 0.f};
        const int k0 = wave * 128;
#pragma unroll 8
        for (int kk = 0; kk < 128; ++kk) { const int k = k0 + kk; const float w = W[(size_t)k * MODW];
#pragma unroll
            for (int r = 0; r < 5; ++r) acc[r] += sin_[r * 1024 + k] * w; }
        LAS float* red = (LAS float*)(lds + 20480);
#pragma unroll
        for (int r = 0; r < 5; ++r) red[(wave * 5 + r) * 64 + lane] = acc[r];
        __syncthreads();
        if (tid < 320) { const int r = tid >> 6, col = tid & 63; float s = 0.f;
#pragma unroll
            for (int w = 0; w < 8; ++w) s += red[(w * 5 + r) * 64 + col];
            s += a.in[5][l * MODW + cb * 64 + col]; mod[(size_t)(l * 5 + r) * MODW + cb * 64 + col] = s; }
        __syncthreads();
    }
    LAS float* scr = (LAS float*)(lds + 32768 + wave * 8448);
    const int gw = vcu * NWAVES + wave, NGW = G * NWAVES;
    constexpr int I_WIN = 16 * 80, I_WOUT = 16 * 32, I_W1 = 16 * 128, I_W2 = 64 * 32, I_ODIN = 16 * 128, I_ODOUT = 32 * 32;
    constexpr int NITEMS = I_WIN + I_WOUT + 2 * I_W1 + 2 * I_W2 + I_ODIN + I_ODOUT;
    for (int it = gw; it < NITEMS; it += NGW) {
        int r = it;
        if (r < I_WIN) { p0_transpose_item(a.in[10], 1024, 2560, (bf16*)(a.ws + WS_WIN), scr, r, lane); continue; } r -= I_WIN;
        if (r < I_WOUT) { p0_transpose_item(a.in[11], 1024, 1024, (bf16*)(a.ws + WS_WOUT), scr, r, lane); continue; } r -= I_WOUT;
        if (r < 2 * I_W1) { const int l = r / I_W1; p0_transpose_item(a.in[8] + (size_t)l * 1024 * 4096, 1024, 4096, (bf16*)(a.ws + WS_W1) + (size_t)l * 4096 * 1024, scr, r % I_W1, lane); continue; } r -= 2 * I_W1;
        if (r < 2 * I_W2) { const int l = r / I_W2; p0_transpose_item(a.in[9] + (size_t)l * 4096 * 1024, 4096, 1024, (bf16*)(a.ws + WS_W2) + (size_t)l * 1024 * 4096, scr, r % I_W2, lane); continue; } r -= 2 * I_W2;
        if (r < I_ODIN) { p0_transpose_item(a.in[21], 1024, 4096, (bf16*)(a.ws + WS_ODIN), scr, r, lane); continue; } r -= I_ODIN;
        p0_transpose_item(a.in[26], 2048, 1024, (bf16*)(a.ws + WS_ODOUT), scr, r, lane);
    }
}

__device__ __forceinline__ void norm_row(const float* xrow, bf16* orow, const f32x4 (&gs)[4], const f32x4 (&sh)[4], int lane) {
    const f32x4* xr = (const f32x4*)xrow + lane;
    f32x4 v[4]; float s2 = 0.f;
#pragma unroll
    for (int j = 0; j < 4; ++j) { v[j] = xr[64 * j]; s2 += (v[j].x * v[j].x + v[j].y * v[j].y) + (v[j].z * v[j].z + v[j].w * v[j].w); }
    const float rstd = rsqrtf(wave_sum(s2) * (1.f / 1024.f) + 1e-6f);
    unsigned long long* o8 = (unsigned long long*)orow + lane;
#pragma unroll
    for (int j = 0; j < 4; ++j) { const f32x4 y = v[j] * rstd * gs[j] + sh[j];
        o8[64 * j] = (unsigned long long)pk2(y.x, y.y) | ((unsigned long long)pk2(y.z, y.w) << 32); }
}
__device__ __forceinline__ void load_mod(const float* g, const float* shp, const float* scp, f32x4 (&gs)[4], f32x4 (&sh)[4], int lane) {
#pragma unroll
    for (int j = 0; j < 4; ++j) { const int idx = 4 * lane + 256 * j; const f32x4 gv = *(const f32x4*)(g + idx), sv = *(const f32x4*)(scp + idx); gs[j] = gv * (sv + 1.0f); sh[j] = *(const f32x4*)(shp + idx); }
}
__device__ __forceinline__ void norm_phase(const float* src, const float* g, const float* modl, int sh_off, int sc_off, bf16* dst, const float* ctx, int vcu, int G) {
    const int tid = ltid(), lane = tid & 63, wave = tid >> 6;
    for (int rb = vcu; rb < 256; rb += G) {
        const int b = rb >> 6; f32x4 gs[4], sh[4];
        load_mod(g, modl + (size_t)b * MODW + sh_off, modl + (size_t)b * MODW + sc_off, gs, sh, lane);
        for (int rr = 0; rr < 8; ++rr) { const size_t row = (size_t)rb * 64 + wave * 8 + rr; norm_row(src + row * 1024, dst + row * 1024, gs, sh, lane); }
        if (ctx && wave < 4) {
            load_mod(g, modl + (size_t)4 * MODW + sh_off, modl + (size_t)4 * MODW + sc_off, gs, sh, lane);
            const size_t row = (size_t)rb * 4 + wave; norm_row(ctx + row * 1024, dst + ((size_t)MTOK + row) * 1024, gs, sh, lane);
        }
    }
}

__device__ __forceinline__ void qknorm_pool_phase(const Args& a, unsigned char* lds, int vcu, int G) {
    const int tid = ltid(), lane = tid & 63, wave = tid >> 6;
    float2* tab = (float2*)lds;
    for (int i = tid; i < 1024; i += NTHR) { const int pos = i >> 4, f = i & 15; const float inv = powf(10000.0f, -(float)f / 16.0f); const float ang = (float)pos * inv; float s, c; sincosf(ang, &s, &c); tab[i] = make_float2(c, s); }
    __syncthreads();
    bf16* Q = (bf16*)(a.ws + WS_Q); bf16* KA = (bf16*)(a.ws + WS_K);
    const float* qg = a.in[14]; const float* kg = a.in[15];
    constexpr int NGQ = MTOK * 12, NGC = 1024 * 12, NITEM = (2 * NGQ + NGC) * 8;
    const int part = tid & 7;
    const f32x4 qg0 = *(const f32x4*)(qg + part * 8), qg1 = *(const f32x4*)(qg + part * 8 + 4), kg0 = *(const f32x4*)(kg + part * 8), kg1 = *(const f32x4*)(kg + part * 8 + 4);
    const int stride = G * NTHR;
    for (int i0 = vcu * NTHR + tid; i0 < NITEM; i0 += 4 * stride) {
        bf16* pp[4]; v4u ww[4]; int tt[4]; bool isq[4], rp[4], ok[4];
#pragma unroll
        for (int k = 0; k < 4; ++k) { const int idx = i0 + k * stride; ok[k] = idx < NITEM; int gi = idx >> 3; bf16* p = Q; isq[k] = false; rp[k] = true; tt[k] = 0;
            if (gi < NGQ) { const int row = gi / 12, hg = gi - row * 12; p = Q + (size_t)row * 768 + hg * 64; isq[k] = true; tt[k] = row & 4095; }
            else if (gi < 2 * NGQ) { gi -= NGQ; const int row = gi / 12, hg = gi - row * 12; tt[k] = row & 4095; p = KA + ((size_t)(row >> 12) * TKV + 256 + tt[k]) * 768 + hg * 64; }
            else { gi -= 2 * NGQ; const int row = gi / 12, hg = gi - row * 12; p = KA + ((size_t)(row >> 8) * TKV + (row & 255)) * 768 + hg * 64; rp[k] = false; }
            pp[k] = p + part * 8; ww[k] = (v4u){0u, 0u, 0u, 0u}; if (ok[k]) ww[k] = *(const v4u*)pp[k]; }
#pragma unroll
        for (int k = 0; k < 4; ++k) { if (!ok[k]) continue;
            const v4u w = ww[k]; float x[8];
            x[0] = bflo(w.x); x[1] = bfhi(w.x); x[2] = bflo(w.y); x[3] = bfhi(w.y); x[4] = bflo(w.z); x[5] = bfhi(w.z); x[6] = bflo(w.w); x[7] = bfhi(w.w);
            float ss = 0.f;
#pragma unroll
            for (int e = 0; e < 8; ++e) ss += x[e] * x[e];
            ss += __shfl_xor(ss, 1); ss += __shfl_xor(ss, 2); ss += __shfl_xor(ss, 4);
            const float rstd = rsqrtf(ss * (1.f / 64.f) + 1e-6f);
            const f32x4 g0 = isq[k] ? qg0 : kg0, g1 = isq[k] ? qg1 : kg1;
            x[0] *= rstd * g0.x; x[1] *= rstd * g0.y; x[2] *= rstd * g0.z; x[3] *= rstd * g0.w; x[4] *= rstd * g1.x; x[5] *= rstd * g1.y; x[6] *= rstd * g1.z; x[7] *= rstd * g1.w;
            if (rp[k]) { const int t = tt[k]; const int pos = part < 4 ? (t >> 6) : (t & 63); const float2* tp = tab + pos * 16 + (part & 3) * 4;
#pragma unroll
                for (int pr = 0; pr < 4; ++pr) { const float2 cs = tp[pr]; const float x0 = x[2 * pr], x1 = x[2 * pr + 1]; x[2 * pr] = x0 * cs.x - x1 * cs.y; x[2 * pr + 1] = x0 * cs.y + x1 * cs.x; } }
            v4u o; o.x = pk2(x[0], x[1]); o.y = pk2(x[2], x[3]); o.z = pk2(x[4], x[5]); o.w = pk2(x[6], x[7]);
            *(v4u*)pp[k] = o; }
    }
    bf16* in_ = (bf16*)(lds + 8192);
    float* pooled = (float*)(lds + 8192 + 40960);
    const bf16* PI = (const bf16*)(a.ws + WS_POOL); bf16* Y = (bf16*)(a.ws + WS_Y);
    const float* pw = a.in[12]; const float* pscale = a.in[13];
    for (int tb = vcu; tb < 256; tb += G) {
        const int b = tb >> 6, t0 = (tb & 63) * 64;
        __syncthreads();
#pragma unroll
        for (int ps = 0; ps < 5; ++ps) { const int row = ps * 16 + (tid >> 5), c8 = (tid & 31) * 8, t = t0 - 8 + row;
            v4u w = {0u, 0u, 0u, 0u}; if (t >= 0 && t < SEQ) w = *(const v4u*)(PI + ((size_t)b * SEQ + t) * 256 + c8);
            *(v4u*)(in_ + row * 256 + c8) = w; }
        __syncthreads();
        { const int c = tid & 255, th = tid >> 8, hw = 1 << (c >> 6);
            for (int tt = 0; tt < 32; ++tt) { const int tl = th * 32 + tt, t = t0 + tl; const int lo = max(t - hw, 0), hi = min(t + hw, SEQ);
                float s = 0.f; for (int j = lo; j < hi; ++j) s += bflo((unsigned)in_[(j - t0 + 8) * 256 + c]);
                pooled[tl * 256 + c] = s / (float)(hi - lo) - bflo((unsigned)in_[(tl + 8) * 256 + c]); } }
        __syncthreads();
        { const int gi = wave & 3, th = wave >> 2; float pwr[64];
#pragma unroll
            for (int c = 0; c < 64; ++c) pwr[c] = pw[gi * 4096 + c * 64 + lane];
            const float psc = pscale[gi * 64 + lane];
            for (int tt = 0; tt < 32; ++tt) { const int tl = th * 32 + tt; const f32x4* pp = (const f32x4*)(pooled + tl * 256 + gi * 64); float acc = 0.f;
#pragma unroll
                for (int c4 = 0; c4 < 16; ++c4) { const f32x4 v = pp[c4]; acc += v.x * pwr[4 * c4] + v.y * pwr[4 * c4 + 1] + v.z * pwr[4 * c4 + 2] + v.w * pwr[4 * c4 + 3]; }
                Y[((size_t)b * SEQ + t0 + tl) * 1024 + gi * 64 + lane] = (bf16)f2bf(acc * psc); } }
    }
}

__device__ __forceinline__ void attn_phase(const Args& a, unsigned char* lds, int vcu, int G) {
    const int lane = ltid() & 63;
    const float s1 = wave_sum(a.in[16][lane] * a.in[17][lane]), s2 = wave_sum(a.in[18][lane] * a.in[19][lane]);
    const float lam = expf(s1) - expf(s2) + 0.2f;
    float mq = fabsf(a.in[14][lane]), mk = fabsf(a.in[15][lane]);
#pragma unroll
    for (int o = 1; o < 64; o <<= 1) { mq = fmaxf(mq, __shfl_xor(mq, o)); mk = fmaxf(mk, __shfl_xor(mk, o)); }
    const float Bq = 0.125f * 64.f * mq * mk * 1.02f;
    const bool fixed = Bq <= 20.f;
    const float mBC = -Bq * 1.4426950408889634f;
    const bf16* Q = (const bf16*)(a.ws + WS_Q); const bf16* KA = (const bf16*)(a.ws + WS_K); const bf16* VA = (const bf16*)(a.ws + WS_V); bf16* Y = (bf16*)(a.ws + WS_Y);
    const int per = 768 / G;
    for (int i = 0; i < per; ++i) { const int u = vcu * per + i, bh = u >> 5, qb = u & 31, b = bh / 6, h = bh - b * 6;
        const bf16* Qp = Q + ((size_t)b * SEQ + qb * 128) * 768 + h * 128; const bf16* Kp = KA + (size_t)b * TKV * 768 + h * 128; const bf16* Vp = VA + (size_t)b * TKV * 768 + h * 128;
        bf16* Yp = Y + ((size_t)b * SEQ + qb * 128) * 1024 + 256 + h * 128;
        if (fixed) att::attn_unit<true>(Qp, Kp, Vp, Yp, a.in[20], lam, mBC, (char*)lds);
        else       att::attn_unit<false>(Qp, Kp, Vp, Yp, a.in[20], lam, mBC, (char*)lds); }
}

__device__ __forceinline__ void spatial_phase(const Args& a, unsigned char* lds, int vcu, int G) {
    const int tid = ltid(), lane = tid & 63, wave = tid >> 6, r32 = lane & 31, hi = lane >> 5;
    const bf16* VT = (const bf16*)(a.ws + WS_VT); bf16* U = (bf16*)(a.ws + WS_U);
    const float* lng = a.in[22]; const float* lnb = a.in[23]; const float* sgw = a.in[24]; const float* sgb = a.in[25];
    constexpr int TROW = 272;
    unsigned char* T = lds;
    float* red = (float*)lds;
    float* scr = (float*)(lds + 69632) + wave * (32 * 68);
    float* stats = (float*)(lds + 69632 + 69632);
    for (int un = vcu; un < 256; un += G) {
        const int chunk = un >> 1, half = un & 1; const size_t tok0 = (size_t)chunk * 128;
        __syncthreads();
        { const int slot = tid & 15, cg = tid >> 4; float s[8], q[8];
#pragma unroll
            for (int e = 0; e < 8; ++e) { s[e] = 0.f; q[e] = 0.f; }
#pragma unroll 8
            for (int i = 0; i < 64; ++i) { const int c = cg + 32 * i; const v4u w = *(const v4u*)(VT + (size_t)c * MTOK + tok0 + slot * 8);
                float x[8]; x[0] = bflo(w.x); x[1] = bfhi(w.x); x[2] = bflo(w.y); x[3] = bfhi(w.y); x[4] = bflo(w.z); x[5] = bfhi(w.z); x[6] = bflo(w.w); x[7] = bfhi(w.w);
#pragma unroll
                for (int e = 0; e < 8; ++e) { s[e] += x[e]; q[e] += x[e] * x[e]; } }
#pragma unroll
            for (int e = 0; e < 8; ++e) { red[(cg * 128 + slot * 8 + e) * 2] = s[e]; red[(cg * 128 + slot * 8 + e) * 2 + 1] = q[e]; } }
        __syncthreads();
        if (tid < 128) { float s = 0.f, q = 0.f;
            for (int cg = 0; cg < 32; ++cg) { s += red[(cg * 128 + tid) * 2]; q += red[(cg * 128 + tid) * 2 + 1]; }
            const float mean = s * (1.f / 2048.f), var = fmaxf(q * (1.f / 2048.f) - mean * mean, 0.f);
            stats[tid * 2] = mean; stats[tid * 2 + 1] = rsqrtf(var + 1e-6f); }
        __syncthreads();
        for (int gq = 0; gq < 4; ++gq) { const int g = half * 4 + gq;
            if (gq) __syncthreads();
            { const int slot = tid & 15, cr = tid >> 4; float mu[8], rs[8];
#pragma unroll
                for (int e = 0; e < 8; ++e) { mu[e] = stats[(slot * 8 + e) * 2]; rs[e] = stats[(slot * 8 + e) * 2 + 1]; }
#pragma unroll
                for (int i = 0; i < 8; ++i) { const int cl = cr + 32 * i, c = g * 256 + cl; const v4u w = *(const v4u*)(VT + (size_t)c * MTOK + tok0 + slot * 8);
                    const float lg = lng[c], lb = lnb[c];
                    float x[8]; x[0] = bflo(w.x); x[1] = bfhi(w.x); x[2] = bflo(w.y); x[3] = bfhi(w.y); x[4] = bflo(w.z); x[5] = bfhi(w.z); x[6] = bflo(w.w); x[7] = bfhi(w.w);
#pragma unroll
                    for (int e = 0; e < 8; ++e) x[e] = (x[e] - mu[e]) * rs[e] * lg + lb;
                    v4u o; o.x = pk2(x[0], x[1]); o.y = pk2(x[2], x[3]); o.z = pk2(x[4], x[5]); o.w = pk2(x[6], x[7]);
                    *(v4u*)(T + cl * TROW + slot * 16) = o; } }
            __syncthreads();
            const int mb = (wave & 3) * 32, ch = (wave >> 2) * 128;
            bf16x8 af[8];
            { const float* wrow = sgw + ((size_t)g * 128 + mb + r32) * 128 + hi * 8;
#pragma unroll
                for (int ks = 0; ks < 8; ++ks) { const f32x4 w0 = *(const f32x4*)(wrow + ks * 16), w1 = *(const f32x4*)(wrow + ks * 16 + 4);
                    v4u p; p.x = pk2(w0.x, w0.y); p.y = pk2(w0.z, w0.w); p.z = pk2(w1.x, w1.y); p.w = pk2(w1.z, w1.w); af[ks] = __builtin_bit_cast(bf16x8, p); } }
            f32x16 o[4];
#pragma unroll
            for (int d0 = 0; d0 < 4; ++d0) { o[d0] = f32x16{};
#pragma unroll
                for (int ks = 0; ks < 8; ++ks) { const bf16x8 bfr = *(const bf16x8*)(T + (ch + d0 * 32 + r32) * TROW + (16 * ks + 8 * hi) * 2);
                    o[d0] = __builtin_amdgcn_mfma_f32_32x32x16_bf16(af[ks], bfr, o[d0], 0, 0, 0); } }
            float bias[16];
#pragma unroll
            for (int r = 0; r < 16; ++r) bias[r] = sgb[g * 128 + mb + att::crow(r, hi)];
#pragma unroll
            for (int p = 0; p < 2; ++p) {
#pragma unroll
                for (int dd = 0; dd < 2; ++dd)
#pragma unroll
                    for (int r = 0; r < 16; ++r) scr[att::crow(r, hi) * 68 + dd * 32 + r32] = o[2 * p + dd][r] + bias[r];
                LDS_WAIT(); asm volatile("" ::: "memory");
                v4u uw[4];
#pragma unroll
                for (int qq = 0; qq < 4; ++qq) { const int row = (lane >> 3) + 8 * qq, c8 = (lane & 7) * 8; uw[qq] = *(const v4u*)(U + (tok0 + mb + row) * 2048 + g * 256 + ch + p * 64 + c8); }
#pragma unroll
                for (int qq = 0; qq < 4; ++qq) { const int row = (lane >> 3) + 8 * qq, c8 = (lane & 7) * 8;
                    const f32x4 m0 = *(const f32x4*)(scr + row * 68 + c8), m1 = *(const f32x4*)(scr + row * 68 + c8 + 4);
                    bf16* up = U + (tok0 + mb + row) * 2048 + g * 256 + ch + p * 64 + c8; const v4u w = uw[qq];
                    v4u ov; ov.x = pk2(bflo(w.x) * m0.x, bfhi(w.x) * m0.y); ov.y = pk2(bflo(w.y) * m0.z, bfhi(w.y) * m0.w);
                    ov.z = pk2(bflo(w.z) * m1.x, bfhi(w.z) * m1.y); ov.w = pk2(bflo(w.w) * m1.z, bfhi(w.w) * m1.w);
                    *(v4u*)up = ov; }
                LDS_WAIT(); asm volatile("" ::: "memory");
            }
        }
    }
}


#if MK_DEBUG
__device__ __forceinline__ float bfr(float f) { return __builtin_bit_cast(float, f2bf(f) << 16); }
__device__ __forceinline__ float bf2f(bf16 v) { return __builtin_bit_cast(float, (unsigned)v << 16); }
__device__ __forceinline__ void rec(float* res, int st, float got, float want) { float e = fabsf(got - want) / (fabsf(want) + 0.1f); if (!(e == e) || e > 1e30f) e = 0.77f; else e = fminf(e, 0.6f); atomicMax((unsigned*)res + st, __float_as_uint(e)); }
__device__ __forceinline__ unsigned hsh(unsigned s) { s ^= s >> 16; s *= 0x7feb352du; s ^= s >> 15; s *= 0x846ca68bu; s ^= s >> 16; return s; }
__global__ void chk_mod(Args a, float* res) {
    const int i = blockIdx.x * 256 + threadIdx.x; if (i >= 2 * 5 * 6144) return; const int l = i / (5 * 6144), r = (i / 6144) % 5, n = i % 6144;
    float s = 0.f; for (int k = 0; k < 1024; ++k) { const float c = r < 4 ? a.in[1][r * 1024 + k] : a.in[3][k]; s += (c / (1.f + expf(-c))) * a.in[4][((size_t)l * 1024 + k) * 6144 + n]; }
    s += a.in[5][l * 6144 + n]; rec(res, 0, ((const float*)(a.ws + WS_MOD))[i], s);
}
__global__ void chk_wt(const float* W, int K, int N, const bf16* WT, float* res, int st) {
    const unsigned h = hsh(blockIdx.x * 256 + threadIdx.x + 77u * st); const int k = h % K, n = (h >> 12) % N;
    rec(res, st, bf2f(WT[(size_t)n * K + k]), bfr(W[(size_t)k * N + n]));
}
__global__ void chk_norm(const float* src, const float* g, const float* modrow_sh, const float* modrow_sc, int bstride, const bf16* dst, int nrows, int rows_per_b, float* res, int st, int row_base = 0) {
    __shared__ float red[256]; const unsigned h = hsh(blockIdx.x + 1000u * st); const int row = row_base + h % nrows; const int b = rows_per_b ? row / rows_per_b : 0; const int t = threadIdx.x;
    float s = 0.f; for (int k = t; k < 1024; k += 256) { const float v = src[(size_t)row * 1024 + k]; s += v * v; } red[t] = s; __syncthreads();
    for (int o = 128; o > 0; o >>= 1) { if (t < o) red[t] += red[t + o]; __syncthreads(); }
    const float rstd = rsqrtf(red[0] / 1024.f + 1e-6f);
    for (int k = t; k < 1024; k += 256) { const float want = src[(size_t)row * 1024 + k] * rstd * g[k] * (1.f + modrow_sc[(size_t)b * bstride + k]) + modrow_sh[(size_t)b * bstride + k]; rec(res, st, bf2f(dst[(size_t)row * 1024 + k]), want); }
}
__device__ __forceinline__ float dotbf(const bf16* A, const bf16* B, int K) { float s = 0.f; for (int k = 0; k < K; ++k) s += bf2f(A[k]) * bf2f(B[k]); return s; }
__global__ void chk_gemm1(Args a, float* res) {
    const unsigned h = hsh(blockIdx.x * 256 + threadIdx.x); int row = h % 17408; int col = (h >> 15) % 2560;
    if (row >= 16384) { col = 1024 + (h >> 15) % 1536; }
    const bf16* XN = (const bf16*)(a.ws + WS_XN); const bf16* WT = (const bf16*)(a.ws + WS_WIN);
    const float want = dotbf(XN + (size_t)row * 1024, WT + (size_t)col * 1024, 1024); float got;
    if (row < 16384) { const int b = row >> 12, t = row & 4095; const size_t kv = (size_t)b * TKV + 256 + t;
        if (col < 256) got = bf2f(((const bf16*)(a.ws + WS_POOL))[(size_t)row * 256 + col]);
        else if (col < 1024) got = bf2f(((const bf16*)(a.ws + WS_Q))[(size_t)row * 768 + col - 256]);
        else if (col < 1792) got = bf2f(((const bf16*)(a.ws + WS_K))[kv * 768 + col - 1024]);
        else got = bf2f(((const bf16*)(a.ws + WS_V))[kv * 768 + col - 1792]);
    } else { const int rc = row - 16384, b = rc >> 8, j = rc & 255; const size_t kv = (size_t)b * TKV + j;
        if (col < 1792) got = bf2f(((const bf16*)(a.ws + WS_K))[kv * 768 + col - 1024]); else got = bf2f(((const bf16*)(a.ws + WS_V))[kv * 768 + col - 1792]); }
    rec(res, 3, got, want);
}
__global__ void chk_qk(Args a, float* res) {
    __shared__ float raw[64]; __shared__ float red[64]; const unsigned h = hsh(blockIdx.x + 4242u); const int d = threadIdx.x;
    int row = h % 17408; const int hg = (h >> 16) % 12; int isq = (h >> 24) & 1; if (row >= 16384) isq = 0;
    const bf16* XN = (const bf16*)(a.ws + WS_XN); const bf16* WT = (const bf16*)(a.ws + WS_WIN);
    const int col = (isq ? 256 : 1024) + hg * 64 + d;
    raw[d] = bfr(dotbf(XN + (size_t)row * 1024, WT + (size_t)col * 1024, 1024)); red[d] = raw[d] * raw[d]; __syncthreads();
    for (int o = 32; o > 0; o >>= 1) { if (d < o) red[d] += red[d + o]; __syncthreads(); }
    const float rstd = rsqrtf(red[0] / 64.f + 1e-6f); const float* gam = isq ? a.in[14] : a.in[15];
    float y = raw[d] * rstd * gam[d]; __syncthreads(); red[d] = y; __syncthreads();
    float want = y; size_t off;
    if (row < 16384) { const int t = row & 4095, pr = d >> 1; const float pos = (float)(pr < 16 ? (t >> 6) : (t & 63)); const float inv = powf(10000.f, -(float)(pr & 15) / 16.f); const float ang = pos * inv;
        const float cs = cosf(ang), sn = sinf(ang), x0 = red[2 * pr], x1 = red[2 * pr + 1]; want = (d & 1) ? x0 * sn + x1 * cs : x0 * cs - x1 * sn;
        off = isq ? (size_t)row * 768 + hg * 64 + d : ((size_t)(row >> 12) * TKV + 256 + t) * 768 + hg * 64 + d;
    } else { const int rc = row - 16384; off = ((size_t)(rc >> 8) * TKV + (rc & 255)) * 768 + hg * 64 + d; }
    const bf16* buf = isq ? (const bf16*)(a.ws + WS_Q) : (const bf16*)(a.ws + WS_K);
    rec(res, 4, bf2f(buf[off]), want);
}
__global__ void chk_pool(Args a, float* res) {
    const unsigned h = hsh(blockIdx.x * 256 + threadIdx.x + 999u); const int row = h % 16384, gi = (h >> 14) & 3, d = (h >> 16) & 63; const int b = row >> 12, t = row & 4095, hw = 1 << gi;
    const bf16* PI = (const bf16*)(a.ws + WS_POOL); const int lo = max(t - hw, 0), hi = min(t + hw, 4096); float acc = 0.f;
    for (int c = 0; c < 64; ++c) { float s = 0.f; for (int j = lo; j < hi; ++j) s += bf2f(PI[((size_t)b * 4096 + j) * 256 + gi * 64 + c]);
        const float pooled = s / (float)(hi - lo) - bf2f(PI[(size_t)row * 256 + gi * 64 + c]); acc += pooled * a.in[12][gi * 4096 + c * 64 + d]; }
    rec(res, 5, bf2f(((const bf16*)(a.ws + WS_Y))[(size_t)row * 1024 + gi * 64 + d]), acc * a.in[13][gi * 64 + d]);
}
__global__ void chk_attn(Args a, float* res) {
    __shared__ float s1[TKV], s2[TKV]; __shared__ float red[256]; __shared__ float ov[128];
    const unsigned hh = hsh(blockIdx.x + 31337u); const int row = hh % 16384, h = (hh >> 14) % 6, b = row >> 12, t = threadIdx.x;
    const bf16* Q = (const bf16*)(a.ws + WS_Q) + (size_t)row * 768 + h * 128; const bf16* KA = (const bf16*)(a.ws + WS_K) + (size_t)b * TKV * 768 + h * 128; const bf16* VA = (const bf16*)(a.ws + WS_V) + (size_t)b * TKV * 768 + h * 128;
    float l1 = 0.f, l2 = 0.f; for (int i = 0; i < 64; ++i) { l1 += a.in[16][i] * a.in[17][i]; l2 += a.in[18][i] * a.in[19][i]; } const float lam = expf(l1) - expf(l2) + 0.2f;
    for (int k = t; k < TKV; k += 256) { float x1 = 0.f, x2 = 0.f; for (int d = 0; d < 64; ++d) { x1 += bf2f(Q[d]) * bf2f(KA[(size_t)k * 768 + d]); x2 += bf2f(Q[64 + d]) * bf2f(KA[(size_t)k * 768 + 64 + d]); } s1[k] = x1 * 0.125f; s2[k] = x2 * 0.125f; }
    __syncthreads();
    float m1 = -1e30f, m2 = -1e30f; for (int k = t; k < TKV; k += 256) { m1 = fmaxf(m1, s1[k]); m2 = fmaxf(m2, s2[k]); }
    red[t] = m1; __syncthreads(); for (int o = 128; o > 0; o >>= 1) { if (t < o) red[t] = fmaxf(red[t], red[t + o]); __syncthreads(); } m1 = red[0]; __syncthreads();
    red[t] = m2; __syncthreads(); for (int o = 128; o > 0; o >>= 1) { if (t < o) red[t] = fmaxf(red[t], red[t + o]); __syncthreads(); } m2 = red[0]; __syncthreads();
    float z1 = 0.f, z2 = 0.f; for (int k = t; k < TKV; k += 256) { s1[k] = expf(s1[k] - m1); s2[k] = expf(s2[k] - m2); z1 += s1[k]; z2 += s2[k]; }
    red[t] = z1; __syncthreads(); for (int o = 128; o > 0; o >>= 1) { if (t < o) red[t] += red[t + o]; __syncthreads(); } z1 = red[0]; __syncthreads();
    red[t] = z2; __syncthreads(); for (int o = 128; o > 0; o >>= 1) { if (t < o) red[t] += red[t + o]; __syncthreads(); } z2 = red[0]; __syncthreads();
    if (t < 128) { float o = 0.f; for (int k = 0; k < TKV; ++k) o += (s1[k] / z1 - lam * s2[k] / z2) * bf2f(VA[(size_t)k * 768 + t]); ov[t] = o; red[t] = o * o; } else red[t] = 0.f;
    __syncthreads(); for (int o = 128; o > 0; o >>= 1) { if (t < o) red[t] += red[t + o]; __syncthreads(); }
    if (t < 128) { const float want = ov[t] * rsqrtf(red[0] / 128.f + 1e-6f) * a.in[20][t] * 0.8f; rec(res, 6, bf2f(((const bf16*)(a.ws + WS_Y))[(size_t)row * 1024 + 256 + h * 128 + t]), want); }
}
__global__ void chk_res(const bf16* A, const bf16* WT, int K, const float* basebuf, const float* gate, const float* out, float* res, int st, int nrows) {
    const unsigned h = hsh(blockIdx.x * 256 + threadIdx.x + 555u * st); const int row = h % nrows, col = (h >> 13) % 1024;
    const float want = basebuf[(size_t)row * 1024 + col] + gate[(size_t)(row >> 12) * 6144 + col] * dotbf(A + (size_t)row * K, WT + (size_t)col * K, K);
    rec(res, st, out[(size_t)row * 1024 + col], want);
}
__global__ void chk_act(const bf16* A, const bf16* WT, int K, int N, const bf16* O, int ldo, int act, int transposed, float* res, int st) {
    const unsigned h = hsh(blockIdx.x * 256 + threadIdx.x + 333u * st); const int row = h % 16384, col = (h >> 14) % N;
    float v = dotbf(A + (size_t)row * K, WT + (size_t)col * K, K); if (act == 2) { v = fmaxf(v, 0.f); v *= v; } else if (act == 1) v = 0.5f * v * (1.f + erff(v * 0.70710678f));
    rec(res, st, bf2f(transposed ? O[(size_t)col * ldo + row] : O[(size_t)row * ldo + col]), v);
}
__global__ void chk_copy(const float* src, float* dst, size_t n4) { for (size_t i = blockIdx.x * 256ull + threadIdx.x; i < n4; i += gridDim.x * 256ull) ((f32x4*)dst)[i] = ((const f32x4*)src)[i]; }
__global__ void chk_final(float* res, float* out, int nst) {
    for (int i = 0; i < nst; ++i) { const float e = res[i]; if (e > 0.08f) { float m = fminf(fmaxf(e * 10.f, 1.0f), 9.9f); float v = m; for (int j = 0; j < 4 + i; ++j) v *= 10.f; out[0] = v; return; } }
}
__global__ void simple_norm(const float* src, const float* g, const float* sh, const float* sc, int bstride, bf16* dst) {
    __shared__ float red[256]; const int row = blockIdx.x, b = row >> 12, t = threadIdx.x;
    float s = 0.f; for (int k = t; k < 1024; k += 256) { const float v = src[(size_t)row * 1024 + k]; s += v * v; } red[t] = s; __syncthreads();
    for (int o = 128; o > 0; o >>= 1) { if (t < o) red[t] += red[t + o]; __syncthreads(); }
    const float rstd = rsqrtf(red[0] / 1024.f + 1e-6f);
    for (int k = t; k < 1024; k += 256) dst[(size_t)row * 1024 + k] = (bf16)f2bf(src[(size_t)row * 1024 + k] * rstd * g[k] * (1.f + sc[(size_t)b * bstride + k]) + sh[(size_t)b * bstride + k]);
}
__global__ void chk_final2(float* res, float* out) { int mask = 0; for (int i = 0; i < 8; ++i) if (res[20 + i] < 0.08f) mask |= 1 << i; out[0] = (float)(mask + 1) * 1e6f; }
#endif

#define XB_TMO      128
#define XB_XCNT(j)  (256  + 64 * (j))
#define XB_XSUB(j)  (1280 + 64 * (j))
#define XB_XGEN(j)  (2304 + 64 * (j))
#define XB_TOP      3328
#define XB_TOPGEN   3392
#define XCD_BAR_WORDS 3456
#define XB_SPIN_CAP (1u << 18)

__device__ __forceinline__ unsigned xb_ld(unsigned* p)              { return __hip_atomic_load(p, __ATOMIC_RELAXED, __HIP_MEMORY_SCOPE_AGENT); }
__device__ __forceinline__ unsigned xb_add(unsigned* p, unsigned v) { return __hip_atomic_fetch_add(p, v, __ATOMIC_RELAXED, __HIP_MEMORY_SCOPE_AGENT); }
__device__ __forceinline__ unsigned xb_xcc_id() { return (unsigned)__builtin_amdgcn_s_getreg((3 << 11) | 20) & 0xFu; }
#define XB_SPIN(cond, bar) do { unsigned _sp = 0; while (cond) { __builtin_amdgcn_s_sleep(1); \
    if ((++_sp & 255u) == 0u) { if (xb_ld(&(bar)[XB_TMO])) break; if (_sp > XB_SPIN_CAP) { atomicAdd(&(bar)[XB_TMO], 1u); break; } } } } while (0)

struct XcdBarrier {
    unsigned* bar; unsigned x;
    volatile LAS unsigned* st;
};

__device__ __forceinline__ XcdBarrier xcd_barrier_post(unsigned* bar, volatile LAS unsigned* st) {
    XcdBarrier b; b.bar = bar; b.x = xb_xcc_id(); b.st = st;
    if (threadIdx.x == 0) (void)xb_add(&bar[XB_XCNT(b.x)], 1u);
    return b;
}
__device__ __forceinline__ void xcd_barrier_complete(unsigned* bar, unsigned x, unsigned& nloc, unsigned& nx) {
    const unsigned G = gridDim.x * gridDim.y * gridDim.z;
    unsigned sum, cnt, mine, sp = 0u;
    for (;;) {
        sum = 0u; cnt = 0u; mine = 0u;
#pragma unroll
        for (unsigned j = 0; j < 16; ++j) { const unsigned c = xb_ld(&bar[XB_XCNT(j)]); sum += c; cnt += (c > 0u) ? 1u : 0u; mine = (j == x) ? c : mine; }
        if (sum == G) break;
        __builtin_amdgcn_s_sleep(1);
        if ((++sp & 255u) == 0u) { if (xb_ld(&bar[XB_TMO])) break; if (sp > XB_SPIN_CAP) { atomicAdd(&bar[XB_TMO], 1u); break; } }
    }
    nloc = mine > 0u ? mine : 1u; nx = cnt > 0u ? cnt : 1u;
}

__device__ __forceinline__ void xcd_barrier(const XcdBarrier& b) {
    asm volatile("s_waitcnt vmcnt(0)" ::: "memory");
    __syncthreads();
    if (threadIdx.x == 0) {
        unsigned* bar = b.bar;
        __builtin_amdgcn_s_waitcnt(0);
        unsigned nloc = b.st[0], nx = b.st[1];
        if (nloc == 0u) { xcd_barrier_complete(bar, b.x, nloc, nx); b.st[0] = nloc; b.st[1] = nx; }
        const unsigned old = xb_add(&bar[XB_XSUB(b.x)], 1u);
        const unsigned gen = old / nloc;
        if (old + 1u == (gen + 1u) * nloc) {
            __builtin_amdgcn_fence(__ATOMIC_RELEASE, "agent");
            asm volatile("s_waitcnt vmcnt(0)" ::: "memory");
            const unsigned og = xb_add(&bar[XB_TOP], 1u);
            const unsigned tg = og / nx;
            if (og + 1u == (tg + 1u) * nx) xb_add(&bar[XB_TOPGEN], 1u);
            else XB_SPIN(xb_ld(&bar[XB_TOPGEN]) == tg, bar);
            __builtin_amdgcn_fence(__ATOMIC_ACQUIRE, "agent");
            xb_add(&bar[XB_XGEN(b.x)], 1u);
            asm volatile("s_waitcnt vmcnt(0)" ::: "memory");
        } else {
            XB_SPIN(xb_ld(&bar[XB_XGEN(b.x)]) == gen, bar);
            __builtin_amdgcn_fence(__ATOMIC_ACQUIRE, "agent");
            asm volatile("s_waitcnt vmcnt(0)" ::: "memory");
        }
    }
    __syncthreads();
}

template <int PH> __device__ __forceinline__ void run_phase(const Args& a, unsigned char* lds, int vcu, int G, int bx) {
    unsigned char* ws = a.ws;
    float* mod = (float*)(ws + WS_MOD);
    bf16* XN = (bf16*)(ws + WS_XN);
    if constexpr (PH == 0) p0_prep(a, lds, vcu, G);
    else if constexpr (PH == 1)  norm_phase(a.in[0], a.in[6],        mod,            0,    1024, XN, a.in[2], vcu, G);
    else if constexpr (PH == 6)  norm_phase(a.out,   a.in[7],        mod,            3072, 4096, XN, nullptr, vcu, G);
    else if constexpr (PH == 9)  norm_phase(a.out,   a.in[6] + 1024, mod + 5 * MODW, 0,    1024, XN, nullptr, vcu, G);
    else if constexpr (PH == 13) norm_phase(a.out,   a.in[7] + 1024, mod + 5 * MODW, 3072, 4096, XN, nullptr, vcu, G);
    else if constexpr (PH == 2) {
        pg8::Gemm g{XN, (const bf16*)(ws + WS_WIN), 17408, 2560, 1024}; pg8::OrderQKV S; S.init(G, bx);
        pg8::EpiRoute E{(bf16*)(ws + WS_POOL), (bf16*)(ws + WS_Q), (bf16*)(ws + WS_K), (bf16*)(ws + WS_V)};
        pg8::gemm_phase<pg8::EpiRoute, pg8::OrderQKV, true, true>((LAS unsigned char*)lds, g, S, E);
    }
    else if constexpr (PH == 3) qknorm_pool_phase(a, lds, vcu, G);
    else if constexpr (PH == 4) { attn_phase(a, lds, vcu, G);
#ifdef PROBE_ATT2
        attn_phase(a, lds, vcu, G);
#endif
    }
    else if constexpr (PH == 5 || PH == 8 || PH == 12 || PH == 15) {
        pg8::Gemm g; const float* base; const float* gate;
        if constexpr (PH == 5)       { g = pg8::Gemm{(const bf16*)(ws + WS_Y),  (const bf16*)(ws + WS_WOUT),  MTOK, 1024, 1024}; base = a.in[0]; gate = mod + 2048; }
        else if constexpr (PH == 8)  { g = pg8::Gemm{(const bf16*)(ws + WS_HB), (const bf16*)(ws + WS_W2),    MTOK, 1024, 4096}; base = a.out;   gate = mod + 5120; }
        else if constexpr (PH == 12) { g = pg8::Gemm{(const bf16*)(ws + WS_U),  (const bf16*)(ws + WS_ODOUT), MTOK, 1024, 2048}; base = a.out;   gate = mod + 5 * MODW + 2048; }
        else                         { g = pg8::Gemm{(const bf16*)(ws + WS_HB), (const bf16*)(ws + WS_W2) + (size_t)1024 * 4096, MTOK, 1024, 4096}; base = a.out; gate = mod + 5 * MODW + 5120; }
        pg8::StaticOrder S; S.init(g.M, g.N, G, bx);
        pg8::EpiRes E{base, a.out, gate};
        pg8::gemm_phase<pg8::EpiRes, pg8::StaticOrder, true, true>((LAS unsigned char*)lds, g, S, E);
    }
    else if constexpr (PH == 7 || PH == 14) {
        pg8::Gemm g{XN, (const bf16*)(ws + WS_W1) + (PH == 14 ? (size_t)4096 * 1024 : 0), MTOK, FF, 1024}; pg8::EpiAct E{(bf16*)(ws + WS_HB), FF, 2};
        pg8::StaticOrder S; S.init(g.M, g.N, G, bx);
        pg8::gemm_phase<pg8::EpiAct, pg8::StaticOrder, true, true>((LAS unsigned char*)lds, g, S, E);
    }
    else if constexpr (PH == 10) {
        { pg8::Gemm g{XN, (const bf16*)(ws + WS_ODIN), MTOK, 2048, 1024}; pg8::EpiAct E{(bf16*)(ws + WS_U), 2048, 1};
          pg8::StaticOrder S; S.init(g.M, g.N, G, bx);
          pg8::gemm_phase<pg8::EpiAct, pg8::StaticOrder, true, true>((LAS unsigned char*)lds, g, S, E); }
        { pg8::Gemm g{(const bf16*)(ws + WS_ODIN) + (size_t)2048 * 1024, XN, 2048, MTOK, 1024}; pg8::EpiAct E{(bf16*)(ws + WS_VT), MTOK, 1};
          pg8::StaticOrder S; S.init(g.M, g.N, G, bx);
          pg8::gemm_phase<pg8::EpiAct, pg8::StaticOrder, true, true>((LAS unsigned char*)lds, g, S, E); }
    }
    else if constexpr (PH == 11) spatial_phase(a, lds, vcu, G);
}
constexpr int XBAR_LDS_OFF = LDS_BYTES - 64;
__global__ void __launch_bounds__(NTHR) fwd_megakernel(Args a) {
    extern __shared__ __attribute__((aligned(16))) unsigned char lds[];
    const int G = gridDim.x, bx = blockIdx.x;
    const int vcu = (G % 8 == 0) ? (bx % 8) * (G / 8) + bx / 8 : bx;
    volatile LAS unsigned* xst = (volatile LAS unsigned*)((LAS unsigned char*)lds + XBAR_LDS_OFF);
    if (threadIdx.x < 2) xst[threadIdx.x] = 0u;
    __syncthreads();
    XcdBarrier bar; bar.bar = (unsigned*)a.ws; bar.x = 0; bar.st = xst;
    const bool fused = (a.ph_hi - a.ph_lo) > 1;
    if (fused) bar = xcd_barrier_post((unsigned*)a.ws, xst);
    if (a.ph_hi > NPH) cg::this_grid().sync();
#define PHASE(k) if (a.ph_lo <= (k) && (k) < a.ph_hi) { run_phase<k>(a, lds, vcu, G, bx); if ((k) + 1 < a.ph_hi) { xcd_barrier(bar); PROBE_XB } }
    PHASE(0) PHASE(1) PHASE(2) PHASE(3) PHASE(4) PHASE(5) PHASE(6) PHASE(7) PHASE(8) PHASE(9) PHASE(10) PHASE(11) PHASE(12) PHASE(13) PHASE(14) PHASE(15)
#undef PHASE
}

extern "C" void kernel_launch(void* const* d_in, const int* in_sizes, int n_in, void* d_out, int out_size, void* d_ws, size_t ws_size, hipStream_t stream) {
    static int grid = 0;
    if (grid == 0) {
        if (n_in != 27 || in_sizes[0] != MTOK * DM || out_size != MTOK * DM || ws_size < WS_END) { fprintf(stderr, "kernel_launch: unexpected shapes (n_in %d, in0 %d, out %d, ws %zu)\n", n_in, n_in > 0 ? in_sizes[0] : -1, out_size, ws_size); grid = -1; return; }
        if (hipFuncSetAttribute((const void*)fwd_megakernel, hipFuncAttributeMaxDynamicSharedMemorySize, LDS_BYTES) != hipSuccess) { fprintf(stderr, "kernel_launch: hipFuncSetAttribute failed\n"); grid = -1; return; }
        int dev = 0, cus = 0, per_cu = 0;
        (void)hipGetDevice(&dev); (void)hipDeviceGetAttribute(&cus, hipDeviceAttributeMultiprocessorCount, dev);
        (void)hipOccupancyMaxActiveBlocksPerMultiprocessor(&per_cu, (const void*)fwd_megakernel, NTHR, LDS_BYTES);
        if (per_cu < 1 || cus < 256) fprintf(stderr, "kernel_launch: note: occupancy query %d blocks/CU, %d CUs\n", per_cu, cus);
        (void)hipGetLastError();
        grid = 256;
    }
    if (grid < 0) return;
    Args a{};
    for (int i = 0; i < 27; ++i) a.in[i] = (const float*)d_in[i];
    a.out = (float*)d_out; a.ws = (unsigned char*)d_ws;
#if MK_MULTI
#if MK_DEBUG
    float* res = (float*)d_ws; (void)hipMemsetAsync(res, 0, 256, stream);
    unsigned char* ws = (unsigned char*)d_ws; float* mod = (float*)(ws + WS_MOD); float* snap = (float*)(ws + 220 * MiB);
#endif
    for (int ph = 0; ph < NPH_RUN; ++ph) { a.ph_lo = ph; a.ph_hi = ph + 1;
#if MK_DEBUG
        if (ph == 8 || ph == 12 || ph == 15) hipLaunchKernelGGL(chk_copy, dim3(2048), dim3(256), 0, stream, (const float*)d_out, snap, (size_t)8192 * 1024 / 4);
#endif
#if MK_DEBUG
        if (ph == 6 && MK_SIMPLE6) hipLaunchKernelGGL(simple_norm, dim3(16384), dim3(256), 0, stream, (const float*)d_out, a.in[7], (const float*)(mod + 3072), (const float*)(mod + 4096), 6144, (bf16*)(ws + WS_XN)); else
#endif
        hipLaunchKernelGGL(fwd_megakernel, dim3(grid), dim3(NTHR), LDS_BYTES, stream, a);
#if MK_DEBUG
        if (ph == 0) { hipLaunchKernelGGL(chk_mod, dim3(240), dim3(256), 0, stream, a, res);
            hipLaunchKernelGGL(chk_wt, dim3(16), dim3(256), 0, stream, a.in[10], 1024, 2560, (const bf16*)(ws + WS_WIN), res, 1);
            hipLaunchKernelGGL(chk_wt, dim3(16), dim3(256), 0, stream, a.in[11], 1024, 1024, (const bf16*)(ws + WS_WOUT), res, 1);
            hipLaunchKernelGGL(chk_wt, dim3(16), dim3(256), 0, stream, a.in[8], 1024, 4096, (const bf16*)(ws + WS_W1), res, 1);
            hipLaunchKernelGGL(chk_wt, dim3(16), dim3(256), 0, stream, a.in[8] + 1024 * 4096, 1024, 4096, (const bf16*)(ws + WS_W1) + 4096 * 1024, res, 1);
            hipLaunchKernelGGL(chk_wt, dim3(16), dim3(256), 0, stream, a.in[9], 4096, 1024, (const bf16*)(ws + WS_W2), res, 1);
            hipLaunchKernelGGL(chk_wt, dim3(16), dim3(256), 0, stream, a.in[9] + 1024 * 4096, 4096, 1024, (const bf16*)(ws + WS_W2) + 4096 * 1024, res, 1);
            hipLaunchKernelGGL(chk_wt, dim3(16), dim3(256), 0, stream, a.in[21], 1024, 4096, (const bf16*)(ws + WS_ODIN), res, 1);
            hipLaunchKernelGGL(chk_wt, dim3(16), dim3(256), 0, stream, a.in[26], 2048, 1024, (const bf16*)(ws + WS_ODOUT), res, 1); }
        if (ph == 1) { hipLaunchKernelGGL(chk_norm, dim3(128), dim3(256), 0, stream, a.in[0], a.in[6], (const float*)mod, (const float*)(mod + 1024), 6144, (const bf16*)(ws + WS_XN), 16384, 4096, res, 2);
            hipLaunchKernelGGL(chk_norm, dim3(64), dim3(256), 0, stream, a.in[2], a.in[6], (const float*)(mod + 4 * 6144), (const float*)(mod + 4 * 6144 + 1024), 0, (const bf16*)(ws + WS_XN) + (size_t)16384 * 1024, 1024, 0, res, 2); }
        if (ph == 2) hipLaunchKernelGGL(chk_gemm1, dim3(32), dim3(256), 0, stream, a, res);
        if (ph == 3) { hipLaunchKernelGGL(chk_qk, dim3(512), dim3(64), 0, stream, a, res); hipLaunchKernelGGL(chk_pool, dim3(16), dim3(256), 0, stream, a, res); }
        if (ph == 4) hipLaunchKernelGGL(chk_attn, dim3(96), dim3(256), 0, stream, a, res);
        if (ph == 5) hipLaunchKernelGGL(chk_res, dim3(16), dim3(256), 0, stream, (const bf16*)(ws + WS_Y), (const bf16*)(ws + WS_WOUT), 1024, a.in[0], (const float*)(mod + 2048), (const float*)d_out, res, 7, 16384);
        if (ph == 6) hipLaunchKernelGGL(chk_norm, dim3(128), dim3(256), 0, stream, (const float*)d_out, a.in[7], (const float*)(mod + 3072), (const float*)(mod + 4096), 6144, (const bf16*)(ws + WS_XN), 16384, 4096, res, 8);
        if (ph == 7) hipLaunchKernelGGL(chk_act, dim3(16), dim3(256), 0, stream, (const bf16*)(ws + WS_XN), (const bf16*)(ws + WS_W1), 1024, 4096, (const bf16*)(ws + WS_HB), 4096, 2, 0, res, 9);
        if (ph == 8) hipLaunchKernelGGL(chk_res, dim3(16), dim3(256), 0, stream, (const bf16*)(ws + WS_HB), (const bf16*)(ws + WS_W2), 4096, (const float*)snap, (const float*)(mod + 5120), (const float*)d_out, res, 10, 8192);
        if (ph == 9) hipLaunchKernelGGL(chk_norm, dim3(128), dim3(256), 0, stream, (const float*)d_out, a.in[6] + 1024, (const float*)(mod + 5 * 6144), (const float*)(mod + 5 * 6144 + 1024), 6144, (const bf16*)(ws + WS_XN), 16384, 4096, res, 11);
        if (ph == 10) { hipLaunchKernelGGL(chk_act, dim3(16), dim3(256), 0, stream, (const bf16*)(ws + WS_XN), (const bf16*)(ws + WS_ODIN), 1024, 2048, (const bf16*)(ws + WS_U), 2048, 1, 0, res, 12);
            hipLaunchKernelGGL(chk_act, dim3(16), dim3(256), 0, stream, (const bf16*)(ws + WS_XN), (const bf16*)(ws + WS_ODIN) + (size_t)2048 * 1024, 1024, 2048, (const bf16*)(ws + WS_VT), 16384, 1, 1, res, 13); }
#endif
    }
#if MK_DEBUG
    if (NPH_RUN == 16) hipLaunchKernelGGL(chk_final, dim3(1), dim3(1), 0, stream, res, (float*)d_out, 14);
#endif
#else
    a.ph_lo = 0; a.ph_hi = NPH;
    if (hipMemsetAsync(d_ws, 0, 16384, stream) != hipSuccess) { fprintf(stderr, "kernel_launch: memset of the barrier words failed\n"); return; }
    void* args[] = {&a};
    hipError_t e = hipLaunchCooperativeKernel((const void*)fwd_megakernel, dim3(grid), dim3(NTHR), args, LDS_BYTES, stream);
    if (e != hipSuccess) fprintf(stderr, "kernel_launch: cooperative launch failed: %s\n", hipGetErrorString(e));
#endif
}
```

```cpp
#include <hip/hip_runtime.h>
#include <hip/hip_cooperative_groups.h>
#include <cstdio>
#include <cstdint>
namespace cg = cooperative_groups;
__device__ __forceinline__ int ltid() { int t = threadIdx.x; asm volatile("" : "+v"(t)); return t; }
namespace pg8 {
#define PG8_LAS __attribute__((address_space(3)))
typedef unsigned short bf16_t;
typedef short bf16x8 __attribute__((ext_vector_type(8)));
typedef float f32x4 __attribute__((ext_vector_type(4)));
typedef unsigned u32x4 __attribute__((ext_vector_type(4)));
constexpr int BM = 256, BK = 64, HALF = 128, HTB = HALF * BK * 2  , STAGE_BYTES = 8 * HTB, NXCD = 8, WGM = 8;

__host__ __device__ __forceinline__ int lds_byte(int r, int c) { const int st = (r >> 4) * 2 + (c >> 5), rr = r & 15, cc = c & 31, ob = rr * 64 + cc * 2; return st * 1024 + (ob ^ (((ob >> 9) & 1) << 5)); }
__host__ __device__ __forceinline__ void stage_rc(int b, int& R, int& C) { const int st = b / 1024, sb = b % 1024, swz = sb ^ (((sb >> 9) & 1) << 5); R = (st >> 1) * 16 + swz / 64; C = (st & 1) * 32 + (swz % 64) / 2; }
__host__ __device__ __forceinline__ int perm32(int rho) { const int n = rho >> 4, i = rho & 15; return 8 * (i >> 2) + 4 * n + (i & 3); }

struct Unit { int pm, pn; };
struct Gemm { const bf16_t* A; const bf16_t* Bt; int M, N, K; };

struct StaticOrder {
    int nM, nN, nwg, G, c;
    __host__ __device__ void init(int M, int N, int G_, int c_) { nM = M / BM; nN = N / BM; nwg = nM * nN; G = G_; c = c_; }
    __host__ __device__ bool next(int i, Unit& u) const {
        const long L = (long)i * G + c; if (L >= nwg) return false;
        int wgid = (int)L; { const int q = nwg / NXCD, r = nwg % NXCD, xcd = wgid % NXCD, off = wgid / NXCD; wgid = (xcd < r ? xcd * (q + 1) : r * (q + 1) + (xcd - r) * q) + off; }
        const int nig = WGM * nN, gid = wgid / nig, fm = gid * WGM, gsz = (nM - fm) < WGM ? (nM - fm) : WGM;
        u.pm = fm + ((wgid % nig) % gsz); u.pn = (wgid % nig) / gsz; return true;
    }
    __device__ __forceinline__ void a_ready(const Unit&) const {}
    __device__ __forceinline__ void done(const Unit&) const {}
};

__device__ __forceinline__ unsigned cvt_pk_bf16(float lo, float hi) { unsigned r; asm volatile("v_cvt_pk_bf16_f32 %0, %1, %2" : "=v"(r) : "v"(lo), "v"(hi)); return r; }
typedef float f32x2 __attribute__((ext_vector_type(2)));
__device__ __forceinline__ f32x2 gelu_pk(f32x2 v) {
    const f32x2 av = __builtin_elementwise_abs(v), d = av * 0.2316418882f + 1.0f;
    f32x2 t; t.x = __builtin_amdgcn_rcpf(d.x); t.y = __builtin_amdgcn_rcpf(d.y);
    f32x2 q = t * 0.5307027145f + (-0.7265760135f); q = q * t + 0.7107068705f; q = q * t + (-0.142248368f); q = q * t + 0.127414796f; q = q * t;
    const f32x2 s = (v * v) * (-0.72134752044f);
    f32x2 e; e.x = __builtin_amdgcn_exp2f(s.x); e.y = __builtin_amdgcn_exp2f(s.y);
    const f32x2 m = v * (q * e), r = v - m;
    f32x2 o; o.x = v.x < 0.f ? m.x : r.x; o.y = v.y < 0.f ? m.y : r.y; return o;
}


struct EpiAct {
    static constexpr bool PERM = true, AFTER_DRAIN = false;
    bf16_t* O; int ldc; int act;
    __device__ __forceinline__ void operator()(const f32x4 (&acc)[2][2][4][2], const Unit& u, int wr, int wc, int fr, int fq) const {
        const int row0 = u.pm * BM + wr * 64 + fr; const int col0 = u.pn * BM + wc * 32 + 8 * fq;
#pragma unroll
        for (int ai = 0; ai < 2; ++ai)
#pragma unroll
            for (int m = 0; m < 4; ++m) { bf16_t* rowp = O + (size_t)(row0 + ai * HALF + m * 16) * ldc + col0;
#pragma unroll
                for (int bj = 0; bj < 2; ++bj) { f32x4 v0 = acc[ai][bj][m][0], v1 = acc[ai][bj][m][1];
                    if (act == 1) { f32x2 a = gelu_pk((f32x2){v0[0], v0[1]}), b = gelu_pk((f32x2){v0[2], v0[3]}), c = gelu_pk((f32x2){v1[0], v1[1]}), d = gelu_pk((f32x2){v1[2], v1[3]});
                        v0 = (f32x4){a.x, a.y, b.x, b.y}; v1 = (f32x4){c.x, c.y, d.x, d.y}; }
                    else if (act == 2) {
#pragma unroll
                        for (int e = 0; e < 4; ++e) { const float a = fmaxf(v0[e], 0.f), b = fmaxf(v1[e], 0.f); v0[e] = a * a; v1[e] = b * b; } }
                    u32x4 w; w.x = cvt_pk_bf16(v0[0], v0[1]); w.y = cvt_pk_bf16(v0[2], v0[3]); w.z = cvt_pk_bf16(v1[0], v1[1]); w.w = cvt_pk_bf16(v1[2], v1[3]);
                    *(u32x4*)(rowp + bj * HALF) = w; } }
    }
};
struct EpiRoute {
    static constexpr bool PERM = true, AFTER_DRAIN = false;
    bf16_t *pool, *q, *k, *v;
    const float *qg, *kg; const float* rope;
    __device__ __forceinline__ void operator()(const f32x4 (&acc)[2][2][4][2], const Unit& u, int wr, int wc, int fr, int fq) const {
        const int pm = u.pm, pn = u.pn; bf16_t* base; int ld, colt; long rowbase;
        if (pm < 64) { const int b = pm >> 4; const long lat = (long)pm * 256, kvrow = (long)b * 4352 + 256 + (pm & 15) * 256;
            if (pn == 0)     { base = pool; ld = 256; colt = 0;              rowbase = lat; }
            else if (pn < 4) { base = q;    ld = 768; colt = (pn - 1) * 256; rowbase = lat; }
            else if (pn < 7) { base = k;    ld = 768; colt = (pn - 4) * 256; rowbase = kvrow; }
            else             { base = v;    ld = 768; colt = (pn - 7) * 256; rowbase = kvrow; }
        } else { const int b = pm - 64; rowbase = (long)b * 4352; ld = 768;
            if (pn < 7) { base = k; colt = (pn - 4) * 256; } else { base = v; colt = (pn - 7) * 256; } }
        const long row0 = rowbase + wr * 64 + fr;
        if (pn >= 1 && pn <= 6) {
            const float* gam = pn < 4 ? qg : kg; const bool rope_on = pm < 64; const int col0 = colt + 64 * wc + 8 * fq;
            f32x4 gm[2][2];
#pragma unroll
            for (int bj = 0; bj < 2; ++bj)
#pragma unroll
                for (int n = 0; n < 2; ++n) gm[bj][n] = *(const f32x4*)(gam + 32 * bj + 8 * fq + 4 * n);
#pragma unroll
            for (int ai = 0; ai < 2; ++ai)
#pragma unroll
                for (int m = 0; m < 4; ++m) { const int rl = wr * 64 + ai * HALF + m * 16 + fr; const int t = (pm & 15) * 256 + rl;
                    float ss = 0.f;
#pragma unroll
                    for (int bj = 0; bj < 2; ++bj)
#pragma unroll
                        for (int n = 0; n < 2; ++n) { const f32x4 x = acc[ai][bj][m][n]; ss += (x[0] * x[0] + x[1] * x[1]) + (x[2] * x[2] + x[3] * x[3]); }
                    ss += __shfl_xor(ss, 16); ss += __shfl_xor(ss, 32);
                    const float rstd = __builtin_amdgcn_rsqf(ss * (1.f / 64.f) + 1e-6f);
                    bf16_t* rowp = base + (size_t)(row0 + ai * HALF + m * 16) * ld + col0;
#pragma unroll
                    for (int bj = 0; bj < 2; ++bj) { f32x4 y0 = acc[ai][bj][m][0] * rstd * gm[bj][0], y1 = acc[ai][bj][m][1] * rstd * gm[bj][1];
                        if (rope_on) { const int pos = bj == 0 ? (t >> 6) : (t & 63); const float* tp = rope + (pos * 16 + 4 * fq) * 2;
                            const f32x4 c01 = *(const f32x4*)tp, c23 = *(const f32x4*)(tp + 4);
                            y0 = (f32x4){y0[0] * c01[0] - y0[1] * c01[1], y0[0] * c01[1] + y0[1] * c01[0], y0[2] * c01[2] - y0[3] * c01[3], y0[2] * c01[3] + y0[3] * c01[2]};
                            y1 = (f32x4){y1[0] * c23[0] - y1[1] * c23[1], y1[0] * c23[1] + y1[1] * c23[0], y1[2] * c23[2] - y1[3] * c23[3], y1[2] * c23[3] + y1[3] * c23[2]}; }
                        u32x4 w; w.x = cvt_pk_bf16(y0[0], y0[1]); w.y = cvt_pk_bf16(y0[2], y0[3]); w.z = cvt_pk_bf16(y1[0], y1[1]); w.w = cvt_pk_bf16(y1[2], y1[3]);
                        *(u32x4*)(rowp + 32 * bj) = w; } }
            return;
        }
        const int col0 = colt + wc * 32 + 8 * fq;
#pragma unroll
        for (int ai = 0; ai < 2; ++ai)
#pragma unroll
            for (int m = 0; m < 4; ++m) { bf16_t* rowp = base + (size_t)(row0 + ai * HALF + m * 16) * ld + col0;
#pragma unroll
                for (int bj = 0; bj < 2; ++bj) { const f32x4 v0 = acc[ai][bj][m][0], v1 = acc[ai][bj][m][1];
                    u32x4 w; w.x = cvt_pk_bf16(v0[0], v0[1]); w.y = cvt_pk_bf16(v0[2], v0[3]); w.z = cvt_pk_bf16(v1[0], v1[1]); w.w = cvt_pk_bf16(v1[2], v1[3]);
                    *(u32x4*)(rowp + bj * HALF) = w; } }
    }
};
struct EpiRes {
    static constexpr bool PERM = false, AFTER_DRAIN = false;
    const float* base; float* out; const float* gate;
    __device__ __forceinline__ void operator()(const f32x4 (&acc)[2][2][4][2], const Unit& u, int wr, int wc, int fr, int fq) const {
        const int col0 = u.pn * BM + wc * 32 + 4 * fq; const float* gp = gate + (size_t)(u.pm >> 4) * 6144 + col0;
        f32x4 gv[2][2];
#pragma unroll
        for (int bj = 0; bj < 2; ++bj)
#pragma unroll
            for (int n = 0; n < 2; ++n) gv[bj][n] = *(const f32x4*)(gp + bj * HALF + n * 16);
#pragma unroll
        for (int ai = 0; ai < 2; ++ai)
#pragma unroll
            for (int m = 0; m < 4; ++m) { const size_t off = (size_t)(u.pm * BM + ai * HALF + wr * 64 + m * 16 + fr) * 1024 + col0;
#pragma unroll
                for (int bj = 0; bj < 2; ++bj)
#pragma unroll
                    for (int n = 0; n < 2; ++n) { const f32x4 bs = *(const f32x4*)(base + off + bj * HALF + n * 16);
                        *(f32x4*)(out + off + bj * HALF + n * 16) = bs + gv[bj][n] * acc[ai][bj][m][n]; }
                if (m & 1) asm volatile("" ::: "memory"); }
    }
};
struct OrderQKV {
    StaticOrder so;
    __host__ __device__ void init(int G_, int c_) { so.init(16384, 2560, G_, c_); }
    __host__ __device__ bool next(int i, Unit& u) const {
        const long L = (long)i * so.G + so.c; if (L < so.nwg) return so.next(i, u);
        const int e = (int)(L - so.nwg); if (e >= 24) return false; u.pm = 64 + e / 6; u.pn = 4 + e % 6; return true; }
    __device__ __forceinline__ void a_ready(const Unit&) const {}
    __device__ __forceinline__ void done(const Unit&) const {}
};

template <class Epi, class Sched, bool ALIGN_EPI = false, bool SP2 = false>
__device__ __forceinline__ void gemm_phase(PG8_LAS unsigned char* lds, const Gemm g, const Sched& S, const Epi& E) {
    const int tid = ltid(), wid = __builtin_amdgcn_readfirstlane(tid >> 6), lane = tid & 63, wr = wid >> 2, wc = wid & 3, fr = lane & 15, fq = lane >> 4;
    const int K = g.K, nt = K / BK;
    unsigned voffA[2], voffB[2];
#pragma unroll
    for (int i = 0; i < 2; ++i) { int R, C; stage_rc(tid * 16 + i * 8192, R, C); const int Rb = Epi::PERM ? ((R & ~31) + perm32(R & 31)) : R;
        voffA[i] = (unsigned)(R * K + C) * 2u; voffB[i] = (unsigned)(Rb * K + C) * 2u; }
    const size_t kstep = (size_t)(BK * 2);
    const size_t hstep = (size_t)HALF * K * 2;
    const size_t tstep = 2 * hstep;
    const unsigned ldsw = (unsigned)wid * 1024u;
    const int aoff = lds_byte(wr * 64 + fr, fq * 8), boff = lds_byte(wc * 32 + fr, fq * 8);
#define PG8_SA(b, h) (((b) * 2 + (h)) * HTB)
#define PG8_SB(b, h) ((4 + (b) * 2 + (h)) * HTB)
#define PG8_STAGE(bufoff, gbase, voff) do { _Pragma("unroll") for (int _i = 0; _i < 2; ++_i) \
        __builtin_amdgcn_global_load_lds((const unsigned*)((const char*)(gbase) + (voff)[_i]), (PG8_LAS unsigned*)(lds + (bufoff) + ldsw + _i * 8192), 16, 0, 0); } while (0)
#define PG8_LDA(dst, b, h) do { _Pragma("unroll") for (int m = 0; m < 4; ++m) _Pragma("unroll") for (int k = 0; k < 2; ++k) dst[m][k] = *(const PG8_LAS bf16x8*)(lds + PG8_SA(b, h) + aoff + m * 2048 + k * 1024); } while (0)
#define PG8_LDB(dst, b, h) do { _Pragma("unroll") for (int n = 0; n < 2; ++n) _Pragma("unroll") for (int k = 0; k < 2; ++k) dst[n][k] = *(const PG8_LAS bf16x8*)(lds + PG8_SB(b, h) + boff + n * 2048 + k * 1024); } while (0)
#define PG8_MMA(ai, bj, At, Bt) do { __builtin_amdgcn_s_setprio(1); _Pragma("unroll") for (int m = 0; m < 4; ++m) _Pragma("unroll") for (int n = 0; n < 2; ++n) _Pragma("unroll") for (int k = 0; k < 2; ++k) \
        acc[ai][bj][m][n] = __builtin_amdgcn_mfma_f32_16x16x32_bf16(Bt[n][k], At[m][k], acc[ai][bj][m][n], 0, 0, 0); __builtin_amdgcn_s_setprio(0); } while (0)
#define PG8_WAIT_V(n) asm volatile("s_waitcnt vmcnt(" #n ")" ::: "memory")
#define PG8_WAIT_L(n) asm volatile("s_waitcnt lgkmcnt(" #n ")" ::: "memory")
#define PG8_BAR __builtin_amdgcn_s_barrier()
#define PG8_SCHED __builtin_amdgcn_sched_barrier(0)
    Unit cur, nxt; int ui = 0;
    if (!S.next(0, cur)) return;
    f32x4 acc[2][2][4][2];
#pragma unroll
    for (int a = 0; a < 2; ++a)
#pragma unroll
        for (int b = 0; b < 2; ++b)
#pragma unroll
            for (int m = 0; m < 4; ++m)
#pragma unroll
                for (int n = 0; n < 2; ++n) acc[a][b][m][n] = (f32x4){0.f, 0.f, 0.f, 0.f};
    bf16x8 At[4][2], B0[2][2], B1[2][2];
    const char* cA = (const char*)g.A + (size_t)cur.pm * tstep; const char* cB = (const char*)g.Bt + (size_t)cur.pn * tstep;
    S.a_ready(cur);
    if constexpr (SP2) {
        PG8_STAGE(PG8_SB(0, 0), cB, voffB); PG8_STAGE(PG8_SB(0, 1), cB + hstep, voffB); PG8_STAGE(PG8_SA(0, 0), cA, voffA); PG8_STAGE(PG8_SA(0, 1), cA + hstep, voffA);
        if (wr == 1) PG8_BAR;
        PG8_WAIT_V(2); PG8_BAR;
        PG8_STAGE(PG8_SB(1, 0), cB + kstep, voffB); PG8_STAGE(PG8_SA(1, 0), cA + kstep, voffA); PG8_STAGE(PG8_SB(1, 1), cB + hstep + kstep, voffB);
        PG8_WAIT_V(6); PG8_BAR;
    } else {
        PG8_STAGE(PG8_SB(0, 0), cB, voffB); PG8_STAGE(PG8_SA(0, 0), cA, voffA); PG8_STAGE(PG8_SB(0, 1), cB + hstep, voffB); PG8_STAGE(PG8_SA(0, 1), cA + hstep, voffA);
        if (wr == 1) PG8_BAR;
        PG8_WAIT_V(4); PG8_BAR;
        PG8_STAGE(PG8_SB(1, 0), cB + kstep, voffB); PG8_STAGE(PG8_SA(1, 0), cA + kstep, voffA); PG8_STAGE(PG8_SB(1, 1), cB + hstep + kstep, voffB);
        PG8_WAIT_V(6); PG8_BAR;
    }
    for (;;) {
        const bool has_next = S.next(ui + 1, nxt);
        const char* nA = has_next ? (const char*)g.A + (size_t)nxt.pm * tstep : cA; const char* nB = has_next ? (const char*)g.Bt + (size_t)nxt.pn * tstep : cB;
        for (int t = 0; t < nt; t += 2) {
            const bool last = (t == nt - 2);
            const char* a1 = cA + (size_t)(t + 1) * kstep;
            const char* a2 = last ? nA : cA + (size_t)(t + 2) * kstep; const char* b2 = last ? nB : cB + (size_t)(t + 2) * kstep;
            const char* a3 = a2 + kstep; const char* b3 = b2 + kstep;
            if (last && has_next) S.a_ready(nxt);
            if constexpr (SP2) {
            PG8_LDB(B0, 0, 0); PG8_LDB(B1, 0, 1); PG8_SCHED; PG8_LDA(At, 0, 0); PG8_STAGE(PG8_SA(1, 1), a1 + hstep, voffA);
            PG8_WAIT_V(8); PG8_WAIT_L(0); PG8_BAR; PG8_MMA(0, 0, At, B0); PG8_MMA(0, 1, At, B1); PG8_BAR; PG8_SCHED;
            PG8_LDA(At, 0, 1); PG8_STAGE(PG8_SB(0, 0), b2, voffB); PG8_STAGE(PG8_SB(0, 1), b2 + hstep, voffB); PG8_STAGE(PG8_SA(0, 0), a2, voffA);
            PG8_WAIT_V(8); PG8_WAIT_L(0); PG8_BAR; PG8_MMA(1, 0, At, B0); PG8_MMA(1, 1, At, B1); PG8_BAR; PG8_SCHED;
            PG8_LDB(B0, 1, 0); PG8_LDB(B1, 1, 1); PG8_SCHED; PG8_LDA(At, 1, 0); PG8_STAGE(PG8_SA(0, 1), a2 + hstep, voffA);
            PG8_WAIT_V(8); PG8_WAIT_L(0); PG8_BAR; PG8_MMA(0, 0, At, B0); PG8_MMA(0, 1, At, B1); PG8_BAR; PG8_SCHED;
            PG8_LDA(At, 1, 1); PG8_STAGE(PG8_SB(1, 0), b3, voffB); PG8_STAGE(PG8_SB(1, 1), b3 + hstep, voffB); PG8_STAGE(PG8_SA(1, 0), a3, voffA);
            PG8_WAIT_V(8); PG8_WAIT_L(0); PG8_BAR; PG8_MMA(1, 0, At, B0); PG8_MMA(1, 1, At, B1); PG8_BAR; PG8_SCHED;
            } else {
            PG8_LDB(B0, 0, 0); PG8_SCHED; PG8_LDA(At, 0, 0); PG8_STAGE(PG8_SA(1, 1), a1 + hstep, voffA);
            PG8_WAIT_L(8); PG8_BAR; PG8_WAIT_L(0); PG8_MMA(0, 0, At, B0); PG8_BAR; PG8_SCHED;
            PG8_LDB(B1, 0, 1); PG8_STAGE(PG8_SB(0, 0), b2, voffB);
            PG8_BAR; PG8_WAIT_L(0); PG8_MMA(0, 1, At, B1); PG8_BAR;
            PG8_LDA(At, 0, 1); PG8_STAGE(PG8_SA(0, 0), a2, voffA);
            PG8_BAR; PG8_WAIT_L(0); PG8_MMA(1, 0, At, B0); PG8_BAR; PG8_SCHED;
            PG8_STAGE(PG8_SB(0, 1), b2 + hstep, voffB);
            PG8_WAIT_V(6); PG8_BAR; PG8_MMA(1, 1, At, B1); PG8_BAR;
            PG8_LDB(B0, 1, 0); PG8_SCHED; PG8_LDA(At, 1, 0); PG8_STAGE(PG8_SA(0, 1), a2 + hstep, voffA);
            PG8_WAIT_L(8); PG8_BAR; PG8_WAIT_L(0); PG8_MMA(0, 0, At, B0); PG8_BAR; PG8_SCHED;
            PG8_LDB(B1, 1, 1); PG8_STAGE(PG8_SB(1, 0), b3, voffB);
            PG8_BAR; PG8_WAIT_L(0); PG8_MMA(0, 1, At, B1); PG8_BAR;
            PG8_LDA(At, 1, 1); PG8_STAGE(PG8_SA(1, 0), a3, voffA);
            PG8_BAR; PG8_WAIT_L(0); PG8_MMA(1, 0, At, B0); PG8_BAR; PG8_SCHED;
            PG8_STAGE(PG8_SB(1, 1), b3 + hstep, voffB);
            PG8_WAIT_V(6); PG8_BAR; PG8_MMA(1, 1, At, B1); PG8_BAR;
            }
        }
        if constexpr (ALIGN_EPI) { if (wr == 0) PG8_BAR; }
        if constexpr (!Epi::AFTER_DRAIN) { E(acc, cur, wr, wc, fr, fq); S.done(cur); }
        if (!has_next) break;
#pragma unroll
        for (int a = 0; a < 2; ++a)
#pragma unroll
            for (int b = 0; b < 2; ++b)
#pragma unroll
                for (int m = 0; m < 4; ++m)
#pragma unroll
                    for (int n = 0; n < 2; ++n) acc[a][b][m][n] = (f32x4){0.f, 0.f, 0.f, 0.f};
        cur = nxt; cA = nA; cB = nB; ++ui;
        if constexpr (ALIGN_EPI) { if (wr == 1) PG8_BAR; }
    }
    PG8_WAIT_V(0);
    if constexpr (!ALIGN_EPI) { if (wr == 0) PG8_BAR; }
    PG8_BAR;
    if constexpr (Epi::AFTER_DRAIN) { E.fused(acc, cur, wr, wc, fr, fq, lds, wid, lane); S.done(cur); }
#undef PG8_SA
#undef PG8_SB
#undef PG8_STAGE
#undef PG8_LDA
#undef PG8_LDB
#undef PG8_MMA
#undef PG8_WAIT_V
#undef PG8_WAIT_L
#undef PG8_BAR
#undef PG8_SCHED
}
}

namespace att {
using bf16x8 = __attribute__((ext_vector_type(8))) short;
using s16x4  = __attribute__((ext_vector_type(4))) short;
using f32x16 = __attribute__((ext_vector_type(16))) float;
using u32x4  = __attribute__((ext_vector_type(4))) unsigned;
typedef unsigned short bf16;
constexpr int NW = 8, QBLK = 32, KVBLK = 64, LDQ = 768, LDK = 768, LDY = 1024, SEQK = 4352;
constexpr float SCALE = 0.125f, THR = 8.f;
constexpr int SDEPTH = 2;
constexpr size_t SHM_V = KVBLK * 128 * 2, SHM_K = KVBLK * 128 * 2, SHM_ATTN = 2 * SHM_V + 2 * SHM_K + NW * 64 * 4;
#define KSWZ(row, colB) ((row) * 256 + ((colB) ^ (((row) & 7) << 4)))
#define SBAR() __builtin_amdgcn_sched_barrier(0)
__device__ __forceinline__ int crow(int r, int hi) { return (r & 3) + 8 * (r >> 2) + 4 * hi; }
__device__ __forceinline__ unsigned cvtpk(float lo, float hi) { unsigned r; asm volatile("v_cvt_pk_bf16_f32 %0, %1, %2" : "=v"(r) : "v"(lo), "v"(hi)); return r; }
__device__ __forceinline__ unsigned short f2bf(float f) { unsigned u = __builtin_bit_cast(unsigned, f); return (unsigned short)((u + 0x7fffu + ((u >> 16) & 1u)) >> 16); }

__device__ __forceinline__ void partialSM(f32x16& p0, f32x16& p1, float& m_reg, float& mn, float& alpha) {
  constexpr float C = SCALE * 1.4426950408889634f;
  float pmax = p0[0];
#pragma unroll
  for (int r = 1; r < 16; ++r) pmax = fmaxf(pmax, p0[r]);
#pragma unroll
  for (int r = 0; r < 16; ++r) pmax = fmaxf(pmax, p1[r]);
  { auto rr = __builtin_amdgcn_permlane32_swap(__float_as_uint(pmax), __float_as_uint(pmax), false, false);
    pmax = fmaxf(__uint_as_float(rr[0]), __uint_as_float(rr[1])); }
  if (__builtin_expect(__all(pmax - m_reg <= THR / SCALE), 1)) { mn = m_reg; alpha = 1.f; }
  else { mn = fmaxf(m_reg, pmax); alpha = __builtin_amdgcn_exp2f((m_reg - mn) * C); m_reg = mn; }
  float mnC = -mn * C;
#pragma unroll
  for (int r = 0; r < 16; ++r) p0[r] = fmaf(p0[r], C, mnC);
#pragma unroll
  for (int r = 0; r < 16; ++r) p1[r] = fmaf(p1[r], C, mnC);
#pragma unroll
  for (int r = 0; r < 16; ++r) p0[r] = __builtin_amdgcn_exp2f(p0[r]);
}
__device__ __forceinline__ void partialSM_fixed(f32x16& p0, f32x16& p1, float mBC) {
  constexpr float C = SCALE * 1.4426950408889634f;
#pragma unroll
  for (int r = 0; r < 16; ++r) p0[r] = fmaf(p0[r], C, mBC);
#pragma unroll
  for (int r = 0; r < 16; ++r) p1[r] = fmaf(p1[r], C, mBC);
#pragma unroll
  for (int r = 0; r < 16; ++r) p0[r] = __builtin_amdgcn_exp2f(p0[r]);
}
__device__ __forceinline__ void finishSM(f32x16& p0, f32x16& p1, float alpha, float& l_reg, bf16x8& pa0, bf16x8& pa1, bf16x8& pa2, bf16x8& pa3) {
#pragma unroll
  for (int r = 0; r < 16; ++r) p1[r] = __builtin_amdgcn_exp2f(p1[r]);
  float ps = 0;
#pragma unroll
  for (int r = 0; r < 16; ++r) ps += p0[r];
#pragma unroll
  for (int r = 0; r < 16; ++r) ps += p1[r];
  { auto rr = __builtin_amdgcn_permlane32_swap(__float_as_uint(ps), __float_as_uint(ps), false, false);
    ps = __uint_as_float(rr[0]) + __uint_as_float(rr[1]); }
  l_reg = l_reg * alpha + ps;
#define PK4(P, BASE, OUT) do { unsigned a0 = cvtpk(P[BASE + 0], P[BASE + 1]), a1 = cvtpk(P[BASE + 2], P[BASE + 3]);   \
    unsigned b0 = cvtpk(P[BASE + 4], P[BASE + 5]), b1 = cvtpk(P[BASE + 6], P[BASE + 7]);                              \
    auto r0 = __builtin_amdgcn_permlane32_swap(a0, b0, false, false); auto r1 = __builtin_amdgcn_permlane32_swap(a1, b1, false, false); \
    u32x4 w = {r0[0], r1[0], r0[1], r1[1]}; OUT = *reinterpret_cast<bf16x8*>(&w); } while (0)
  PK4(p0, 0, pa0); PK4(p0, 8, pa1); PK4(p1, 0, pa2); PK4(p1, 8, pa3);
#undef PK4
}
__device__ __forceinline__ void qkt(f32x16& p0, f32x16& p1, const bf16* Ks, const bf16x8* qr, int r32, int hi, int comp) {
  p0 = f32x16{}; p1 = f32x16{};
#pragma unroll
  for (int d0 = 0; d0 < 4; ++d0) { int cb = (comp * 64 + d0 * 16 + hi * 8) * 2;
    bf16x8 b0 = *reinterpret_cast<const bf16x8*>((const char*)Ks + KSWZ(r32, cb));
    bf16x8 b1 = *reinterpret_cast<const bf16x8*>((const char*)Ks + KSWZ(32 + r32, cb));
    p0 = __builtin_amdgcn_mfma_f32_32x32x16_bf16(b0, qr[d0], p0, 0, 0, 0);
    p1 = __builtin_amdgcn_mfma_f32_32x32x16_bf16(b1, qr[d0], p1, 0, 0, 0); }
}
__device__ __forceinline__ int v_st(int k, int c) { const int kk = (k & ~0xC) | ((k & 4) << 1) | ((k & 8) >> 1); return ((kk >> 3) * 4 + (c >> 5)) * 512 + ((kk & 7) * 32 + (c & 31)) * 2; }
__device__ __forceinline__ int v_rd_base(int lane) { return ((lane & 3) << 3) | (((lane >> 2) & 3) << 6) | (((lane >> 4) & 1) << 5) | (((lane >> 5) & 1) << 8); }
constexpr int v_rd_off(int d0, int ks, int half) { return d0 * 512 + ks * 4096 + half * 2048; }
template <int OFF> __device__ __forceinline__ s16x4 tr_read(int vb) {
  s16x4 r; asm volatile("ds_read_b64_tr_b16 %0, %1 offset:%2" : "=&v"(r) : "v"(vb), "i"(OFF) : "memory"); return r;
}
template <int D0> __device__ __forceinline__ void pv_one(f32x16& od, int vb, bf16x8 pa0, bf16x8 pa1, bf16x8 pa2, bf16x8 pa3) {
  const s16x4 l0 = tr_read<v_rd_off(D0, 0, 0)>(vb), h0 = tr_read<v_rd_off(D0, 0, 1)>(vb), l1 = tr_read<v_rd_off(D0, 1, 0)>(vb), h1 = tr_read<v_rd_off(D0, 1, 1)>(vb);
  const s16x4 l2 = tr_read<v_rd_off(D0, 2, 0)>(vb), h2 = tr_read<v_rd_off(D0, 2, 1)>(vb), l3 = tr_read<v_rd_off(D0, 3, 0)>(vb), h3 = tr_read<v_rd_off(D0, 3, 1)>(vb);
  asm volatile("s_waitcnt lgkmcnt(0)" ::: "memory"); SBAR();
#define PK(L, H) (bf16x8){L[0], L[1], L[2], L[3], H[0], H[1], H[2], H[3]}
  od = __builtin_amdgcn_mfma_f32_32x32x16_bf16(pa0, PK(l0, h0), od, 0, 0, 0);
  od = __builtin_amdgcn_mfma_f32_32x32x16_bf16(pa1, PK(l1, h1), od, 0, 0, 0);
  od = __builtin_amdgcn_mfma_f32_32x32x16_bf16(pa2, PK(l2, h2), od, 0, 0, 0);
  od = __builtin_amdgcn_mfma_f32_32x32x16_bf16(pa3, PK(l3, h3), od, 0, 0, 0);
#undef PK
}
__device__ __forceinline__ void pv_d0(f32x16* o, int vb, bf16x8 pa0, bf16x8 pa1, bf16x8 pa2, bf16x8 pa3) {
  pv_one<0>(o[0], vb, pa0, pa1, pa2, pa3); pv_one<1>(o[1], vb, pa0, pa1, pa2, pa3); pv_one<2>(o[2], vb, pa0, pa1, pa2, pa3); pv_one<3>(o[3], vb, pa0, pa1, pa2, pa3);
}

template <bool FIXED> __device__ __forceinline__ void attn_unit(const bf16* __restrict__ Qb, const bf16* __restrict__ Kh, const bf16* __restrict__ Vh, bf16* __restrict__ Yb,
                                          const float* __restrict__ subg, float lam, float mBC, char* lds) {
  const int tid = ltid(), wid = tid >> 6, lane = tid & 63, r32 = lane & 31, hi = lane >> 5;
  const int comp = wid >> 2, wq = wid & 3;
  bf16* V_lds = (bf16*)lds; bf16* K_lds = (bf16*)(lds + 2 * SHM_V);
  float* ws = (float*)(lds + 2 * SHM_V + 2 * SHM_K) + wid * 64; float* li_l = ws; float* al_l = ws + 32;
  float m_reg = -1e30f, l_reg = 0; f32x16 o[4] = {}; bf16x8 qr[4];
  const bf16* Qw = Qb + (long)(wq * QBLK + r32) * LDQ + comp * 64 + hi * 8;
#pragma unroll
  for (int d0 = 0; d0 < 4; ++d0) qr[d0] = *reinterpret_cast<const bf16x8*>(Qw + d0 * 16);
  const int sr = tid >> 4, sc = (tid & 15) * 8, vst0 = v_st(sr, sc), vst1 = v_st(32 + sr, sc);
  const int vb0 = (int)(uintptr_t)V_lds + v_rd_base(lane);
  struct { bf16x8 vs0, vs1, ks0, ks1; } sr_[SDEPTH];
#define SLOAD(i, k0) do { sr_[i].vs0 = *reinterpret_cast<const bf16x8*>(&Vh[(long)((k0) + sr) * LDK + sc]); sr_[i].vs1 = *reinterpret_cast<const bf16x8*>(&Vh[(long)((k0) + 32 + sr) * LDK + sc]); \
    sr_[i].ks0 = *reinterpret_cast<const bf16x8*>(&Kh[(long)((k0) + sr) * LDK + sc]); sr_[i].ks1 = *reinterpret_cast<const bf16x8*>(&Kh[(long)((k0) + 32 + sr) * LDK + sc]); } while (0)
#define SWRITE(b, i) do { *(bf16x8*)((char*)V_lds + (b) * SHM_V + vst0) = sr_[i].vs0;          \
    *(bf16x8*)((char*)V_lds + (b) * SHM_V + vst1) = sr_[i].vs1; int kc = sc * 2;               \
    *(bf16x8*)((char*)K_lds + (b) * SHM_K + KSWZ(sr, kc)) = sr_[i].ks0;                       \
    *(bf16x8*)((char*)K_lds + (b) * SHM_K + KSWZ(32 + sr, kc)) = sr_[i].ks1; } while (0)
#define SWAIT() do { asm volatile("s_waitcnt vmcnt(4)" ::: "memory"); } while (0)
#define PSM(P0, P1, MN, AL) do { if constexpr (FIXED) { partialSM_fixed(P0, P1, mBC); AL = 1.f; } else partialSM(P0, P1, m_reg, MN, AL); } while (0)
#define RESC(a) do { if constexpr (!FIXED) if (__any((a) < 1.f)) { if (hi == 0) al_l[r32] = (a); asm volatile("s_waitcnt lgkmcnt(0)" ::: "memory"); \
    _Pragma("unroll") for (int d = 0; d < 4; ++d) _Pragma("unroll") for (int r = 0; r < 16; ++r) o[d][r] *= al_l[crow(r, hi)]; } } while (0)
  f32x16 pA0, pA1, pB0, pB1; float mnA, mnB, alA, alB; bf16x8 pa0, pa1, pa2, pa3; constexpr int NT = SEQK / KVBLK;
  constexpr int SE = 0, SO = SDEPTH - 1;
  SLOAD(SE, 0); asm volatile("s_waitcnt vmcnt(0)" ::: "memory"); SWRITE(0, SE); __syncthreads();
  qkt(pA0, pA1, K_lds, qr, r32, hi, comp); PSM(pA0, pA1, mnA, alA);
  SLOAD(SO, KVBLK); if (2 < NT) SLOAD(SE, 2 * KVBLK);
  SWAIT(); SWRITE(1, SO); __syncthreads();
  for (int j = 1; j + 1 < NT; j += 2) {
    SBAR(); qkt(pB0, pB1, (bf16*)((char*)K_lds + SHM_K), qr, r32, hi, comp);
    finishSM(pA0, pA1, alA, l_reg, pa0, pa1, pa2, pa3); SBAR();
    SLOAD(SO, (j + SDEPTH) * KVBLK); SBAR();
    pv_d0(o, vb0, pa0, pa1, pa2, pa3); PSM(pB0, pB1, mnB, alB);
    __syncthreads(); SWAIT(); SWRITE(0, SE);
    RESC(alB); __syncthreads();
    SBAR(); qkt(pA0, pA1, K_lds, qr, r32, hi, comp);
    finishSM(pB0, pB1, alB, l_reg, pa0, pa1, pa2, pa3); SBAR();
    if (j + 3 < NT) SLOAD(SE, (j + 1 + SDEPTH) * KVBLK); SBAR();
    pv_d0(o, vb0 + (int)SHM_V, pa0, pa1, pa2, pa3); PSM(pA0, pA1, mnA, alA);
    __syncthreads(); SWAIT(); SWRITE(1, SO);
    RESC(alA); __syncthreads();
  }
  SBAR(); qkt(pB0, pB1, (bf16*)((char*)K_lds + SHM_K), qr, r32, hi, comp);
  finishSM(pA0, pA1, alA, l_reg, pa0, pa1, pa2, pa3); SBAR();
  pv_d0(o, vb0, pa0, pa1, pa2, pa3); PSM(pB0, pB1, mnB, alB);
  __syncthreads(); RESC(alB);
  finishSM(pB0, pB1, alB, l_reg, pa0, pa1, pa2, pa3); SBAR();
  pv_d0(o, vb0 + (int)SHM_V, pa0, pa1, pa2, pa3);
  if (hi == 0) li_l[r32] = l_reg; asm volatile("s_waitcnt lgkmcnt(0)" ::: "memory");
  float rli[16];
#pragma unroll
  for (int r = 0; r < 16; ++r) rli[r] = __builtin_amdgcn_rcpf(li_l[crow(r, hi)]);
  __syncthreads();
  float* X = (float*)lds + wq * 4096;
  if (comp == 1) {
#pragma unroll
    for (int d0 = 0; d0 < 4; ++d0)
#pragma unroll
      for (int r = 0; r < 16; ++r) X[(d0 * 16 + r) * 64 + lane] = o[d0][r] * rli[r] * lam;
  }
  __syncthreads();
  if (comp == 0) {
    float ss[16];
#pragma unroll
    for (int r = 0; r < 16; ++r) ss[r] = 0.f;
#pragma unroll
    for (int d0 = 0; d0 < 4; ++d0)
#pragma unroll
      for (int r = 0; r < 16; ++r) { const float d = o[d0][r] * rli[r] - X[(d0 * 16 + r) * 64 + lane]; o[d0][r] = d; ss[r] += d * d; }
#pragma unroll
    for (int r = 0; r < 16; ++r) {
#pragma unroll
      for (int off = 1; off < 32; off <<= 1) ss[r] += __shfl_xor(ss[r], off);
    }
    float g4[4];
#pragma unroll
    for (int d0 = 0; d0 < 4; ++d0) g4[d0] = subg[d0 * 32 + r32] * 0.8f;
#pragma unroll
    for (int r = 0; r < 16; ++r) { const float rs = rsqrtf(ss[r] * (1.f / 128.f) + 1e-6f); bf16* yrow = Yb + (long)(wq * QBLK + crow(r, hi)) * LDY;
#pragma unroll
      for (int d0 = 0; d0 < 4; ++d0) yrow[d0 * 32 + r32] = f2bf(o[d0][r] * rs * g4[d0]); }
  }
  __syncthreads();
#undef SLOAD
#undef SWRITE
#undef SWAIT
#undef RESC
#undef PSM
}
#undef SBAR
}


#ifndef MK_DEBUG
#define MK_DEBUG 0
#endif
#define PROBE_XB
#ifndef MK_SIMPLE6
#define MK_SIMPLE6 0
#endif
#ifndef NPH_RUN
#define NPH_RUN 16
#endif
#ifndef PHMASK
#define PHMASK 0xFFFF
#endif
#define PHM(k) ((PHMASK >> (k)) & 1)
#ifndef MK_MULTI
#define MK_MULTI 0
#endif
#define LAS __attribute__((address_space(3)))
#define GAS __attribute__((address_space(1)))
typedef unsigned short bf16;
typedef unsigned v4u __attribute__((ext_vector_type(4)));
typedef unsigned v2u __attribute__((ext_vector_type(2)));
typedef float f32x4 __attribute__((ext_vector_type(4)));
typedef short bf16x8 __attribute__((ext_vector_type(8)));
typedef float f32x16 __attribute__((ext_vector_type(16)));
#define LDS_WAIT() asm volatile("s_waitcnt lgkmcnt(0)" ::: "memory")
constexpr int NWAVES = 8, NTHR = 512, NPH = 16;
constexpr int SEQ = 4096, DM = 1024, MTOK = 16384, TKV = 4352, FF = 4096, MODW = 6144;
constexpr size_t MiB = 1u << 20;
constexpr size_t WS_ROPE = 524288;
constexpr size_t WS_MOD = 1 * MiB, WS_WIN = 2 * MiB, WS_WOUT = 7 * MiB, WS_W1 = 9 * MiB, WS_W2 = 25 * MiB, WS_ODIN = 41 * MiB, WS_ODOUT = 49 * MiB;
constexpr size_t WS_XN = 56 * MiB;
constexpr size_t WS_Q = 92 * MiB, WS_K = 116 * MiB, WS_V = 142 * MiB, WS_POOL = 168 * MiB, WS_Y = 176 * MiB;
constexpr size_t WS_HB = 92 * MiB;
constexpr size_t WS_U = 92 * MiB, WS_VT = 156 * MiB;
constexpr size_t WS_END = 220 * MiB;
constexpr int LDS_BYTES = 147456;

__device__ __forceinline__ unsigned f2bf(float f) { unsigned u = __builtin_bit_cast(unsigned, f); return (u + 0x7fffu + ((u >> 16) & 1u)) >> 16; }
__device__ __forceinline__ unsigned pk2(float lo, float hi) { return f2bf(lo) | (f2bf(hi) << 16); }
__device__ __forceinline__ float bflo(unsigned w) { return __builtin_bit_cast(float, w << 16); }
__device__ __forceinline__ float bfhi(unsigned w) { return __builtin_bit_cast(float, w & 0xffff0000u); }
__device__ __forceinline__ float wave_sum(float v) {
#pragma unroll
    for (int o = 1; o < 64; o <<= 1) v += __shfl_xor(v, o);
    return v;
}

struct Args { const float* in[27]; float* out; unsigned char* ws; int ph_lo, ph_hi; };

__device__ __forceinline__ void p0_transpose_item(const float* W, int K, int N, bf16* WT, LAS float* scr, int item, int lane, bool permqk = false) {
    const int nblk = N / 32, kb = item / nblk, nb = item % nblk, k0 = 64 * kb, n0 = 32 * nb;
    int d0 = n0;
    if (permqk) { const int tile = n0 >> 8, c = n0 & 255; if (tile >= 1 && tile <= 6) d0 = tile * 256 + 128 * ((c >> 5) & 1) + 32 * (c >> 6); }
#pragma unroll 8
    for (int i = 0; i < 32; ++i) { const int kk = 2 * i + (lane >> 5); scr[kk * 33 + (lane & 31)] = W[(size_t)(k0 + kk) * N + n0 + (lane & 31)]; }
    LDS_WAIT(); asm volatile("" ::: "memory");
    const int c = lane & 7;
#pragma unroll
    for (int j = 0; j < 4; ++j) { const int n = (lane >> 3) + 8 * j; const LAS float* s = scr + (8 * c) * 33 + n;
        v4u o; o.x = pk2(s[0 * 33], s[1 * 33]); o.y = pk2(s[2 * 33], s[3 * 33]); o.z = pk2(s[4 * 33], s[5 * 33]); o.w = pk2(s[6 * 33], s[7 * 33]);
        *(v4u*)(WT + (size_t)(d0 + n) * K + k0 + 8 * c) = o; }
    LDS_WAIT(); asm volatile("" ::: "memory");
}
__device__ __forceinline__ void p0_prep(const Args& a, unsigned char* ldsg, int vcu, int G) {
    LAS unsigned char* lds = (LAS unsigned char*)ldsg;
    const int tid = ltid(), lane = tid & 63, wave = tid >> 6;
    float* mod = (float*)(a.ws + WS_MOD);
    for (int item = blockIdx.x; item < 192; item += G) {
        LAS float* sin_ = (LAS float*)lds;
        for (int i = tid; i < 5 * 1024; i += NTHR) { const int r = i >> 10, k = i & 1023; const float c = r < 4 ? a.in[1][r * 1024 + k] : a.in[3][k]; sin_[i] = c / (1.f + __expf(-c)); }
        __syncthreads();
        const int l = item / 96, cb = item % 96;
        const float* W = a.in[4] + (size_t)l * 1024 * MODW + cb * 64 + lane;
        float acc[5] = {0.f, 0.f, 0.f, 0.f, 0.f};
        const int k0 = wave * 128;
#pragma unroll 8
        for (int kk = 0; kk < 128; ++kk) { const int k = k0 + kk; const float w = W[(size_t)k * MODW];
#pragma unroll
            for (int r = 0; r < 5; ++r) acc[r] += sin_[r * 1024 + k] * w; }
        LAS float* red = (LAS float*)(lds + 20480);
#pragma unroll
        for (int r = 0; r < 5; ++r) red[(wave * 5 + r) * 64 + lane] = acc[r];
        __syncthreads();
        if (tid < 320) { const int r = tid >> 6, col = tid & 63; float s = 0.f;
#pragma unroll
            for (int w = 0; w < 8; ++w) s += red[(w * 5 + r) * 64 + col];
            s += a.in[5][l * MODW + cb * 64 + col]; mod[(size_t)(l * 5 + r) * MODW + cb * 64 + col] = s; }
        __syncthreads();
    }
    if (blockIdx.x == G - 1) { float* rt = (float*)(a.ws + WS_ROPE);
        for (int i = tid; i < 1024; i += NTHR) { const int pos = i >> 4, f = i & 15; const float inv = powf(10000.0f, -(float)f / 16.0f); const float ang = (float)pos * inv; float sn, cs; sincosf(ang, &sn, &cs); rt[2 * i] = cs; rt[2 * i + 1] = sn; } }
    LAS float* scr = (LAS float*)(lds + 32768 + wave * 8448);
    const int gw = vcu * NWAVES + wave, NGW = G * NWAVES;
    constexpr int I_WIN = 16 * 80, I_WOUT = 16 * 32, I_W1 = 16 * 128, I_W2 = 64 * 32, I_ODIN = 16 * 128, I_ODOUT = 32 * 32;
    constexpr int NITEMS = I_WIN + I_WOUT + 2 * I_W1 + 2 * I_W2 + I_ODIN + I_ODOUT;
    for (int it = gw; it < NITEMS; it += NGW) {
        int r = it;
        if (r < I_WIN) { p0_transpose_item(a.in[10], 1024, 2560, (bf16*)(a.ws + WS_WIN), scr, r, lane, true); continue; } r -= I_WIN;
        if (r < I_WOUT) { p0_transpose_item(a.in[11], 1024, 1024, (bf16*)(a.ws + WS_WOUT), scr, r, lane); continue; } r -= I_WOUT;
        if (r < 2 * I_W1) { const int l = r / I_W1; p0_transpose_item(a.in[8] + (size_t)l * 1024 * 4096, 1024, 4096, (bf16*)(a.ws + WS_W1) + (size_t)l * 4096 * 1024, scr, r % I_W1, lane); continue; } r -= 2 * I_W1;
        if (r < 2 * I_W2) { const int l = r / I_W2; p0_transpose_item(a.in[9] + (size_t)l * 4096 * 1024, 4096, 1024, (bf16*)(a.ws + WS_W2) + (size_t)l * 1024 * 4096, scr, r % I_W2, lane); continue; } r -= 2 * I_W2;
        if (r < I_ODIN) { p0_transpose_item(a.in[21], 1024, 4096, (bf16*)(a.ws + WS_ODIN), scr, r, lane); continue; } r -= I_ODIN;
        p0_transpose_item(a.in[26], 2048, 1024, (bf16*)(a.ws + WS_ODOUT), scr, r, lane);
    }
}

__device__ __forceinline__ void norm_row(const float* xrow, bf16* orow, const f32x4 (&gs)[4], const f32x4 (&sh)[4], int lane) {
    const f32x4* xr = (const f32x4*)xrow + lane;
    f32x4 v[4]; float s2 = 0.f;
#pragma unroll
    for (int j = 0; j < 4; ++j) { v[j] = xr[64 * j]; s2 += (v[j].x * v[j].x + v[j].y * v[j].y) + (v[j].z * v[j].z + v[j].w * v[j].w); }
    const float rstd = rsqrtf(wave_sum(s2) * (1.f / 1024.f) + 1e-6f);
    unsigned long long* o8 = (unsigned long long*)orow + lane;
#pragma unroll
    for (int j = 0; j < 4; ++j) { const f32x4 y = v[j] * rstd * gs[j] + sh[j];
        o8[64 * j] = (unsigned long long)pk2(y.x, y.y) | ((unsigned long long)pk2(y.z, y.w) << 32); }
}
__device__ __forceinline__ void load_mod(const float* g, const float* shp, const float* scp, f32x4 (&gs)[4], f32x4 (&sh)[4], int lane) {
#pragma unroll
    for (int j = 0; j < 4; ++j) { const int idx = 4 * lane + 256 * j; const f32x4 gv = *(const f32x4*)(g + idx), sv = *(const f32x4*)(scp + idx); gs[j] = gv * (sv + 1.0f); sh[j] = *(const f32x4*)(shp + idx); }
}
__device__ __forceinline__ void norm_phase(const float* src, const float* g, const float* modl, int sh_off, int sc_off, bf16* dst, const float* ctx, int vcu, int G) {
    const int tid = ltid(), lane = tid & 63, wave = tid >> 6;
    for (int rb = vcu; rb < 256; rb += G) {
        const int b = rb >> 6; f32x4 gs[4], sh[4];
        load_mod(g, modl + (size_t)b * MODW + sh_off, modl + (size_t)b * MODW + sc_off, gs, sh, lane);
        for (int rr = 0; rr < 8; ++rr) { const size_t row = (size_t)rb * 64 + wave * 8 + rr; norm_row(src + row * 1024, dst + row * 1024, gs, sh, lane); }
        if (ctx && wave < 4) {
            load_mod(g, modl + (size_t)4 * MODW + sh_off, modl + (size_t)4 * MODW + sc_off, gs, sh, lane);
            const size_t row = (size_t)rb * 4 + wave; norm_row(ctx + row * 1024, dst + ((size_t)MTOK + row) * 1024, gs, sh, lane);
        }
    }
}

__device__ __forceinline__ void pool_phase(const Args& a, unsigned char* lds, int vcu, int G) {
    const int tid = ltid(), lane = tid & 63, wave = tid >> 6;
    bf16* in_ = (bf16*)(lds + 8192);
    float* pooled = (float*)(lds + 8192 + 40960);
    const bf16* PI = (const bf16*)(a.ws + WS_POOL); bf16* Y = (bf16*)(a.ws + WS_Y);
    const float* pw = a.in[12]; const float* pscale = a.in[13];
    for (int tb = vcu; tb < 256; tb += G) {
        const int b = tb >> 6, t0 = (tb & 63) * 64;
        __syncthreads();
#pragma unroll
        for (int ps = 0; ps < 5; ++ps) { const int row = ps * 16 + (tid >> 5), c8 = (tid & 31) * 8, t = t0 - 8 + row;
            v4u w = {0u, 0u, 0u, 0u}; if (t >= 0 && t < SEQ) w = *(const v4u*)(PI + ((size_t)b * SEQ + t) * 256 + c8);
            *(v4u*)(in_ + row * 256 + c8) = w; }
        __syncthreads();
        { const int c = tid & 255, th = tid >> 8, hw = 1 << (c >> 6);
            for (int tt = 0; tt < 32; ++tt) { const int tl = th * 32 + tt, t = t0 + tl; const int lo = max(t - hw, 0), hi = min(t + hw, SEQ);
                float s = 0.f; for (int j = lo; j < hi; ++j) s += bflo((unsigned)in_[(j - t0 + 8) * 256 + c]);
                pooled[tl * 256 + c] = s / (float)(hi - lo) - bflo((unsigned)in_[(tl + 8) * 256 + c]); } }
        __syncthreads();
        { const int gi = wave & 3, th = wave >> 2; float pwr[64];
#pragma unroll
            for (int c = 0; c < 64; ++c) pwr[c] = pw[gi * 4096 + c * 64 + lane];
            const float psc = pscale[gi * 64 + lane];
            for (int tt = 0; tt < 32; ++tt) { const int tl = th * 32 + tt; const f32x4* pp = (const f32x4*)(pooled + tl * 256 + gi * 64); float acc = 0.f;
#pragma unroll
                for (int c4 = 0; c4 < 16; ++c4) { const f32x4 v = pp[c4]; acc += v.x * pwr[4 * c4] + v.y * pwr[4 * c4 + 1] + v.z * pwr[4 * c4 + 2] + v.w * pwr[4 * c4 + 3]; }
                Y[((size_t)b * SEQ + t0 + tl) * 1024 + gi * 64 + lane] = (bf16)f2bf(acc * psc); } }
    }
    __syncthreads();
}

__device__ __forceinline__ void attn_phase(const Args& a, unsigned char* lds, int vcu, int G) {
    const int lane = ltid() & 63;
    const float s1 = wave_sum(a.in[16][lane] * a.in[17][lane]), s2 = wave_sum(a.in[18][lane] * a.in[19][lane]);
    const float lam = expf(s1) - expf(s2) + 0.2f;
    float mq = fabsf(a.in[14][lane]), mk = fabsf(a.in[15][lane]);
#pragma unroll
    for (int o = 1; o < 64; o <<= 1) { mq = fmaxf(mq, __shfl_xor(mq, o)); mk = fmaxf(mk, __shfl_xor(mk, o)); }
    const float Bq = 0.125f * 64.f * mq * mk * 1.02f;
    const bool fixed = Bq <= 20.f;
    const float mBC = -Bq * 1.4426950408889634f;
    const bf16* Q = (const bf16*)(a.ws + WS_Q); const bf16* KA = (const bf16*)(a.ws + WS_K); const bf16* VA = (const bf16*)(a.ws + WS_V); bf16* Y = (bf16*)(a.ws + WS_Y);
    const int per = 768 / G;
    for (int i = 0; i < per; ++i) { const int u = vcu * per + i, bh = u >> 5, qb = u & 31, b = bh / 6, h = bh - b * 6;
        const bf16* Qp = Q + ((size_t)b * SEQ + qb * 128) * 768 + h * 128; const bf16* Kp = KA + (size_t)b * TKV * 768 + h * 128; const bf16* Vp = VA + (size_t)b * TKV * 768 + h * 128;
        bf16* Yp = Y + ((size_t)b * SEQ + qb * 128) * 1024 + 256 + h * 128;
        if (fixed) att::attn_unit<true>(Qp, Kp, Vp, Yp, a.in[20], lam, mBC, (char*)lds);
        else       att::attn_unit<false>(Qp, Kp, Vp, Yp, a.in[20], lam, mBC, (char*)lds); }
}

__device__ __forceinline__ void spatial_phase(const Args& a, unsigned char* lds, int vcu, int G, bool probe = false) {
    const int tid = ltid(), lane = tid & 63, wave = tid >> 6, r32 = lane & 31, hi = lane >> 5;
    const bf16* VT = (const bf16*)(a.ws + WS_VT); bf16* U = (bf16*)(a.ws + WS_U);
    const float* lng = a.in[22]; const float* lnb = a.in[23]; const float* sgw = a.in[24]; const float* sgb = a.in[25];
    constexpr int TROW = 272;
    unsigned char* T = lds;
    float* red = (float*)lds;
    float* scr = (float*)(lds + 69632) + wave * (32 * 68);
    float* stats = (float*)(lds + 69632 + 69632);
    for (int un = vcu; un < 256; un += G) {
        const int chunk = un >> 1, half = un & 1; const size_t tok0 = (size_t)chunk * 128;
        __syncthreads();
        { const int slot = tid & 15, cg = tid >> 4; float s[8], q[8];
#pragma unroll
            for (int e = 0; e < 8; ++e) { s[e] = 0.f; q[e] = 0.f; }
#pragma unroll 8
            for (int i = 0; i < 64; ++i) { const int c = cg + 32 * i; const v4u w = *(const v4u*)(VT + (size_t)c * MTOK + tok0 + slot * 8);
                float x[8]; x[0] = bflo(w.x); x[1] = bfhi(w.x); x[2] = bflo(w.y); x[3] = bfhi(w.y); x[4] = bflo(w.z); x[5] = bfhi(w.z); x[6] = bflo(w.w); x[7] = bfhi(w.w);
#pragma unroll
                for (int e = 0; e < 8; ++e) { s[e] += x[e]; q[e] += x[e] * x[e]; } }
#pragma unroll
            for (int e = 0; e < 8; ++e) { red[(cg * 128 + slot * 8 + e) * 2] = s[e]; red[(cg * 128 + slot * 8 + e) * 2 + 1] = q[e]; } }
        __syncthreads();
        if (tid < 128) { float s = 0.f, q = 0.f;
            for (int cg = 0; cg < 32; ++cg) { s += red[(cg * 128 + tid) * 2]; q += red[(cg * 128 + tid) * 2 + 1]; }
            const float mean = s * (1.f / 2048.f), var = fmaxf(q * (1.f / 2048.f) - mean * mean, 0.f);
            stats[tid * 2] = mean; stats[tid * 2 + 1] = rsqrtf(var + 1e-6f); }
        __syncthreads();
        for (int gq = 0; gq < 4; ++gq) { const int g = half * 4 + gq;
            if (gq) __syncthreads();
            { const int slot = tid & 15, cr = tid >> 4; float mu[8], rs[8];
#pragma unroll
                for (int e = 0; e < 8; ++e) { mu[e] = stats[(slot * 8 + e) * 2]; rs[e] = stats[(slot * 8 + e) * 2 + 1]; }
#pragma unroll
                for (int i = 0; i < 8; ++i) { const int cl = cr + 32 * i, c = g * 256 + cl; const v4u w = *(const v4u*)(VT + (size_t)c * MTOK + tok0 + slot * 8);
                    const float lg = lng[c], lb = lnb[c];
                    float x[8]; x[0] = bflo(w.x); x[1] = bfhi(w.x); x[2] = bflo(w.y); x[3] = bfhi(w.y); x[4] = bflo(w.z); x[5] = bfhi(w.z); x[6] = bflo(w.w); x[7] = bfhi(w.w);
#pragma unroll
                    for (int e = 0; e < 8; ++e) x[e] = (x[e] - mu[e]) * rs[e] * lg + lb;
                    v4u o; o.x = pk2(x[0], x[1]); o.y = pk2(x[2], x[3]); o.z = pk2(x[4], x[5]); o.w = pk2(x[6], x[7]);
                    *(v4u*)(T + cl * TROW + slot * 16) = o; } }
            __syncthreads();
            const int mb = (wave & 3) * 32, ch = (wave >> 2) * 128;
            bf16x8 af[8];
            { const float* wrow = sgw + ((size_t)g * 128 + mb + r32) * 128 + hi * 8;
#pragma unroll
                for (int ks = 0; ks < 8; ++ks) { const f32x4 w0 = *(const f32x4*)(wrow + ks * 16), w1 = *(const f32x4*)(wrow + ks * 16 + 4);
                    v4u p; p.x = pk2(w0.x, w0.y); p.y = pk2(w0.z, w0.w); p.z = pk2(w1.x, w1.y); p.w = pk2(w1.z, w1.w); af[ks] = __builtin_bit_cast(bf16x8, p); } }
            f32x16 o[4];
#pragma unroll
            for (int d0 = 0; d0 < 4; ++d0) { o[d0] = f32x16{};
#pragma unroll
                for (int ks = 0; ks < 8; ++ks) { const bf16x8 bfr = *(const bf16x8*)(T + (ch + d0 * 32 + r32) * TROW + (16 * ks + 8 * hi) * 2);
                    o[d0] = __builtin_amdgcn_mfma_f32_32x32x16_bf16(af[ks], bfr, o[d0], 0, 0, 0); } }
            float bias[16];
#pragma unroll
            for (int r = 0; r < 16; ++r) bias[r] = sgb[g * 128 + mb + att::crow(r, hi)];
#pragma unroll
            for (int p = 0; p < 2; ++p) {
#pragma unroll
                for (int dd = 0; dd < 2; ++dd)
#pragma unroll
                    for (int r = 0; r < 16; ++r) scr[att::crow(r, hi) * 68 + dd * 32 + r32] = o[2 * p + dd][r] + bias[r];
                LDS_WAIT(); asm volatile("" ::: "memory");
                v4u uw[4];
#pragma unroll
                for (int qq = 0; qq < 4; ++qq) { const int row = (lane >> 3) + 8 * qq, c8 = (lane & 7) * 8; uw[qq] = *(const v4u*)(U + (tok0 + mb + row) * 2048 + g * 256 + ch + p * 64 + c8); }
#pragma unroll
                for (int qq = 0; qq < 4; ++qq) { const int row = (lane >> 3) + 8 * qq, c8 = (lane & 7) * 8;
                    const f32x4 m0 = *(const f32x4*)(scr + row * 68 + c8), m1 = *(const f32x4*)(scr + row * 68 + c8 + 4);
                    bf16* up = U + (tok0 + mb + row) * 2048 + g * 256 + ch + p * 64 + c8; const v4u w = uw[qq];
                    v4u ov; ov.x = pk2(bflo(w.x) * m0.x, bfhi(w.x) * m0.y); ov.y = pk2(bflo(w.y) * m0.z, bfhi(w.y) * m0.w);
                    ov.z = pk2(bflo(w.z) * m1.x, bfhi(w.z) * m1.y); ov.w = pk2(bflo(w.w) * m1.z, bfhi(w.w) * m1.w);
                    bf16* wp = up; if (probe) { const size_t tok = tok0 + mb + row; wp = (tok < 8192 ? (bf16*)(a.ws + 56 * MiB) + tok * 2048 : (bf16*)(a.ws + 220 * MiB) + (tok - 8192) * 2048) + g * 256 + ch + p * 64 + c8; }
                    *(v4u*)wp = ov; }
                LDS_WAIT(); asm volatile("" ::: "memory");
            }
        }
    }
}


#if MK_DEBUG
__device__ __forceinline__ float bfr(float f) { return __builtin_bit_cast(float, f2bf(f) << 16); }
__device__ __forceinline__ float bf2f(bf16 v) { return __builtin_bit_cast(float, (unsigned)v << 16); }
__device__ __forceinline__ void rec(float* res, int st, float got, float want) { float e = fabsf(got - want) / (fabsf(want) + 0.1f); if (!(e == e) || e > 1e30f) e = 0.77f; else e = fminf(e, 0.6f); atomicMax((unsigned*)res + st, __float_as_uint(e)); }
__device__ __forceinline__ unsigned hsh(unsigned s) { s ^= s >> 16; s *= 0x7feb352du; s ^= s >> 15; s *= 0x846ca68bu; s ^= s >> 16; return s; }
__global__ void chk_mod(Args a, float* res) {
    const int i = blockIdx.x * 256 + threadIdx.x; if (i >= 2 * 5 * 6144) return; const int l = i / (5 * 6144), r = (i / 6144) % 5, n = i % 6144;
    float s = 0.f; for (int k = 0; k < 1024; ++k) { const float c = r < 4 ? a.in[1][r * 1024 + k] : a.in[3][k]; s += (c / (1.f + expf(-c))) * a.in[4][((size_t)l * 1024 + k) * 6144 + n]; }
    s += a.in[5][l * 6144 + n]; rec(res, 0, ((const float*)(a.ws + WS_MOD))[i], s);
}
__global__ void chk_wt(const float* W, int K, int N, const bf16* WT, float* res, int st) {
    const unsigned h = hsh(blockIdx.x * 256 + threadIdx.x + 77u * st); const int k = h % K, n = (h >> 12) % N;
    rec(res, st, bf2f(WT[(size_t)n * K + k]), bfr(W[(size_t)k * N + n]));
}
__global__ void chk_norm(const float* src, const float* g, const float* modrow_sh, const float* modrow_sc, int bstride, const bf16* dst, int nrows, int rows_per_b, float* res, int st, int row_base = 0) {
    __shared__ float red[256]; const unsigned h = hsh(blockIdx.x + 1000u * st); const int row = row_base + h % nrows; const int b = rows_per_b ? row / rows_per_b : 0; const int t = threadIdx.x;
    float s = 0.f; for (int k = t; k < 1024; k += 256) { const float v = src[(size_t)row * 1024 + k]; s += v * v; } red[t] = s; __syncthreads();
    for (int o = 128; o > 0; o >>= 1) { if (t < o) red[t] += red[t + o]; __syncthreads(); }
    const float rstd = rsqrtf(red[0] / 1024.f + 1e-6f);
    for (int k = t; k < 1024; k += 256) { const float want = src[(size_t)row * 1024 + k] * rstd * g[k] * (1.f + modrow_sc[(size_t)b * bstride + k]) + modrow_sh[(size_t)b * bstride + k]; rec(res, st, bf2f(dst[(size_t)row * 1024 + k]), want); }
}
__device__ __forceinline__ float dotbf(const bf16* A, const bf16* B, int K) { float s = 0.f; for (int k = 0; k < K; ++k) s += bf2f(A[k]) * bf2f(B[k]); return s; }
__global__ void chk_gemm1(Args a, float* res) {
    const unsigned h = hsh(blockIdx.x * 256 + threadIdx.x); int row = h % 17408; int col = (h >> 15) % 2560;
    if (row >= 16384) { col = 1024 + (h >> 15) % 1536; }
    const bf16* XN = (const bf16*)(a.ws + WS_XN); const bf16* WT = (const bf16*)(a.ws + WS_WIN);
    const float want = dotbf(XN + (size_t)row * 1024, WT + (size_t)col * 1024, 1024); float got;
    if (row < 16384) { const int b = row >> 12, t = row & 4095; const size_t kv = (size_t)b * TKV + 256 + t;
        if (col < 256) got = bf2f(((const bf16*)(a.ws + WS_POOL))[(size_t)row * 256 + col]);
        else if (col < 1024) got = bf2f(((const bf16*)(a.ws + WS_Q))[(size_t)row * 768 + col - 256]);
        else if (col < 1792) got = bf2f(((const bf16*)(a.ws + WS_K))[kv * 768 + col - 1024]);
        else got = bf2f(((const bf16*)(a.ws + WS_V))[kv * 768 + col - 1792]);
    } else { const int rc = row - 16384, b = rc >> 8, j = rc & 255; const size_t kv = (size_t)b * TKV + j;
        if (col < 1792) got = bf2f(((const bf16*)(a.ws + WS_K))[kv * 768 + col - 1024]); else got = bf2f(((const bf16*)(a.ws + WS_V))[kv * 768 + col - 1792]); }
    rec(res, 3, got, want);
}
__global__ void chk_qk(Args a, float* res) {
    __shared__ float raw[64]; __shared__ float red[64]; const unsigned h = hsh(blockIdx.x + 4242u); const int d = threadIdx.x;
    int row = h % 17408; const int hg = (h >> 16) % 12; int isq = (h >> 24) & 1; if (row >= 16384) isq = 0;
    const bf16* XN = (const bf16*)(a.ws + WS_XN); const bf16* WT = (const bf16*)(a.ws + WS_WIN);
    const int col = (isq ? 256 : 1024) + hg * 64 + d;
    raw[d] = bfr(dotbf(XN + (size_t)row * 1024, WT + (size_t)col * 1024, 1024)); red[d] = raw[d] * raw[d]; __syncthreads();
    for (int o = 32; o > 0; o >>= 1) { if (d < o) red[d] += red[d + o]; __syncthreads(); }
    const float rstd = rsqrtf(red[0] / 64.f + 1e-6f); const float* gam = isq ? a.in[14] : a.in[15];
    float y = raw[d] * rstd * gam[d]; __syncthreads(); red[d] = y; __syncthreads();
    float want = y; size_t off;
    if (row < 16384) { const int t = row & 4095, pr = d >> 1; const float pos = (float)(pr < 16 ? (t >> 6) : (t & 63)); const float inv = powf(10000.f, -(float)(pr & 15) / 16.f); const float ang = pos * inv;
        const float cs = cosf(ang), sn = sinf(ang), x0 = red[2 * pr], x1 = red[2 * pr + 1]; want = (d & 1) ? x0 * sn + x1 * cs : x0 * cs - x1 * sn;
        off = isq ? (size_t)row * 768 + hg * 64 + d : ((size_t)(row >> 12) * TKV + 256 + t) * 768 + hg * 64 + d;
    } else { const int rc = row - 16384; off = ((size_t)(rc >> 8) * TKV + (rc & 255)) * 768 + hg * 64 + d; }
    const bf16* buf = isq ? (const bf16*)(a.ws + WS_Q) : (const bf16*)(a.ws + WS_K);
    rec(res, 4, bf2f(buf[off]), want);
}
__global__ void chk_pool(Args a, float* res) {
    const unsigned h = hsh(blockIdx.x * 256 + threadIdx.x + 999u); const int row = h % 16384, gi = (h >> 14) & 3, d = (h >> 16) & 63; const int b = row >> 12, t = row & 4095, hw = 1 << gi;
    const bf16* PI = (const bf16*)(a.ws + WS_POOL); const int lo = max(t - hw, 0), hi = min(t + hw, 4096); float acc = 0.f;
    for (int c = 0; c < 64; ++c) { float s = 0.f; for (int j = lo; j < hi; ++j) s += bf2f(PI[((size_t)b * 4096 + j) * 256 + gi * 64 + c]);
        const float pooled = s / (float)(hi - lo) - bf2f(PI[(size_t)row * 256 + gi * 64 + c]); acc += pooled * a.in[12][gi * 4096 + c * 64 + d]; }
    rec(res, 5, bf2f(((const bf16*)(a.ws + WS_Y))[(size_t)row * 1024 + gi * 64 + d]), acc * a.in[13][gi * 64 + d]);
}
__global__ void chk_attn(Args a, float* res) {
    __shared__ float s1[TKV], s2[TKV]; __shared__ float red[256]; __shared__ float ov[128];
    const unsigned hh = hsh(blockIdx.x + 31337u); const int row = hh % 16384, h = (hh >> 14) % 6, b = row >> 12, t = threadIdx.x;
    const bf16* Q = (const bf16*)(a.ws + WS_Q) + (size_t)row * 768 + h * 128; const bf16* KA = (const bf16*)(a.ws + WS_K) + (size_t)b * TKV * 768 + h * 128; const bf16* VA = (const bf16*)(a.ws + WS_V) + (size_t)b * TKV * 768 + h * 128;
    float l1 = 0.f, l2 = 0.f; for (int i = 0; i < 64; ++i) { l1 += a.in[16][i] * a.in[17][i]; l2 += a.in[18][i] * a.in[19][i]; } const float lam = expf(l1) - expf(l2) + 0.2f;
    for (int k = t; k < TKV; k += 256) { float x1 = 0.f, x2 = 0.f; for (int d = 0; d < 64; ++d) { x1 += bf2f(Q[d]) * bf2f(KA[(size_t)k * 768 + d]); x2 += bf2f(Q[64 + d]) * bf2f(KA[(size_t)k * 768 + 64 + d]); } s1[k] = x1 * 0.125f; s2[k] = x2 * 0.125f; }
    __syncthreads();
    float m1 = -1e30f, m2 = -1e30f; for (int k = t; k < TKV; k += 256) { m1 = fmaxf(m1, s1[k]); m2 = fmaxf(m2, s2[k]); }
    red[t] = m1; __syncthreads(); for (int o = 128; o > 0; o >>= 1) { if (t < o) red[t] = fmaxf(red[t], red[t + o]); __syncthreads(); } m1 = red[0]; __syncthreads();
    red[t] = m2; __syncthreads(); for (int o = 128; o > 0; o >>= 1) { if (t < o) red[t] = fmaxf(red[t], red[t + o]); __syncthreads(); } m2 = red[0]; __syncthreads();
    float z1 = 0.f, z2 = 0.f; for (int k = t; k < TKV; k += 256) { s1[k] = expf(s1[k] - m1); s2[k] = expf(s2[k] - m2); z1 += s1[k]; z2 += s2[k]; }
    red[t] = z1; __syncthreads(); for (int o = 128; o > 0; o >>= 1) { if (t < o) red[t] += red[t + o]; __syncthreads(); } z1 = red[0]; __syncthreads();
    red[t] = z2; __syncthreads(); for (int o = 128; o > 0; o >>= 1) { if (t < o) red[t] += red[t + o]; __syncthreads(); } z2 = red[0]; __syncthreads();
    if (t < 128) { float o = 0.f; for (int k = 0; k < TKV; ++k) o += (s1[k] / z1 - lam * s2[k] / z2) * bf2f(VA[(size_t)k * 768 + t]); ov[t] = o; red[t] = o * o; } else red[t] = 0.f;
    __syncthreads(); for (int o = 128; o > 0; o >>= 1) { if (t < o) red[t] += red[t + o]; __syncthreads(); }
    if (t < 128) { const float want = ov[t] * rsqrtf(red[0] / 128.f + 1e-6f) * a.in[20][t] * 0.8f; rec(res, 6, bf2f(((const bf16*)(a.ws + WS_Y))[(size_t)row * 1024 + 256 + h * 128 + t]), want); }
}
__global__ void chk_res(const bf16* A, const bf16* WT, int K, const float* basebuf, const float* gate, const float* out, float* res, int st, int nrows) {
    const unsigned h = hsh(blockIdx.x * 256 + threadIdx.x + 555u * st); const int row = h % nrows, col = (h >> 13) % 1024;
    const float want = basebuf[(size_t)row * 1024 + col] + gate[(size_t)(row >> 12) * 6144 + col] * dotbf(A + (size_t)row * K, WT + (size_t)col * K, K);
    rec(res, st, out[(size_t)row * 1024 + col], want);
}
__global__ void chk_act(const bf16* A, const bf16* WT, int K, int N, const bf16* O, int ldo, int act, int transposed, float* res, int st) {
    const unsigned h = hsh(blockIdx.x * 256 + threadIdx.x + 333u * st); const int row = h % 16384, col = (h >> 14) % N;
    float v = dotbf(A + (size_t)row * K, WT + (size_t)col * K, K); if (act == 2) { v = fmaxf(v, 0.f); v *= v; } else if (act == 1) v = 0.5f * v * (1.f + erff(v * 0.70710678f));
    rec(res, st, bf2f(transposed ? O[(size_t)col * ldo + row] : O[(size_t)row * ldo + col]), v);
}
__global__ void chk_copy(const float* src, float* dst, size_t n4) { for (size_t i = blockIdx.x * 256ull + threadIdx.x; i < n4; i += gridDim.x * 256ull) ((f32x4*)dst)[i] = ((const f32x4*)src)[i]; }
__global__ void chk_final(float* res, float* out, int nst) {
    for (int i = 0; i < nst; ++i) { const float e = res[i]; if (e > 0.08f) { float m = fminf(fmaxf(e * 10.f, 1.0f), 9.9f); float v = m; for (int j = 0; j < 4 + i; ++j) v *= 10.f; out[0] = v; return; } }
}
__global__ void simple_norm(const float* src, const float* g, const float* sh, const float* sc, int bstride, bf16* dst) {
    __shared__ float red[256]; const int row = blockIdx.x, b = row >> 12, t = threadIdx.x;
    float s = 0.f; for (int k = t; k < 1024; k += 256) { const float v = src[(size_t)row * 1024 + k]; s += v * v; } red[t] = s; __syncthreads();
    for (int o = 128; o > 0; o >>= 1) { if (t < o) red[t] += red[t + o]; __syncthreads(); }
    const float rstd = rsqrtf(red[0] / 1024.f + 1e-6f);
    for (int k = t; k < 1024; k += 256) dst[(size_t)row * 1024 + k] = (bf16)f2bf(src[(size_t)row * 1024 + k] * rstd * g[k] * (1.f + sc[(size_t)b * bstride + k]) + sh[(size_t)b * bstride + k]);
}
__global__ void chk_final2(float* res, float* out) { int mask = 0; for (int i = 0; i < 8; ++i) if (res[20 + i] < 0.08f) mask |= 1 << i; out[0] = (float)(mask + 1) * 1e6f; }
#endif

#define XB_TMO      128
#define XB_XCNT(j)  (256  + 64 * (j))
#define XB_XSUB(j)  (1280 + 64 * (j))
#define XB_XGEN(j)  (2304 + 64 * (j))
#define XB_TOP      3328
#define XB_TOPGEN   3392
#define XCD_BAR_WORDS 3456
#define XB_SPIN_CAP (1u << 18)

__device__ __forceinline__ unsigned xb_ld(unsigned* p)              { return __hip_atomic_load(p, __ATOMIC_RELAXED, __HIP_MEMORY_SCOPE_AGENT); }
__device__ __forceinline__ unsigned xb_add(unsigned* p, unsigned v) { return __hip_atomic_fetch_add(p, v, __ATOMIC_RELAXED, __HIP_MEMORY_SCOPE_AGENT); }
__device__ __forceinline__ unsigned xb_xcc_id() { return (unsigned)__builtin_amdgcn_s_getreg((3 << 11) | 20) & 0xFu; }
#define XB_SPIN(cond, bar) do { unsigned _sp = 0; while (cond) { __builtin_amdgcn_s_sleep(1); \
    if ((++_sp & 255u) == 0u) { if (xb_ld(&(bar)[XB_TMO])) break; if (_sp > XB_SPIN_CAP) { atomicAdd(&(bar)[XB_TMO], 1u); break; } } } } while (0)

struct XcdBarrier {
    unsigned* bar; unsigned x;
    volatile LAS unsigned* st;
};

__device__ __forceinline__ XcdBarrier xcd_barrier_post(unsigned* bar, volatile LAS unsigned* st) {
    XcdBarrier b; b.bar = bar; b.x = xb_xcc_id(); b.st = st;
    if (threadIdx.x == 0) (void)xb_add(&bar[XB_XCNT(b.x)], 1u);
    return b;
}
__device__ __forceinline__ void xcd_barrier_complete(unsigned* bar, unsigned x, unsigned& nloc, unsigned& nx) {
    const unsigned G = gridDim.x * gridDim.y * gridDim.z;
    unsigned sum, cnt, mine, sp = 0u;
    for (;;) {
        sum = 0u; cnt = 0u; mine = 0u;
#pragma unroll
        for (unsigned j = 0; j < 16; ++j) { const unsigned c = xb_ld(&bar[XB_XCNT(j)]); sum += c; cnt += (c > 0u) ? 1u : 0u; mine = (j == x) ? c : mine; }
        if (sum == G) break;
        __builtin_amdgcn_s_sleep(1);
        if ((++sp & 255u) == 0u) { if (xb_ld(&bar[XB_TMO])) break; if (sp > XB_SPIN_CAP) { atomicAdd(&bar[XB_TMO], 1u); break; } }
    }
    nloc = mine > 0u ? mine : 1u; nx = cnt > 0u ? cnt : 1u;
}

__device__ __forceinline__ void xcd_barrier(const XcdBarrier& b) {
    asm volatile("s_waitcnt vmcnt(0)" ::: "memory");
    __syncthreads();
    if (threadIdx.x == 0) {
        unsigned* bar = b.bar;
        __builtin_amdgcn_s_waitcnt(0);
        unsigned nloc = b.st[0], nx = b.st[1];
        if (nloc == 0u) { xcd_barrier_complete(bar, b.x, nloc, nx); b.st[0] = nloc; b.st[1] = nx; }
        const unsigned old = xb_add(&bar[XB_XSUB(b.x)], 1u);
        const unsigned gen = old / nloc;
        if (old + 1u == (gen + 1u) * nloc) {
            __builtin_amdgcn_fence(__ATOMIC_RELEASE, "agent");
            asm volatile("s_waitcnt vmcnt(0)" ::: "memory");
            const unsigned og = xb_add(&bar[XB_TOP], 1u);
            const unsigned tg = og / nx;
            if (og + 1u == (tg + 1u) * nx) xb_add(&bar[XB_TOPGEN], 1u);
            else XB_SPIN(xb_ld(&bar[XB_TOPGEN]) == tg, bar);
            __builtin_amdgcn_fence(__ATOMIC_ACQUIRE, "agent");
            xb_add(&bar[XB_XGEN(b.x)], 1u);
            asm volatile("s_waitcnt vmcnt(0)" ::: "memory");
        } else {
            XB_SPIN(xb_ld(&bar[XB_XGEN(b.x)]) == gen, bar);
            __builtin_amdgcn_fence(__ATOMIC_ACQUIRE, "agent");
            asm volatile("s_waitcnt vmcnt(0)" ::: "memory");
        }
    }
    __syncthreads();
}

template <int PH> __device__ __forceinline__ void run_phase(const Args& a, unsigned char* lds, int vcu, int G, int bx) {
    unsigned char* ws = a.ws;
    float* mod = (float*)(ws + WS_MOD);
    bf16* XN = (bf16*)(ws + WS_XN);
    if constexpr (PH == 0) p0_prep(a, lds, vcu, G);
    else if constexpr (PH == 1)  norm_phase(a.in[0], a.in[6],        mod,            0,    1024, XN, a.in[2], vcu, G);
    else if constexpr (PH == 6)  norm_phase(a.out,   a.in[7],        mod,            3072, 4096, XN, nullptr, vcu, G);
    else if constexpr (PH == 9)  norm_phase(a.out,   a.in[6] + 1024, mod + 5 * MODW, 0,    1024, XN, nullptr, vcu, G);
    else if constexpr (PH == 13) norm_phase(a.out,   a.in[7] + 1024, mod + 5 * MODW, 3072, 4096, XN, nullptr, vcu, G);
    else if constexpr (PH == 2) {
        pg8::Gemm g{XN, (const bf16*)(ws + WS_WIN), 17408, 2560, 1024}; pg8::OrderQKV S; S.init(G, bx);
        pg8::EpiRoute E{(bf16*)(ws + WS_POOL), (bf16*)(ws + WS_Q), (bf16*)(ws + WS_K), (bf16*)(ws + WS_V), a.in[14], a.in[15], (const float*)(ws + WS_ROPE)};
        pg8::gemm_phase<pg8::EpiRoute, pg8::OrderQKV, true, true>((LAS unsigned char*)lds, g, S, E);
    }
    else if constexpr (PH == 3) {}
    else if constexpr (PH == 4) { pool_phase(a, lds, vcu, G); attn_phase(a, lds, vcu, G);
#ifdef PROBE_ATT2
        attn_phase(a, lds, vcu, G);
#endif
    }
    else if constexpr (PH == 5 || PH == 8 || PH == 12 || PH == 15) {
        pg8::Gemm g; const float* base; const float* gate;
        if constexpr (PH == 5)       { g = pg8::Gemm{(const bf16*)(ws + WS_Y),  (const bf16*)(ws + WS_WOUT),  MTOK, 1024, 1024}; base = a.in[0]; gate = mod + 2048; }
        else if constexpr (PH == 8)  { g = pg8::Gemm{(const bf16*)(ws + WS_HB), (const bf16*)(ws + WS_W2),    MTOK, 1024, 4096}; base = a.out;   gate = mod + 5120; }
        else if constexpr (PH == 12) { g = pg8::Gemm{(const bf16*)(ws + WS_U),  (const bf16*)(ws + WS_ODOUT), MTOK, 1024, 2048}; base = a.out;   gate = mod + 5 * MODW + 2048; }
        else                         { g = pg8::Gemm{(const bf16*)(ws + WS_HB), (const bf16*)(ws + WS_W2) + (size_t)1024 * 4096, MTOK, 1024, 4096}; base = a.out; gate = mod + 5 * MODW + 5120; }
        pg8::StaticOrder S; S.init(g.M, g.N, G, bx);
        pg8::EpiRes E{base, a.out, gate};
        pg8::gemm_phase<pg8::EpiRes, pg8::StaticOrder, true, true>((LAS unsigned char*)lds, g, S, E);
    }
    else if constexpr (PH == 7 || PH == 14) {
        pg8::Gemm g{XN, (const bf16*)(ws + WS_W1) + (PH == 14 ? (size_t)4096 * 1024 : 0), MTOK, FF, 1024}; pg8::EpiAct E{(bf16*)(ws + WS_HB), FF, 2};
        pg8::StaticOrder S; S.init(g.M, g.N, G, bx);
        pg8::gemm_phase<pg8::EpiAct, pg8::StaticOrder, true, true>((LAS unsigned char*)lds, g, S, E);
    }
    else if constexpr (PH == 10) {
        { pg8::Gemm g{XN, (const bf16*)(ws + WS_ODIN), MTOK, 2048, 1024}; pg8::EpiAct E{(bf16*)(ws + WS_U), 2048, 1};
          pg8::StaticOrder S; S.init(g.M, g.N, G, bx);
          pg8::gemm_phase<pg8::EpiAct, pg8::StaticOrder, true, true>((LAS unsigned char*)lds, g, S, E); }
        { pg8::Gemm g{(const bf16*)(ws + WS_ODIN) + (size_t)2048 * 1024, XN, 2048, MTOK, 1024}; pg8::EpiAct E{(bf16*)(ws + WS_VT), MTOK, 1};
          pg8::StaticOrder S; S.init(g.M, g.N, G, bx);
          pg8::gemm_phase<pg8::EpiAct, pg8::StaticOrder, true, true>((LAS unsigned char*)lds, g, S, E); }
    }
    else if constexpr (PH == 11) { spatial_phase(a, lds, vcu, G);
#ifdef PROBE_SP2
        spatial_phase(a, lds, vcu, G, true);
#endif
    }
}
constexpr int XBAR_LDS_OFF = LDS_BYTES - 64;
__global__ void __launch_bounds__(NTHR) fwd_megakernel(Args a) {
    extern __shared__ __attribute__((aligned(16))) unsigned char lds[];
    const int G = gridDim.x, bx = blockIdx.x;
    const int vcu = (G % 8 == 0) ? (bx % 8) * (G / 8) + bx / 8 : bx;
    volatile LAS unsigned* xst = (volatile LAS unsigned*)((LAS unsigned char*)lds + XBAR_LDS_OFF);
    if (threadIdx.x < 2) xst[threadIdx.x] = 0u;
    __syncthreads();
    XcdBarrier bar; bar.bar = (unsigned*)a.ws; bar.x = 0; bar.st = xst;
    const bool fused = (a.ph_hi - a.ph_lo) > 1;
    if (fused) bar = xcd_barrier_post((unsigned*)a.ws, xst);
    if (a.ph_hi > NPH) cg::this_grid().sync();
#define PHASE(k) if ((k) != 3 && a.ph_lo <= (k) && (k) < a.ph_hi) { run_phase<k>(a, lds, vcu, G, bx); if ((k) + 1 < a.ph_hi) { xcd_barrier(bar); PROBE_XB } }
    PHASE(0) PHASE(1) PHASE(2) PHASE(3) PHASE(4) PHASE(5) PHASE(6) PHASE(7) PHASE(8) PHASE(9) PHASE(10) PHASE(11) PHASE(12) PHASE(13) PHASE(14) PHASE(15)
#undef PHASE
}

extern "C" void kernel_launch(void* const* d_in, const int* in_sizes, int n_in, void* d_out, int out_size, void* d_ws, size_t ws_size, hipStream_t stream) {
    static int grid = 0;
    if (grid == 0) {
        if (n_in != 27 || in_sizes[0] != MTOK * DM || out_size != MTOK * DM || ws_size < WS_END) { fprintf(stderr, "kernel_launch: unexpected shapes (n_in %d, in0 %d, out %d, ws %zu)\n", n_in, n_in > 0 ? in_sizes[0] : -1, out_size, ws_size); grid = -1; return; }
        if (hipFuncSetAttribute((const void*)fwd_megakernel, hipFuncAttributeMaxDynamicSharedMemorySize, LDS_BYTES) != hipSuccess) { fprintf(stderr, "kernel_launch: hipFuncSetAttribute failed\n"); grid = -1; return; }
        int dev = 0, cus = 0, per_cu = 0;
        (void)hipGetDevice(&dev); (void)hipDeviceGetAttribute(&cus, hipDeviceAttributeMultiprocessorCount, dev);
        (void)hipOccupancyMaxActiveBlocksPerMultiprocessor(&per_cu, (const void*)fwd_megakernel, NTHR, LDS_BYTES);
        if (per_cu < 1 || cus < 256) fprintf(stderr, "kernel_launch: note: occupancy query %d blocks/CU, %d CUs\n", per_cu, cus);
        (void)hipGetLastError();
        grid = 256;
    }
    if (grid < 0) return;
    Args a{};
    for (int i = 0; i < 27; ++i) a.in[i] = (const float*)d_in[i];
    a.out = (float*)d_out; a.ws = (unsigned char*)d_ws;
#if MK_MULTI
#if MK_DEBUG
    float* res = (float*)d_ws; (void)hipMemsetAsync(res, 0, 256, stream);
    unsigned char* ws = (unsigned char*)d_ws; float* mod = (float*)(ws + WS_MOD); float* snap = (float*)(ws + 220 * MiB);
#endif
    for (int ph = 0; ph < NPH_RUN; ++ph) { a.ph_lo = ph; a.ph_hi = ph + 1;
#if MK_DEBUG
        if (ph == 8 || ph == 12 || ph == 15) hipLaunchKernelGGL(chk_copy, dim3(2048), dim3(256), 0, stream, (const float*)d_out, snap, (size_t)8192 * 1024 / 4);
#endif
#if MK_DEBUG
        if (ph == 6 && MK_SIMPLE6) hipLaunchKernelGGL(simple_norm, dim3(16384), dim3(256), 0, stream, (const float*)d_out, a.in[7], (const float*)(mod + 3072), (const float*)(mod + 4096), 6144, (bf16*)(ws + WS_XN)); else
#endif
        hipLaunchKernelGGL(fwd_megakernel, dim3(grid), dim3(NTHR), LDS_BYTES, stream, a);
#if MK_DEBUG
        if (ph == 0) { hipLaunchKernelGGL(chk_mod, dim3(240), dim3(256), 0, stream, a, res);
            hipLaunchKernelGGL(chk_wt, dim3(16), dim3(256), 0, stream, a.in[10], 1024, 2560, (const bf16*)(ws + WS_WIN), res, 1);
            hipLaunchKernelGGL(chk_wt, dim3(16), dim3(256), 0, stream, a.in[11], 1024, 1024, (const bf16*)(ws + WS_WOUT), res, 1);
            hipLaunchKernelGGL(chk_wt, dim3(16), dim3(256), 0, stream, a.in[8], 1024, 4096, (const bf16*)(ws + WS_W1), res, 1);
            hipLaunchKernelGGL(chk_wt, dim3(16), dim3(256), 0, stream, a.in[8] + 1024 * 4096, 1024, 4096, (const bf16*)(ws + WS_W1) + 4096 * 1024, res, 1);
            hipLaunchKernelGGL(chk_wt, dim3(16), dim3(256), 0, stream, a.in[9], 4096, 1024, (const bf16*)(ws + WS_W2), res, 1);
            hipLaunchKernelGGL(chk_wt, dim3(16), dim3(256), 0, stream, a.in[9] + 1024 * 4096, 4096, 1024, (const bf16*)(ws + WS_W2) + 4096 * 1024, res, 1);
            hipLaunchKernelGGL(chk_wt, dim3(16), dim3(256), 0, stream, a.in[21], 1024, 4096, (const bf16*)(ws + WS_ODIN), res, 1);
            hipLaunchKernelGGL(chk_wt, dim3(16), dim3(256), 0, stream, a.in[26], 2048, 1024, (const bf16*)(ws + WS_ODOUT), res, 1); }
        if (ph == 1) { hipLaunchKernelGGL(chk_norm, dim3(128), dim3(256), 0, stream, a.in[0], a.in[6], (const float*)mod, (const float*)(mod + 1024), 6144, (const bf16*)(ws + WS_XN), 16384, 4096, res, 2);
            hipLaunchKernelGGL(chk_norm, dim3(64), dim3(256), 0, stream, a.in[2], a.in[6], (const float*)(mod + 4 * 6144), (const float*)(mod + 4 * 6144 + 1024), 0, (const bf16*)(ws + WS_XN) + (size_t)16384 * 1024, 1024, 0, res, 2); }
        if (ph == 2) hipLaunchKernelGGL(chk_gemm1, dim3(32), dim3(256), 0, stream, a, res);
        if (ph == 3) { hipLaunchKernelGGL(chk_qk, dim3(512), dim3(64), 0, stream, a, res); hipLaunchKernelGGL(chk_pool, dim3(16), dim3(256), 0, stream, a, res); }
        if (ph == 4) hipLaunchKernelGGL(chk_attn, dim3(96), dim3(256), 0, stream, a, res);
        if (ph == 5) hipLaunchKernelGGL(chk_res, dim3(16), dim3(256), 0, stream, (const bf16*)(ws + WS_Y), (const bf16*)(ws + WS_WOUT), 1024, a.in[0], (const float*)(mod + 2048), (const float*)d_out, res, 7, 16384);
        if (ph == 6) hipLaunchKernelGGL(chk_norm, dim3(128), dim3(256), 0, stream, (const float*)d_out, a.in[7], (const float*)(mod + 3072), (const float*)(mod + 4096), 6144, (const bf16*)(ws + WS_XN), 16384, 4096, res, 8);
        if (ph == 7) hipLaunchKernelGGL(chk_act, dim3(16), dim3(256), 0, stream, (const bf16*)(ws + WS_XN), (const bf16*)(ws + WS_W1), 1024, 4096, (const bf16*)(ws + WS_HB), 4096, 2, 0, res, 9);
        if (ph == 8) hipLaunchKernelGGL(chk_res, dim3(16), dim3(256), 0, stream, (const bf16*)(ws + WS_HB), (const bf16*)(ws + WS_W2), 4096, (const float*)snap, (const float*)(mod + 5120), (const float*)d_out, res, 10, 8192);
        if (ph == 9) hipLaunchKernelGGL(chk_norm, dim3(128), dim3(256), 0, stream, (const float*)d_out, a.in[6] + 1024, (const float*)(mod + 5 * 6144), (const float*)(mod + 5 * 6144 + 1024), 6144, (const bf16*)(ws + WS_XN), 16384, 4096, res, 11);
        if (ph == 10) { hipLaunchKernelGGL(chk_act, dim3(16), dim3(256), 0, stream, (const bf16*)(ws + WS_XN), (const bf16*)(ws + WS_ODIN), 1024, 2048, (const bf16*)(ws + WS_U), 2048, 1, 0, res, 12);
            hipLaunchKernelGGL(chk_act, dim3(16), dim3(256), 0, stream, (const bf16*)(ws + WS_XN), (const bf16*)(ws + WS_ODIN) + (size_t)2048 * 1024, 1024, 2048, (const bf16*)(ws + WS_VT), 16384, 1, 1, res, 13); }
#endif
    }
#if MK_DEBUG
    if (NPH_RUN == 16) hipLaunchKernelGGL(chk_final, dim3(1), dim3(1), 0, stream, res, (float*)d_out, 14);
#endif
#else
    a.ph_lo = 0; a.ph_hi = NPH;
    if (hipMemsetAsync(d_ws, 0, 16384, stream) != hipSuccess) { fprintf(stderr, "kernel_launch: memset of the barrier words failed\n"); return; }
    void* args[] = {&a};
    hipError_t e = hipLaunchCooperativeKernel((const void*)fwd_megakernel, dim3(grid), dim3(NTHR), args, LDS_BYTES, stream);
    if (e != hipSuccess) fprintf(stderr, "kernel_launch: cooperative launch failed: %s\n", hipGetErrorString(e));
#endif
}
```

```cpp
#include <hip/hip_runtime.h>
#include <hip/hip_cooperative_groups.h>
#include <cstdio>
#include <cstdint>
namespace cg = cooperative_groups;
__device__ __forceinline__ int ltid() { int t = threadIdx.x; asm volatile("" : "+v"(t)); return t; }
namespace pg8 {
#define PG8_LAS __attribute__((address_space(3)))
typedef unsigned short bf16_t;
typedef short bf16x8 __attribute__((ext_vector_type(8)));
typedef float f32x4 __attribute__((ext_vector_type(4)));
typedef unsigned u32x4 __attribute__((ext_vector_type(4)));
constexpr int BM = 256, BK = 64, HALF = 128, HTB = HALF * BK * 2  , STAGE_BYTES = 8 * HTB, NXCD = 8, WGM = 8;

__host__ __device__ __forceinline__ int lds_byte(int r, int c) { const int st = (r >> 4) * 2 + (c >> 5), rr = r & 15, cc = c & 31, ob = rr * 64 + cc * 2; return st * 1024 + (ob ^ (((ob >> 9) & 1) << 5)); }
__host__ __device__ __forceinline__ void stage_rc(int b, int& R, int& C) { const int st = b / 1024, sb = b % 1024, swz = sb ^ (((sb >> 9) & 1) << 5); R = (st >> 1) * 16 + swz / 64; C = (st & 1) * 32 + (swz % 64) / 2; }
__host__ __device__ __forceinline__ int perm32(int rho) { const int n = rho >> 4, i = rho & 15; return 8 * (i >> 2) + 4 * n + (i & 3); }

struct Unit { int pm, pn; };
struct Gemm { const bf16_t* A; const bf16_t* Bt; int M, N, K; };

struct StaticOrder {
    int nM, nN, nwg, G, c;
    __host__ __device__ void init(int M, int N, int G_, int c_) { nM = M / BM; nN = N / BM; nwg = nM * nN; G = G_; c = c_; }
    __host__ __device__ bool next(int i, Unit& u) const {
        const long L = (long)i * G + c; if (L >= nwg) return false;
        int wgid = (int)L; { const int q = nwg / NXCD, r = nwg % NXCD, xcd = wgid % NXCD, off = wgid / NXCD; wgid = (xcd < r ? xcd * (q + 1) : r * (q + 1) + (xcd - r) * q) + off; }
        const int nig = WGM * nN, gid = wgid / nig, fm = gid * WGM, gsz = (nM - fm) < WGM ? (nM - fm) : WGM;
        u.pm = fm + ((wgid % nig) % gsz); u.pn = (wgid % nig) / gsz; return true;
    }
    __device__ __forceinline__ void a_ready(const Unit&) const {}
    __device__ __forceinline__ void done(const Unit&) const {}
};

__device__ __forceinline__ unsigned cvt_pk_bf16(float lo, float hi) { unsigned r; asm volatile("v_cvt_pk_bf16_f32 %0, %1, %2" : "=v"(r) : "v"(lo), "v"(hi)); return r; }
typedef float f32x2 __attribute__((ext_vector_type(2)));
__device__ __forceinline__ f32x2 gelu_pk(f32x2 v) {
    const f32x2 av = __builtin_elementwise_abs(v), d = av * 0.2316418882f + 1.0f;
    f32x2 t; t.x = __builtin_amdgcn_rcpf(d.x); t.y = __builtin_amdgcn_rcpf(d.y);
    f32x2 q = t * 0.5307027145f + (-0.7265760135f); q = q * t + 0.7107068705f; q = q * t + (-0.142248368f); q = q * t + 0.127414796f; q = q * t;
    const f32x2 s = (v * v) * (-0.72134752044f);
    f32x2 e; e.x = __builtin_amdgcn_exp2f(s.x); e.y = __builtin_amdgcn_exp2f(s.y);
    const f32x2 m = v * (q * e), r = v - m;
    f32x2 o; o.x = v.x < 0.f ? m.x : r.x; o.y = v.y < 0.f ? m.y : r.y; return o;
}


struct EpiAct {
    static constexpr bool PERM = true, AFTER_DRAIN = false;
    bf16_t* O; int ldc; int act;
    __device__ __forceinline__ void operator()(const f32x4 (&acc)[2][2][4][2], const Unit& u, int wr, int wc, int fr, int fq) const {
        const int row0 = u.pm * BM + wr * 64 + fr; const int col0 = u.pn * BM + wc * 32 + 8 * fq;
#pragma unroll
        for (int ai = 0; ai < 2; ++ai)
#pragma unroll
            for (int m = 0; m < 4; ++m) { bf16_t* rowp = O + (size_t)(row0 + ai * HALF + m * 16) * ldc + col0;
#pragma unroll
                for (int bj = 0; bj < 2; ++bj) { f32x4 v0 = acc[ai][bj][m][0], v1 = acc[ai][bj][m][1];
                    if (act == 1) { f32x2 a = gelu_pk((f32x2){v0[0], v0[1]}), b = gelu_pk((f32x2){v0[2], v0[3]}), c = gelu_pk((f32x2){v1[0], v1[1]}), d = gelu_pk((f32x2){v1[2], v1[3]});
                        v0 = (f32x4){a.x, a.y, b.x, b.y}; v1 = (f32x4){c.x, c.y, d.x, d.y}; }
                    else if (act == 2) {
#pragma unroll
                        for (int e = 0; e < 4; ++e) { const float a = fmaxf(v0[e], 0.f), b = fmaxf(v1[e], 0.f); v0[e] = a * a; v1[e] = b * b; } }
                    u32x4 w; w.x = cvt_pk_bf16(v0[0], v0[1]); w.y = cvt_pk_bf16(v0[2], v0[3]); w.z = cvt_pk_bf16(v1[0], v1[1]); w.w = cvt_pk_bf16(v1[2], v1[3]);
                    *(u32x4*)(rowp + bj * HALF) = w; } }
    }
};
struct EpiRoute {
    static constexpr bool PERM = true, AFTER_DRAIN = false;
    bf16_t *pool, *q, *k, *v;
    const float *qg, *kg; const float* rope;
    __device__ __forceinline__ void operator()(const f32x4 (&acc)[2][2][4][2], const Unit& u, int wr, int wc, int fr, int fq) const {
        const int pm = u.pm, pn = u.pn; bf16_t* base; int ld, colt; long rowbase;
        if (pm < 64) { const int b = pm >> 4; const long lat = (long)pm * 256, kvrow = (long)b * 4352 + 256 + (pm & 15) * 256;
            if (pn == 0)     { base = pool; ld = 256; colt = 0;              rowbase = lat; }
            else if (pn < 4) { base = q;    ld = 768; colt = (pn - 1) * 256; rowbase = lat; }
            else if (pn < 7) { base = k;    ld = 768; colt = (pn - 4) * 256; rowbase = kvrow; }
            else             { base = v;    ld = 768; colt = (pn - 7) * 256; rowbase = kvrow; }
        } else { const int b = pm - 64; rowbase = (long)b * 4352; ld = 768;
            if (pn < 7) { base = k; colt = (pn - 4) * 256; } else { base = v; colt = (pn - 7) * 256; } }
        const long row0 = rowbase + wr * 64 + fr;
        if (pn >= 1 && pn <= 6) {
            const float* gam = pn < 4 ? qg : kg; const bool rope_on = pm < 64; const int col0 = colt + 64 * wc + 8 * fq;
            f32x4 gm[2][2];
#pragma unroll
            for (int bj = 0; bj < 2; ++bj)
#pragma unroll
                for (int n = 0; n < 2; ++n) gm[bj][n] = *(const f32x4*)(gam + 32 * bj + 8 * fq + 4 * n);
#pragma unroll
            for (int ai = 0; ai < 2; ++ai)
#pragma unroll
                for (int m = 0; m < 4; ++m) { const int rl = wr * 64 + ai * HALF + m * 16 + fr; const int t = (pm & 15) * 256 + rl;
                    float ss = 0.f;
#pragma unroll
                    for (int bj = 0; bj < 2; ++bj)
#pragma unroll
                        for (int n = 0; n < 2; ++n) { const f32x4 x = acc[ai][bj][m][n]; ss += (x[0] * x[0] + x[1] * x[1]) + (x[2] * x[2] + x[3] * x[3]); }
                    ss += __shfl_xor(ss, 16); ss += __shfl_xor(ss, 32);
                    const float rstd = __builtin_amdgcn_rsqf(ss * (1.f / 64.f) + 1e-6f);
                    bf16_t* rowp = base + (size_t)(row0 + ai * HALF + m * 16) * ld + col0;
#pragma unroll
                    for (int bj = 0; bj < 2; ++bj) { f32x4 y0 = acc[ai][bj][m][0] * rstd * gm[bj][0], y1 = acc[ai][bj][m][1] * rstd * gm[bj][1];
                        if (rope_on) { const int pos = bj == 0 ? (t >> 6) : (t & 63); const float* tp = rope + (pos * 16 + 4 * fq) * 2;
                            const f32x4 c01 = *(const f32x4*)tp, c23 = *(const f32x4*)(tp + 4);
                            y0 = (f32x4){y0[0] * c01[0] - y0[1] * c01[1], y0[0] * c01[1] + y0[1] * c01[0], y0[2] * c01[2] - y0[3] * c01[3], y0[2] * c01[3] + y0[3] * c01[2]};
                            y1 = (f32x4){y1[0] * c23[0] - y1[1] * c23[1], y1[0] * c23[1] + y1[1] * c23[0], y1[2] * c23[2] - y1[3] * c23[3], y1[2] * c23[3] + y1[3] * c23[2]}; }
                        u32x4 w; w.x = cvt_pk_bf16(y0[0], y0[1]); w.y = cvt_pk_bf16(y0[2], y0[3]); w.z = cvt_pk_bf16(y1[0], y1[1]); w.w = cvt_pk_bf16(y1[2], y1[3]);
                        *(u32x4*)(rowp + 32 * bj) = w; } }
            return;
        }
        const int col0 = colt + wc * 32 + 8 * fq;
#pragma unroll
        for (int ai = 0; ai < 2; ++ai)
#pragma unroll
            for (int m = 0; m < 4; ++m) { bf16_t* rowp = base + (size_t)(row0 + ai * HALF + m * 16) * ld + col0;
#pragma unroll
                for (int bj = 0; bj < 2; ++bj) { const f32x4 v0 = acc[ai][bj][m][0], v1 = acc[ai][bj][m][1];
                    u32x4 w; w.x = cvt_pk_bf16(v0[0], v0[1]); w.y = cvt_pk_bf16(v0[2], v0[3]); w.z = cvt_pk_bf16(v1[0], v1[1]); w.w = cvt_pk_bf16(v1[2], v1[3]);
                    *(u32x4*)(rowp + bj * HALF) = w; } }
    }
};
template <int MODE  > struct EpiRes {
    static constexpr bool PERM = true, AFTER_DRAIN = false;
    const float* base_f; const bf16_t* base_h; float* out_f; bf16_t* out_h; const float* gate;
    __device__ __forceinline__ void operator()(const f32x4 (&acc)[2][2][4][2], const Unit& u, int wr, int wc, int fr, int fq) const {
        const int col0 = u.pn * BM + wc * 32 + 8 * fq; const float* gp = gate + (size_t)(u.pm >> 4) * 6144 + col0;
        f32x4 gv[2][2];
#pragma unroll
        for (int bj = 0; bj < 2; ++bj)
#pragma unroll
            for (int n = 0; n < 2; ++n) gv[bj][n] = *(const f32x4*)(gp + bj * HALF + 4 * n);
#pragma unroll
        for (int ai = 0; ai < 2; ++ai)
#pragma unroll
            for (int m = 0; m < 4; ++m) { const size_t off = (size_t)(u.pm * BM + ai * HALF + wr * 64 + m * 16 + fr) * 1024 + col0;
#pragma unroll
                for (int bj = 0; bj < 2; ++bj) { f32x4 b0, b1;
                    if constexpr (MODE == 0) { b0 = *(const f32x4*)(base_f + off + bj * HALF); b1 = *(const f32x4*)(base_f + off + bj * HALF + 4); }
                    else { const u32x4 w = *(const u32x4*)(base_h + off + bj * HALF);
                        b0 = (f32x4){__builtin_bit_cast(float, w.x << 16), __builtin_bit_cast(float, w.x & 0xffff0000u), __builtin_bit_cast(float, w.y << 16), __builtin_bit_cast(float, w.y & 0xffff0000u)};
                        b1 = (f32x4){__builtin_bit_cast(float, w.z << 16), __builtin_bit_cast(float, w.z & 0xffff0000u), __builtin_bit_cast(float, w.w << 16), __builtin_bit_cast(float, w.w & 0xffff0000u)}; }
                    const f32x4 o0 = b0 + gv[bj][0] * acc[ai][bj][m][0], o1 = b1 + gv[bj][1] * acc[ai][bj][m][1];
                    if constexpr (MODE == 2) { *(f32x4*)(out_f + off + bj * HALF) = o0; *(f32x4*)(out_f + off + bj * HALF + 4) = o1; }
                    else { u32x4 w; w.x = cvt_pk_bf16(o0[0], o0[1]); w.y = cvt_pk_bf16(o0[2], o0[3]); w.z = cvt_pk_bf16(o1[0], o1[1]); w.w = cvt_pk_bf16(o1[2], o1[3]); *(u32x4*)(out_h + off + bj * HALF) = w; } }
                if (m & 1) asm volatile("" ::: "memory"); }
    }
};
struct OrderQKV {
    StaticOrder so;
    __host__ __device__ void init(int G_, int c_) { so.init(16384, 2560, G_, c_); }
    __host__ __device__ bool next(int i, Unit& u) const {
        const long L = (long)i * so.G + so.c; if (L < so.nwg) return so.next(i, u);
        const int e = (int)(L - so.nwg); if (e >= 24) return false; u.pm = 64 + e / 6; u.pn = 4 + e % 6; return true; }
    __device__ __forceinline__ void a_ready(const Unit&) const {}
    __device__ __forceinline__ void done(const Unit&) const {}
};

template <class Epi, class Sched, bool ALIGN_EPI = false, bool SP2 = false>
__device__ __forceinline__ void gemm_phase(PG8_LAS unsigned char* lds, const Gemm g, const Sched& S, const Epi& E) {
    const int tid = ltid(), wid = __builtin_amdgcn_readfirstlane(tid >> 6), lane = tid & 63, wr = wid >> 2, wc = wid & 3, fr = lane & 15, fq = lane >> 4;
    const int K = g.K, nt = K / BK;
    unsigned voffA[2], voffB[2];
#pragma unroll
    for (int i = 0; i < 2; ++i) { int R, C; stage_rc(tid * 16 + i * 8192, R, C); const int Rb = Epi::PERM ? ((R & ~31) + perm32(R & 31)) : R;
        voffA[i] = (unsigned)(R * K + C) * 2u; voffB[i] = (unsigned)(Rb * K + C) * 2u; }
    const size_t kstep = (size_t)(BK * 2);
    const size_t hstep = (size_t)HALF * K * 2;
    const size_t tstep = 2 * hstep;
    const unsigned ldsw = (unsigned)wid * 1024u;
    const int aoff = lds_byte(wr * 64 + fr, fq * 8), boff = lds_byte(wc * 32 + fr, fq * 8);
#define PG8_SA(b, h) (((b) * 2 + (h)) * HTB)
#define PG8_SB(b, h) ((4 + (b) * 2 + (h)) * HTB)
#define PG8_STAGE(bufoff, gbase, voff) do { _Pragma("unroll") for (int _i = 0; _i < 2; ++_i) \
        __builtin_amdgcn_global_load_lds((const unsigned*)((const char*)(gbase) + (voff)[_i]), (PG8_LAS unsigned*)(lds + (bufoff) + ldsw + _i * 8192), 16, 0, 0); } while (0)
#define PG8_LDA(dst, b, h) do { _Pragma("unroll") for (int m = 0; m < 4; ++m) _Pragma("unroll") for (int k = 0; k < 2; ++k) dst[m][k] = *(const PG8_LAS bf16x8*)(lds + PG8_SA(b, h) + aoff + m * 2048 + k * 1024); } while (0)
#define PG8_LDB(dst, b, h) do { _Pragma("unroll") for (int n = 0; n < 2; ++n) _Pragma("unroll") for (int k = 0; k < 2; ++k) dst[n][k] = *(const PG8_LAS bf16x8*)(lds + PG8_SB(b, h) + boff + n * 2048 + k * 1024); } while (0)
#define PG8_MMA(ai, bj, At, Bt) do { __builtin_amdgcn_s_setprio(1); _Pragma("unroll") for (int m = 0; m < 4; ++m) _Pragma("unroll") for (int n = 0; n < 2; ++n) _Pragma("unroll") for (int k = 0; k < 2; ++k) \
        acc[ai][bj][m][n] = __builtin_amdgcn_mfma_f32_16x16x32_bf16(Bt[n][k], At[m][k], acc[ai][bj][m][n], 0, 0, 0); __builtin_amdgcn_s_setprio(0); } while (0)
#define PG8_WAIT_V(n) asm volatile("s_waitcnt vmcnt(" #n ")" ::: "memory")
#define PG8_WAIT_L(n) asm volatile("s_waitcnt lgkmcnt(" #n ")" ::: "memory")
#define PG8_BAR __builtin_amdgcn_s_barrier()
#define PG8_SCHED __builtin_amdgcn_sched_barrier(0)
    Unit cur, nxt; int ui = 0;
    if (!S.next(0, cur)) return;
    f32x4 acc[2][2][4][2];
#pragma unroll
    for (int a = 0; a < 2; ++a)
#pragma unroll
        for (int b = 0; b < 2; ++b)
#pragma unroll
            for (int m = 0; m < 4; ++m)
#pragma unroll
                for (int n = 0; n < 2; ++n) acc[a][b][m][n] = (f32x4){0.f, 0.f, 0.f, 0.f};
    bf16x8 At[4][2], B0[2][2], B1[2][2];
    const char* cA = (const char*)g.A + (size_t)cur.pm * tstep; const char* cB = (const char*)g.Bt + (size_t)cur.pn * tstep;
    S.a_ready(cur);
    if constexpr (SP2) {
        PG8_STAGE(PG8_SB(0, 0), cB, voffB); PG8_STAGE(PG8_SB(0, 1), cB + hstep, voffB); PG8_STAGE(PG8_SA(0, 0), cA, voffA); PG8_STAGE(PG8_SA(0, 1), cA + hstep, voffA);
        if (wr == 1) PG8_BAR;
        PG8_WAIT_V(2); PG8_BAR;
        PG8_STAGE(PG8_SB(1, 0), cB + kstep, voffB); PG8_STAGE(PG8_SA(1, 0), cA + kstep, voffA); PG8_STAGE(PG8_SB(1, 1), cB + hstep + kstep, voffB);
        PG8_WAIT_V(6); PG8_BAR;
    } else {
        PG8_STAGE(PG8_SB(0, 0), cB, voffB); PG8_STAGE(PG8_SA(0, 0), cA, voffA); PG8_STAGE(PG8_SB(0, 1), cB + hstep, voffB); PG8_STAGE(PG8_SA(0, 1), cA + hstep, voffA);
        if (wr == 1) PG8_BAR;
        PG8_WAIT_V(4); PG8_BAR;
        PG8_STAGE(PG8_SB(1, 0), cB + kstep, voffB); PG8_STAGE(PG8_SA(1, 0), cA + kstep, voffA); PG8_STAGE(PG8_SB(1, 1), cB + hstep + kstep, voffB);
        PG8_WAIT_V(6); PG8_BAR;
    }
    for (;;) {
        const bool has_next = S.next(ui + 1, nxt);
        const char* nA = has_next ? (const char*)g.A + (size_t)nxt.pm * tstep : cA; const char* nB = has_next ? (const char*)g.Bt + (size_t)nxt.pn * tstep : cB;
        for (int t = 0; t < nt; t += 2) {
            const bool last = (t == nt - 2);
            const char* a1 = cA + (size_t)(t + 1) * kstep;
            const char* a2 = last ? nA : cA + (size_t)(t + 2) * kstep; const char* b2 = last ? nB : cB + (size_t)(t + 2) * kstep;
            const char* a3 = a2 + kstep; const char* b3 = b2 + kstep;
            if (last && has_next) S.a_ready(nxt);
            if constexpr (SP2) {
            PG8_LDB(B0, 0, 0); PG8_LDB(B1, 0, 1); PG8_SCHED; PG8_LDA(At, 0, 0); PG8_STAGE(PG8_SA(1, 1), a1 + hstep, voffA);
            PG8_WAIT_V(8); PG8_WAIT_L(0); PG8_BAR; PG8_MMA(0, 0, At, B0); PG8_MMA(0, 1, At, B1); PG8_BAR; PG8_SCHED;
            PG8_LDA(At, 0, 1); PG8_STAGE(PG8_SB(0, 0), b2, voffB); PG8_STAGE(PG8_SB(0, 1), b2 + hstep, voffB); PG8_STAGE(PG8_SA(0, 0), a2, voffA);
            PG8_WAIT_V(8); PG8_WAIT_L(0); PG8_BAR; PG8_MMA(1, 0, At, B0); PG8_MMA(1, 1, At, B1); PG8_BAR; PG8_SCHED;
            PG8_LDB(B0, 1, 0); PG8_LDB(B1, 1, 1); PG8_SCHED; PG8_LDA(At, 1, 0); PG8_STAGE(PG8_SA(0, 1), a2 + hstep, voffA);
            PG8_WAIT_V(8); PG8_WAIT_L(0); PG8_BAR; PG8_MMA(0, 0, At, B0); PG8_MMA(0, 1, At, B1); PG8_BAR; PG8_SCHED;
            PG8_LDA(At, 1, 1); PG8_STAGE(PG8_SB(1, 0), b3, voffB); PG8_STAGE(PG8_SB(1, 1), b3 + hstep, voffB); PG8_STAGE(PG8_SA(1, 0), a3, voffA);
            PG8_WAIT_V(8); PG8_WAIT_L(0); PG8_BAR; PG8_MMA(1, 0, At, B0); PG8_MMA(1, 1, At, B1); PG8_BAR; PG8_SCHED;
            } else {
            PG8_LDB(B0, 0, 0); PG8_SCHED; PG8_LDA(At, 0, 0); PG8_STAGE(PG8_SA(1, 1), a1 + hstep, voffA);
            PG8_WAIT_L(8); PG8_BAR; PG8_WAIT_L(0); PG8_MMA(0, 0, At, B0); PG8_BAR; PG8_SCHED;
            PG8_LDB(B1, 0, 1); PG8_STAGE(PG8_SB(0, 0), b2, voffB);
            PG8_BAR; PG8_WAIT_L(0); PG8_MMA(0, 1, At, B1); PG8_BAR;
            PG8_LDA(At, 0, 1); PG8_STAGE(PG8_SA(0, 0), a2, voffA);
            PG8_BAR; PG8_WAIT_L(0); PG8_MMA(1, 0, At, B0); PG8_BAR; PG8_SCHED;
            PG8_STAGE(PG8_SB(0, 1), b2 + hstep, voffB);
            PG8_WAIT_V(6); PG8_BAR; PG8_MMA(1, 1, At, B1); PG8_BAR;
            PG8_LDB(B0, 1, 0); PG8_SCHED; PG8_LDA(At, 1, 0); PG8_STAGE(PG8_SA(0, 1), a2 + hstep, voffA);
            PG8_WAIT_L(8); PG8_BAR; PG8_WAIT_L(0); PG8_MMA(0, 0, At, B0); PG8_BAR; PG8_SCHED;
            PG8_LDB(B1, 1, 1); PG8_STAGE(PG8_SB(1, 0), b3, voffB);
            PG8_BAR; PG8_WAIT_L(0); PG8_MMA(0, 1, At, B1); PG8_BAR;
            PG8_LDA(At, 1, 1); PG8_STAGE(PG8_SA(1, 0), a3, voffA);
            PG8_BAR; PG8_WAIT_L(0); PG8_MMA(1, 0, At, B0); PG8_BAR; PG8_SCHED;
            PG8_STAGE(PG8_SB(1, 1), b3 + hstep, voffB);
            PG8_WAIT_V(6); PG8_BAR; PG8_MMA(1, 1, At, B1); PG8_BAR;
            }
        }
        if constexpr (ALIGN_EPI) { if (wr == 0) PG8_BAR; }
        if constexpr (!Epi::AFTER_DRAIN) { E(acc, cur, wr, wc, fr, fq); S.done(cur); }
        if (!has_next) break;
#pragma unroll
        for (int a = 0; a < 2; ++a)
#pragma unroll
            for (int b = 0; b < 2; ++b)
#pragma unroll
                for (int m = 0; m < 4; ++m)
#pragma unroll
                    for (int n = 0; n < 2; ++n) acc[a][b][m][n] = (f32x4){0.f, 0.f, 0.f, 0.f};
        cur = nxt; cA = nA; cB = nB; ++ui;
        if constexpr (ALIGN_EPI) { if (wr == 1) PG8_BAR; }
    }
    PG8_WAIT_V(0);
    if constexpr (!ALIGN_EPI) { if (wr == 0) PG8_BAR; }
    PG8_BAR;
    if constexpr (Epi::AFTER_DRAIN) { E.fused(acc, cur, wr, wc, fr, fq, lds, wid, lane); S.done(cur); }
#undef PG8_SA
#undef PG8_SB
#undef PG8_STAGE
#undef PG8_LDA
#undef PG8_LDB
#undef PG8_MMA
#undef PG8_WAIT_V
#undef PG8_WAIT_L
#undef PG8_BAR
#undef PG8_SCHED
}
}

namespace att {
using bf16x8 = __attribute__((ext_vector_type(8))) short;
using s16x4  = __attribute__((ext_vector_type(4))) short;
using f32x16 = __attribute__((ext_vector_type(16))) float;
using u32x4  = __attribute__((ext_vector_type(4))) unsigned;
typedef unsigned short bf16;
constexpr int NW = 8, QBLK = 32, KVBLK = 64, LDQ = 768, LDK = 768, LDY = 1024, SEQK = 4352;
constexpr float SCALE = 0.125f, THR = 8.f;
constexpr int SDEPTH = 2;
constexpr int NSLOT = 3;
constexpr size_t SHM_V = KVBLK * 128 * 2, SHM_K = KVBLK * 128 * 2, SHM_ATTN = NSLOT * SHM_V + NSLOT * SHM_K + NW * 64 * 4;
#define KSWZ(row, colB) ((row) * 256 + ((colB) ^ (((row) & 7) << 4)))
#define SBAR() __builtin_amdgcn_sched_barrier(0)
__device__ __forceinline__ int crow(int r, int hi) { return (r & 3) + 8 * (r >> 2) + 4 * hi; }
__device__ __forceinline__ unsigned cvtpk(float lo, float hi) { unsigned r; asm volatile("v_cvt_pk_bf16_f32 %0, %1, %2" : "=v"(r) : "v"(lo), "v"(hi)); return r; }
__device__ __forceinline__ unsigned short f2bf(float f) { unsigned u = __builtin_bit_cast(unsigned, f); return (unsigned short)((u + 0x7fffu + ((u >> 16) & 1u)) >> 16); }

__device__ __forceinline__ void partialSM(f32x16& p0, f32x16& p1, float& m_reg, float& mn, float& alpha) {
  constexpr float C = SCALE * 1.4426950408889634f;
  float pmax = p0[0];
#pragma unroll
  for (int r = 1; r < 16; ++r) pmax = fmaxf(pmax, p0[r]);
#pragma unroll
  for (int r = 0; r < 16; ++r) pmax = fmaxf(pmax, p1[r]);
  { auto rr = __builtin_amdgcn_permlane32_swap(__float_as_uint(pmax), __float_as_uint(pmax), false, false);
    pmax = fmaxf(__uint_as_float(rr[0]), __uint_as_float(rr[1])); }
  if (__builtin_expect(__all(pmax - m_reg <= THR / SCALE), 1)) { mn = m_reg; alpha = 1.f; }
  else { mn = fmaxf(m_reg, pmax); alpha = __builtin_amdgcn_exp2f((m_reg - mn) * C); m_reg = mn; }
  float mnC = -mn * C;
#pragma unroll
  for (int r = 0; r < 16; ++r) p0[r] = fmaf(p0[r], C, mnC);
#pragma unroll
  for (int r = 0; r < 16; ++r) p1[r] = fmaf(p1[r], C, mnC);
#pragma unroll
  for (int r = 0; r < 16; ++r) p0[r] = __builtin_amdgcn_exp2f(p0[r]);
}
__device__ __forceinline__ void partialSM_fixed(f32x16& p0, f32x16& p1, float mBC) {
  constexpr float C = SCALE * 1.4426950408889634f;
#pragma unroll
  for (int r = 0; r < 16; ++r) p0[r] = fmaf(p0[r], C, mBC);
#pragma unroll
  for (int r = 0; r < 16; ++r) p1[r] = fmaf(p1[r], C, mBC);
#pragma unroll
  for (int r = 0; r < 16; ++r) p0[r] = __builtin_amdgcn_exp2f(p0[r]);
}
__device__ __forceinline__ void finishSM(f32x16& p0, f32x16& p1, float alpha, float& l_reg, bf16x8& pa0, bf16x8& pa1, bf16x8& pa2, bf16x8& pa3) {
#pragma unroll
  for (int r = 0; r < 16; ++r) p1[r] = __builtin_amdgcn_exp2f(p1[r]);
  float ps = 0;
#pragma unroll
  for (int r = 0; r < 16; ++r) ps += p0[r];
#pragma unroll
  for (int r = 0; r < 16; ++r) ps += p1[r];
  { auto rr = __builtin_amdgcn_permlane32_swap(__float_as_uint(ps), __float_as_uint(ps), false, false);
    ps = __uint_as_float(rr[0]) + __uint_as_float(rr[1]); }
  l_reg = l_reg * alpha + ps;
#define PK4(P, BASE, OUT) do { unsigned a0 = cvtpk(P[BASE + 0], P[BASE + 1]), a1 = cvtpk(P[BASE + 2], P[BASE + 3]);   \
    unsigned b0 = cvtpk(P[BASE + 4], P[BASE + 5]), b1 = cvtpk(P[BASE + 6], P[BASE + 7]);                              \
    auto r0 = __builtin_amdgcn_permlane32_swap(a0, b0, false, false); auto r1 = __builtin_amdgcn_permlane32_swap(a1, b1, false, false); \
    u32x4 w = {r0[0], r1[0], r0[1], r1[1]}; OUT = *reinterpret_cast<bf16x8*>(&w); } while (0)
  PK4(p0, 0, pa0); PK4(p0, 8, pa1); PK4(p1, 0, pa2); PK4(p1, 8, pa3);
#undef PK4
}
__device__ __forceinline__ void qkt(f32x16& p0, f32x16& p1, const bf16* Ks, const bf16x8* qr, int r32, int hi, int comp) {
  p0 = f32x16{}; p1 = f32x16{};
#pragma unroll
  for (int d0 = 0; d0 < 4; ++d0) { int cb = (comp * 64 + d0 * 16 + hi * 8) * 2;
    bf16x8 b0 = *reinterpret_cast<const bf16x8*>((const char*)Ks + KSWZ(r32, cb));
    bf16x8 b1 = *reinterpret_cast<const bf16x8*>((const char*)Ks + KSWZ(32 + r32, cb));
    p0 = __builtin_amdgcn_mfma_f32_32x32x16_bf16(b0, qr[d0], p0, 0, 0, 0);
    p1 = __builtin_amdgcn_mfma_f32_32x32x16_bf16(b1, qr[d0], p1, 0, 0, 0); }
}
__device__ __forceinline__ int v_st(int k, int c) { const int kk = (k & ~0xC) | ((k & 4) << 1) | ((k & 8) >> 1); return ((kk >> 3) * 4 + (c >> 5)) * 512 + ((kk & 7) * 32 + (c & 31)) * 2; }
__device__ __forceinline__ int v_rd_base(int lane) { return ((lane & 3) << 3) | (((lane >> 2) & 3) << 6) | (((lane >> 4) & 1) << 5) | (((lane >> 5) & 1) << 8); }
constexpr int v_rd_off(int d0, int ks, int half) { return d0 * 512 + ks * 4096 + half * 2048; }
template <int OFF> __device__ __forceinline__ s16x4 tr_read(int vb) {
  s16x4 r; asm volatile("ds_read_b64_tr_b16 %0, %1 offset:%2" : "=&v"(r) : "v"(vb), "i"(OFF) : "memory"); return r;
}
template <int D0> __device__ __forceinline__ void pv_one(f32x16& od, int vb, bf16x8 pa0, bf16x8 pa1, bf16x8 pa2, bf16x8 pa3) {
  const s16x4 l0 = tr_read<v_rd_off(D0, 0, 0)>(vb), h0 = tr_read<v_rd_off(D0, 0, 1)>(vb), l1 = tr_read<v_rd_off(D0, 1, 0)>(vb), h1 = tr_read<v_rd_off(D0, 1, 1)>(vb);
  const s16x4 l2 = tr_read<v_rd_off(D0, 2, 0)>(vb), h2 = tr_read<v_rd_off(D0, 2, 1)>(vb), l3 = tr_read<v_rd_off(D0, 3, 0)>(vb), h3 = tr_read<v_rd_off(D0, 3, 1)>(vb);
  asm volatile("s_waitcnt lgkmcnt(0)" ::: "memory"); SBAR();
#define PK(L, H) (bf16x8){L[0], L[1], L[2], L[3], H[0], H[1], H[2], H[3]}
  od = __builtin_amdgcn_mfma_f32_32x32x16_bf16(pa0, PK(l0, h0), od, 0, 0, 0);
  od = __builtin_amdgcn_mfma_f32_32x32x16_bf16(pa1, PK(l1, h1), od, 0, 0, 0);
  od = __builtin_amdgcn_mfma_f32_32x32x16_bf16(pa2, PK(l2, h2), od, 0, 0, 0);
  od = __builtin_amdgcn_mfma_f32_32x32x16_bf16(pa3, PK(l3, h3), od, 0, 0, 0);
#undef PK
}
__device__ __forceinline__ void pv_d0(f32x16* o, int vb, bf16x8 pa0, bf16x8 pa1, bf16x8 pa2, bf16x8 pa3) {
  pv_one<0>(o[0], vb, pa0, pa1, pa2, pa3); pv_one<1>(o[1], vb, pa0, pa1, pa2, pa3); pv_one<2>(o[2], vb, pa0, pa1, pa2, pa3); pv_one<3>(o[3], vb, pa0, pa1, pa2, pa3);
}

template <bool FIXED> __device__ __forceinline__ void attn_unit(const bf16* __restrict__ Qb, const bf16* __restrict__ Kh, const bf16* __restrict__ Vh, bf16* __restrict__ Yb,
                                          const float* __restrict__ subg, float lam, float mBC, char* lds) {
  const int tid = ltid(), wid = tid >> 6, lane = tid & 63, r32 = lane & 31, hi = lane >> 5;
  const int comp = wid >> 2, wq = wid & 3;
  bf16* V_lds = (bf16*)lds; bf16* K_lds = (bf16*)(lds + NSLOT * SHM_V);
  float* ws = (float*)(lds + NSLOT * SHM_V + NSLOT * SHM_K) + wid * 64; float* li_l = ws; float* al_l = ws + 32;
  float m_reg = -1e30f, l_reg = 0; f32x16 o[4] = {}; bf16x8 qr[4];
  const bf16* Qw = Qb + (long)(wq * QBLK + r32) * LDQ + comp * 64 + hi * 8;
#pragma unroll
  for (int d0 = 0; d0 < 4; ++d0) qr[d0] = *reinterpret_cast<const bf16x8*>(Qw + d0 * 16);
  const int sr = tid >> 4, sc = (tid & 15) * 8, vst0 = v_st(sr, sc), vst1 = v_st(32 + sr, sc);
  const int vb0 = (int)(uintptr_t)V_lds + v_rd_base(lane);
  struct { bf16x8 vs0, vs1, ks0, ks1; } sr_[SDEPTH];
#define SLOAD(i, k0) do { sr_[i].vs0 = *reinterpret_cast<const bf16x8*>(&Vh[(long)((k0) + sr) * LDK + sc]); sr_[i].vs1 = *reinterpret_cast<const bf16x8*>(&Vh[(long)((k0) + 32 + sr) * LDK + sc]); \
    sr_[i].ks0 = *reinterpret_cast<const bf16x8*>(&Kh[(long)((k0) + sr) * LDK + sc]); sr_[i].ks1 = *reinterpret_cast<const bf16x8*>(&Kh[(long)((k0) + 32 + sr) * LDK + sc]); } while (0)
#define SWRITE(b, i) do { *(bf16x8*)((char*)V_lds + (b) * SHM_V + vst0) = sr_[i].vs0;          \
    *(bf16x8*)((char*)V_lds + (b) * SHM_V + vst1) = sr_[i].vs1; int kc = sc * 2;               \
    *(bf16x8*)((char*)K_lds + (b) * SHM_K + KSWZ(sr, kc)) = sr_[i].ks0;                       \
    *(bf16x8*)((char*)K_lds + (b) * SHM_K + KSWZ(32 + sr, kc)) = sr_[i].ks1; } while (0)
#define SWAIT() do { asm volatile("s_waitcnt vmcnt(4)" ::: "memory"); } while (0)
#define PSM(P0, P1, MN, AL) do { if constexpr (FIXED) { partialSM_fixed(P0, P1, mBC); AL = 1.f; } else partialSM(P0, P1, m_reg, MN, AL); } while (0)
#define RESC(a) do { if constexpr (!FIXED) if (__any((a) < 1.f)) { if (hi == 0) al_l[r32] = (a); asm volatile("s_waitcnt lgkmcnt(0)" ::: "memory"); \
    _Pragma("unroll") for (int d = 0; d < 4; ++d) _Pragma("unroll") for (int r = 0; r < 16; ++r) o[d][r] *= al_l[crow(r, hi)]; } } while (0)
  f32x16 pA0, pA1, pB0, pB1; float mnA, mnB, alA, alB; bf16x8 pa0, pa1, pa2, pa3; constexpr int NT = SEQK / KVBLK;
  constexpr int SE = 0, SO = SDEPTH - 1;
  SLOAD(SE, 0); asm volatile("s_waitcnt vmcnt(0)" ::: "memory"); SWRITE(0, SE); __syncthreads();
  qkt(pA0, pA1, K_lds, qr, r32, hi, comp); PSM(pA0, pA1, mnA, alA);
  SLOAD(SO, KVBLK); if (2 < NT) SLOAD(SE, 2 * KVBLK);
  SWAIT(); SWRITE(1, SO); __syncthreads();
  int sk = 1, sv = 0, sw = 2;
#define ROT() do { sv = sk; sk = sw; sw = (sw == NSLOT - 1) ? 0 : sw + 1; } while (0)
  for (int j = 1; j + 1 < NT; j += 2) {
    SBAR(); qkt(pB0, pB1, (bf16*)((char*)K_lds + sk * SHM_K), qr, r32, hi, comp);
    finishSM(pA0, pA1, alA, l_reg, pa0, pa1, pa2, pa3); SBAR();
    SLOAD(SO, (j + SDEPTH) * KVBLK); SBAR();
    SWAIT(); SWRITE(sw, SE); SBAR();
    pv_d0(o, vb0 + sv * (int)SHM_V, pa0, pa1, pa2, pa3); PSM(pB0, pB1, mnB, alB);
    RESC(alB); __syncthreads(); ROT();
    SBAR(); qkt(pA0, pA1, (bf16*)((char*)K_lds + sk * SHM_K), qr, r32, hi, comp);
    finishSM(pB0, pB1, alB, l_reg, pa0, pa1, pa2, pa3); SBAR();
    if (j + 3 < NT) { SLOAD(SE, (j + 1 + SDEPTH) * KVBLK); SBAR(); SWAIT(); } else { asm volatile("s_waitcnt vmcnt(0)" ::: "memory"); }
    SWRITE(sw, SO); SBAR();
    pv_d0(o, vb0 + sv * (int)SHM_V, pa0, pa1, pa2, pa3); PSM(pA0, pA1, mnA, alA);
    RESC(alA); __syncthreads(); ROT();
  }
  SBAR(); qkt(pB0, pB1, (bf16*)((char*)K_lds + sk * SHM_K), qr, r32, hi, comp);
  finishSM(pA0, pA1, alA, l_reg, pa0, pa1, pa2, pa3); SBAR();
  pv_d0(o, vb0 + sv * (int)SHM_V, pa0, pa1, pa2, pa3); PSM(pB0, pB1, mnB, alB);
  RESC(alB);
  finishSM(pB0, pB1, alB, l_reg, pa0, pa1, pa2, pa3); SBAR();
  pv_d0(o, vb0 + sk * (int)SHM_V, pa0, pa1, pa2, pa3);
#undef ROT
  if (hi == 0) li_l[r32] = l_reg; asm volatile("s_waitcnt lgkmcnt(0)" ::: "memory");
  float rli[16];
#pragma unroll
  for (int r = 0; r < 16; ++r) rli[r] = __builtin_amdgcn_rcpf(li_l[crow(r, hi)]);
  __syncthreads();
  float* X = (float*)lds + wq * 4096;
  if (comp == 1) {
#pragma unroll
    for (int d0 = 0; d0 < 4; ++d0)
#pragma unroll
      for (int r = 0; r < 16; ++r) X[(d0 * 16 + r) * 64 + lane] = o[d0][r] * rli[r] * lam;
  }
  __syncthreads();
  if (comp == 0) {
    float ss[16];
#pragma unroll
    for (int r = 0; r < 16; ++r) ss[r] = 0.f;
#pragma unroll
    for (int d0 = 0; d0 < 4; ++d0)
#pragma unroll
      for (int r = 0; r < 16; ++r) { const float d = o[d0][r] * rli[r] - X[(d0 * 16 + r) * 64 + lane]; o[d0][r] = d; ss[r] += d * d; }
#pragma unroll
    for (int r = 0; r < 16; ++r) {
#pragma unroll
      for (int off = 1; off < 32; off <<= 1) ss[r] += __shfl_xor(ss[r], off);
    }
    float g4[4];
#pragma unroll
    for (int d0 = 0; d0 < 4; ++d0) g4[d0] = subg[d0 * 32 + r32] * 0.8f;
#pragma unroll
    for (int r = 0; r < 16; ++r) { const float rs = rsqrtf(ss[r] * (1.f / 128.f) + 1e-6f); bf16* yrow = Yb + (long)(wq * QBLK + crow(r, hi)) * LDY;
#pragma unroll
      for (int d0 = 0; d0 < 4; ++d0) yrow[d0 * 32 + r32] = f2bf(o[d0][r] * rs * g4[d0]); }
  }
  __syncthreads();
#undef SLOAD
#undef SWRITE
#undef SWAIT
#undef RESC
#undef PSM
}
#undef SBAR
}


#ifndef MK_DEBUG
#define MK_DEBUG 0
#endif
#define PROBE_XB
#ifndef MK_SIMPLE6
#define MK_SIMPLE6 0
#endif
#ifndef NPH_RUN
#define NPH_RUN 16
#endif
#ifndef PHMASK
#define PHMASK 0xFFFF
#endif
#define PHM(k) ((PHMASK >> (k)) & 1)
#ifndef MK_MULTI
#define MK_MULTI 0
#endif
#define LAS __attribute__((address_space(3)))
#define GAS __attribute__((address_space(1)))
typedef unsigned short bf16;
typedef unsigned v4u __attribute__((ext_vector_type(4)));
typedef unsigned v2u __attribute__((ext_vector_type(2)));
typedef float f32x4 __attribute__((ext_vector_type(4)));
typedef short bf16x8 __attribute__((ext_vector_type(8)));
typedef float f32x16 __attribute__((ext_vector_type(16)));
#define LDS_WAIT() asm volatile("s_waitcnt lgkmcnt(0)" ::: "memory")
constexpr int NWAVES = 8, NTHR = 512, NPH = 16;
constexpr int SEQ = 4096, DM = 1024, MTOK = 16384, TKV = 4352, FF = 4096, MODW = 6144;
constexpr size_t MiB = 1u << 20;
constexpr size_t WS_ROPE = 524288;
constexpr size_t WS_MOD = 1 * MiB, WS_WIN = 2 * MiB, WS_WOUT = 7 * MiB, WS_W1 = 9 * MiB, WS_W2 = 25 * MiB, WS_ODIN = 41 * MiB, WS_ODOUT = 49 * MiB;
constexpr size_t WS_XN = 56 * MiB;
constexpr size_t WS_Q = 92 * MiB, WS_K = 116 * MiB, WS_V = 142 * MiB, WS_POOL = 168 * MiB, WS_Y = 176 * MiB;
constexpr size_t WS_HB = 92 * MiB;
constexpr size_t WS_U = 92 * MiB, WS_VT = 156 * MiB;
constexpr size_t WS_XR = 220 * MiB;
constexpr size_t WS_END = 252 * MiB;
constexpr int LDS_BYTES = 147456;

__device__ __forceinline__ unsigned f2bf(float f) { unsigned u = __builtin_bit_cast(unsigned, f); return (u + 0x7fffu + ((u >> 16) & 1u)) >> 16; }
__device__ __forceinline__ unsigned pk2(float lo, float hi) { return f2bf(lo) | (f2bf(hi) << 16); }
__device__ __forceinline__ float bflo(unsigned w) { return __builtin_bit_cast(float, w << 16); }
__device__ __forceinline__ float bfhi(unsigned w) { return __builtin_bit_cast(float, w & 0xffff0000u); }
__device__ __forceinline__ float wave_sum(float v) {
#pragma unroll
    for (int o = 1; o < 64; o <<= 1) v += __shfl_xor(v, o);
    return v;
}

struct Args { const float* in[27]; float* out; unsigned char* ws; int ph_lo, ph_hi; };

__device__ __forceinline__ void p0_transpose_item(const float* W, int K, int N, bf16* WT, LAS float* scr, int item, int lane, bool permqk = false) {
    const int nblk = N / 32, kb = item / nblk, nb = item % nblk, k0 = 64 * kb, n0 = 32 * nb;
    int d0 = n0;
    if (permqk) { const int tile = n0 >> 8, c = n0 & 255; if (tile >= 1 && tile <= 6) d0 = tile * 256 + 128 * ((c >> 5) & 1) + 32 * (c >> 6); }
#pragma unroll 8
    for (int i = 0; i < 32; ++i) { const int kk = 2 * i + (lane >> 5); scr[kk * 33 + (lane & 31)] = W[(size_t)(k0 + kk) * N + n0 + (lane & 31)]; }
    LDS_WAIT(); asm volatile("" ::: "memory");
    const int c = lane & 7;
#pragma unroll
    for (int j = 0; j < 4; ++j) { const int n = (lane >> 3) + 8 * j; const LAS float* s = scr + (8 * c) * 33 + n;
        v4u o; o.x = pk2(s[0 * 33], s[1 * 33]); o.y = pk2(s[2 * 33], s[3 * 33]); o.z = pk2(s[4 * 33], s[5 * 33]); o.w = pk2(s[6 * 33], s[7 * 33]);
        *(v4u*)(WT + (size_t)(d0 + n) * K + k0 + 8 * c) = o; }
    LDS_WAIT(); asm volatile("" ::: "memory");
}
__device__ __forceinline__ void p0_prep(const Args& a, unsigned char* ldsg, int vcu, int G) {
    LAS unsigned char* lds = (LAS unsigned char*)ldsg;
    const int tid = ltid(), lane = tid & 63, wave = tid >> 6;
    float* mod = (float*)(a.ws + WS_MOD);
    for (int item = blockIdx.x; item < 192; item += G) {
        LAS float* sin_ = (LAS float*)lds;
        for (int i = tid; i < 5 * 1024; i += NTHR) { const int r = i >> 10, k = i & 1023; const float c = r < 4 ? a.in[1][r * 1024 + k] : a.in[3][k]; sin_[i] = c / (1.f + __expf(-c)); }
        __syncthreads();
        const int l = item / 96, cb = item % 96;
        const float* W = a.in[4] + (size_t)l * 1024 * MODW + cb * 64 + lane;
        float acc[5] = {0.f, 0.f, 0.f, 0.f, 0.f};
        const int k0 = wave * 128;
#pragma unroll 8
        for (int kk = 0; kk < 128; ++kk) { const int k = k0 + kk; const float w = W[(size_t)k * MODW];
#pragma unroll
            for (int r = 0; r < 5; ++r) acc[r] += sin_[r * 1024 + k] * w; }
        LAS float* red = (LAS float*)(lds + 20480);
#pragma unroll
        for (int r = 0; r < 5; ++r) red[(wave * 5 + r) * 64 + lane] = acc[r];
        __syncthreads();
        if (tid < 320) { const int r = tid >> 6, col = tid & 63; float s = 0.f;
#pragma unroll
            for (int w = 0; w < 8; ++w) s += red[(w * 5 + r) * 64 + col];
            s += a.in[5][l * MODW + cb * 64 + col]; mod[(size_t)(l * 5 + r) * MODW + cb * 64 + col] = s; }
        __syncthreads();
    }
    if (blockIdx.x == G - 1) { float* rt = (float*)(a.ws + WS_ROPE);
        for (int i = tid; i < 1024; i += NTHR) { const int pos = i >> 4, f = i & 15; const float inv = powf(10000.0f, -(float)f / 16.0f); const float ang = (float)pos * inv; float sn, cs; sincosf(ang, &sn, &cs); rt[2 * i] = cs; rt[2 * i + 1] = sn; } }
    LAS float* scr = (LAS float*)(lds + 32768 + wave * 8448);
    const int gw = vcu * NWAVES + wave, NGW = G * NWAVES;
    constexpr int I_WIN = 16 * 80, I_WOUT = 16 * 32, I_W1 = 16 * 128, I_W2 = 64 * 32, I_ODIN = 16 * 128, I_ODOUT = 32 * 32;
    constexpr int NITEMS = I_WIN + I_WOUT + 2 * I_W1 + 2 * I_W2 + I_ODIN + I_ODOUT;
    for (int it = gw; it < NITEMS; it += NGW) {
        int r = it;
        if (r < I_WIN) { p0_transpose_item(a.in[10], 1024, 2560, (bf16*)(a.ws + WS_WIN), scr, r, lane, true); continue; } r -= I_WIN;
        if (r < I_WOUT) { p0_transpose_item(a.in[11], 1024, 1024, (bf16*)(a.ws + WS_WOUT), scr, r, lane); continue; } r -= I_WOUT;
        if (r < 2 * I_W1) { const int l = r / I_W1; p0_transpose_item(a.in[8] + (size_t)l * 1024 * 4096, 1024, 4096, (bf16*)(a.ws + WS_W1) + (size_t)l * 4096 * 1024, scr, r % I_W1, lane); continue; } r -= 2 * I_W1;
        if (r < 2 * I_W2) { const int l = r / I_W2; p0_transpose_item(a.in[9] + (size_t)l * 4096 * 1024, 4096, 1024, (bf16*)(a.ws + WS_W2) + (size_t)l * 1024 * 4096, scr, r % I_W2, lane); continue; } r -= 2 * I_W2;
        if (r < I_ODIN) { p0_transpose_item(a.in[21], 1024, 4096, (bf16*)(a.ws + WS_ODIN), scr, r, lane); continue; } r -= I_ODIN;
        p0_transpose_item(a.in[26], 2048, 1024, (bf16*)(a.ws + WS_ODOUT), scr, r, lane);
    }
}

__device__ __forceinline__ void norm_row(const float* xrow, bf16* orow, const f32x4 (&gs)[4], const f32x4 (&sh)[4], int lane) {
    const f32x4* xr = (const f32x4*)xrow + lane;
    f32x4 v[4]; float s2 = 0.f;
#pragma unroll
    for (int j = 0; j < 4; ++j) { v[j] = xr[64 * j]; s2 += (v[j].x * v[j].x + v[j].y * v[j].y) + (v[j].z * v[j].z + v[j].w * v[j].w); }
    const float rstd = rsqrtf(wave_sum(s2) * (1.f / 1024.f) + 1e-6f);
    unsigned long long* o8 = (unsigned long long*)orow + lane;
#pragma unroll
    for (int j = 0; j < 4; ++j) { const f32x4 y = v[j] * rstd * gs[j] + sh[j];
        o8[64 * j] = (unsigned long long)pk2(y.x, y.y) | ((unsigned long long)pk2(y.z, y.w) << 32); }
}
__device__ __forceinline__ void load_mod(const float* g, const float* shp, const float* scp, f32x4 (&gs)[4], f32x4 (&sh)[4], int lane) {
#pragma unroll
    for (int j = 0; j < 4; ++j) { const int idx = 4 * lane + 256 * j; const f32x4 gv = *(const f32x4*)(g + idx), sv = *(const f32x4*)(scp + idx); gs[j] = gv * (sv + 1.0f); sh[j] = *(const f32x4*)(shp + idx); }
}
__device__ __forceinline__ void norm_phase(const float* src, const float* g, const float* modl, int sh_off, int sc_off, bf16* dst, const float* ctx, int vcu, int G) {
    const int tid = ltid(), lane = tid & 63, wave = tid >> 6;
    for (int rb = vcu; rb < 256; rb += G) {
        const int b = rb >> 6; f32x4 gs[4], sh[4];
        load_mod(g, modl + (size_t)b * MODW + sh_off, modl + (size_t)b * MODW + sc_off, gs, sh, lane);
        for (int rr = 0; rr < 8; ++rr) { const size_t row = (size_t)rb * 64 + wave * 8 + rr; norm_row(src + row * 1024, dst + row * 1024, gs, sh, lane); }
        if (ctx && wave < 4) {
            load_mod(g, modl + (size_t)4 * MODW + sh_off, modl + (size_t)4 * MODW + sc_off, gs, sh, lane);
            const size_t row = (size_t)rb * 4 + wave; norm_row(ctx + row * 1024, dst + ((size_t)MTOK + row) * 1024, gs, sh, lane);
        }
    }
}

__device__ __forceinline__ void norm_phase_h(const bf16* src, const float* g, const float* modl, int sh_off, int sc_off, bf16* dst, int vcu, int G) {
    const int tid = ltid(), lane = tid & 63, wave = tid >> 6;
    for (int rb = vcu; rb < 256; rb += G) {
        const int b = rb >> 6; f32x4 gs[4], sh[4];
#pragma unroll
        for (int j = 0; j < 4; ++j) { const int idx = 16 * lane + 4 * j; const f32x4 gv = *(const f32x4*)(g + idx), sv = *(const f32x4*)(modl + (size_t)b * MODW + sc_off + idx); gs[j] = gv * (sv + 1.0f); sh[j] = *(const f32x4*)(modl + (size_t)b * MODW + sh_off + idx); }
        for (int hb = 0; hb < 2; ++hb) {
        v4u w[4][2];
#pragma unroll
        for (int rr = 0; rr < 4; ++rr) { const size_t row = (size_t)rb * 64 + wave * 8 + hb * 4 + rr; w[rr][0] = *(const v4u*)(src + row * 1024 + 16 * lane); w[rr][1] = *(const v4u*)(src + row * 1024 + 16 * lane + 8); }
#pragma unroll
        for (int rr = 0; rr < 4; ++rr) { const size_t row = (size_t)rb * 64 + wave * 8 + hb * 4 + rr; f32x4 v[4];
            v[0] = (f32x4){bflo(w[rr][0].x), bfhi(w[rr][0].x), bflo(w[rr][0].y), bfhi(w[rr][0].y)}; v[1] = (f32x4){bflo(w[rr][0].z), bfhi(w[rr][0].z), bflo(w[rr][0].w), bfhi(w[rr][0].w)};
            v[2] = (f32x4){bflo(w[rr][1].x), bfhi(w[rr][1].x), bflo(w[rr][1].y), bfhi(w[rr][1].y)}; v[3] = (f32x4){bflo(w[rr][1].z), bfhi(w[rr][1].z), bflo(w[rr][1].w), bfhi(w[rr][1].w)};
            float s2 = 0.f;
#pragma unroll
            for (int j = 0; j < 4; ++j) s2 += (v[j].x * v[j].x + v[j].y * v[j].y) + (v[j].z * v[j].z + v[j].w * v[j].w);
            const float rstd = rsqrtf(wave_sum(s2) * (1.f / 1024.f) + 1e-6f);
            v4u o0, o1; f32x4 y;
            y = v[0] * rstd * gs[0] + sh[0]; o0.x = pk2(y.x, y.y); o0.y = pk2(y.z, y.w); y = v[1] * rstd * gs[1] + sh[1]; o0.z = pk2(y.x, y.y); o0.w = pk2(y.z, y.w);
            y = v[2] * rstd * gs[2] + sh[2]; o1.x = pk2(y.x, y.y); o1.y = pk2(y.z, y.w); y = v[3] * rstd * gs[3] + sh[3]; o1.z = pk2(y.x, y.y); o1.w = pk2(y.z, y.w);
            *(v4u*)(dst + row * 1024 + 16 * lane) = o0; *(v4u*)(dst + row * 1024 + 16 * lane + 8) = o1; }
        }
    }
}

__device__ __forceinline__ void pool_phase(const Args& a, unsigned char* lds, int vcu, int G) {
    const int tid = ltid(), lane = tid & 63, wave = tid >> 6;
    bf16* in_ = (bf16*)(lds + 8192);
    float* pooled = (float*)(lds + 8192 + 40960);
    const bf16* PI = (const bf16*)(a.ws + WS_POOL); bf16* Y = (bf16*)(a.ws + WS_Y);
    const float* pw = a.in[12]; const float* pscale = a.in[13];
    for (int tb = vcu; tb < 256; tb += G) {
        const int b = tb >> 6, t0 = (tb & 63) * 64;
        __syncthreads();
#pragma unroll
        for (int ps = 0; ps < 5; ++ps) { const int row = ps * 16 + (tid >> 5), c8 = (tid & 31) * 8, t = t0 - 8 + row;
            v4u w = {0u, 0u, 0u, 0u}; if (t >= 0 && t < SEQ) w = *(const v4u*)(PI + ((size_t)b * SEQ + t) * 256 + c8);
            *(v4u*)(in_ + row * 256 + c8) = w; }
        __syncthreads();
        { const int c = tid & 255, th = tid >> 8, hw = 1 << (c >> 6);
            for (int tt = 0; tt < 32; ++tt) { const int tl = th * 32 + tt, t = t0 + tl; const int lo = max(t - hw, 0), hi = min(t + hw, SEQ);
                float s = 0.f; for (int j = lo; j < hi; ++j) s += bflo((unsigned)in_[(j - t0 + 8) * 256 + c]);
                pooled[tl * 256 + c] = s / (float)(hi - lo) - bflo((unsigned)in_[(tl + 8) * 256 + c]); } }
        __syncthreads();
        { const int gi = wave & 3, th = wave >> 2; float pwr[64];
#pragma unroll
            for (int c = 0; c < 64; ++c) pwr[c] = pw[gi * 4096 + c * 64 + lane];
            const float psc = pscale[gi * 64 + lane];
            for (int tt = 0; tt < 32; ++tt) { const int tl = th * 32 + tt; const f32x4* pp = (const f32x4*)(pooled + tl * 256 + gi * 64); float acc = 0.f;
#pragma unroll
                for (int c4 = 0; c4 < 16; ++c4) { const f32x4 v = pp[c4]; acc += v.x * pwr[4 * c4] + v.y * pwr[4 * c4 + 1] + v.z * pwr[4 * c4 + 2] + v.w * pwr[4 * c4 + 3]; }
                Y[((size_t)b * SEQ + t0 + tl) * 1024 + gi * 64 + lane] = (bf16)f2bf(acc * psc); } }
    }
    __syncthreads();
}

__device__ __forceinline__ void attn_phase(const Args& a, unsigned char* lds, int vcu, int G) {
    const int lane = ltid() & 63;
    const float s1 = wave_sum(a.in[16][lane] * a.in[17][lane]), s2 = wave_sum(a.in[18][lane] * a.in[19][lane]);
    const float lam = expf(s1) - expf(s2) + 0.2f;
    float mq = fabsf(a.in[14][lane]), mk = fabsf(a.in[15][lane]);
#pragma unroll
    for (int o = 1; o < 64; o <<= 1) { mq = fmaxf(mq, __shfl_xor(mq, o)); mk = fmaxf(mk, __shfl_xor(mk, o)); }
    const float Bq = 0.125f * 64.f * mq * mk * 1.02f;
    const bool fixed = Bq <= 20.f;
    const float mBC = -Bq * 1.4426950408889634f;
    const bf16* Q = (const bf16*)(a.ws + WS_Q); const bf16* KA = (const bf16*)(a.ws + WS_K); const bf16* VA = (const bf16*)(a.ws + WS_V); bf16* Y = (bf16*)(a.ws + WS_Y);
    const int per = 768 / G;
    for (int i = 0; i < per; ++i) { const int u = vcu * per + i, bh = u >> 5, qb = u & 31, b = bh / 6, h = bh - b * 6;
        const bf16* Qp = Q + ((size_t)b * SEQ + qb * 128) * 768 + h * 128; const bf16* Kp = KA + (size_t)b * TKV * 768 + h * 128; const bf16* Vp = VA + (size_t)b * TKV * 768 + h * 128;
        bf16* Yp = Y + ((size_t)b * SEQ + qb * 128) * 1024 + 256 + h * 128;
        if (fixed) att::attn_unit<true>(Qp, Kp, Vp, Yp, a.in[20], lam, mBC, (char*)lds);
        else       att::attn_unit<false>(Qp, Kp, Vp, Yp, a.in[20], lam, mBC, (char*)lds); }
}

__device__ __forceinline__ void spatial_phase(const Args& a, unsigned char* lds, int vcu, int G, bool probe = false) {
    const int tid = ltid(), lane = tid & 63, wave = tid >> 6, r32 = lane & 31, hi = lane >> 5;
    const bf16* VT = (const bf16*)(a.ws + WS_VT); bf16* U = (bf16*)(a.ws + WS_U);
    const float* lng = a.in[22]; const float* lnb = a.in[23]; const float* sgw = a.in[24]; const float* sgb = a.in[25];
    constexpr int TROW = 272;
    unsigned char* T = lds;
    float* red = (float*)lds;
    float* scr = (float*)(lds + 69632) + wave * (32 * 68);
    float* stats = (float*)(lds + 69632 + 69632);
    for (int un = vcu; un < 256; un += G) {
        const int chunk = un >> 1, half = un & 1; const size_t tok0 = (size_t)chunk * 128;
        __syncthreads();
        { const int slot = tid & 15, cg = tid >> 4; float s[8], q[8];
#pragma unroll
            for (int e = 0; e < 8; ++e) { s[e] = 0.f; q[e] = 0.f; }
#pragma unroll 8
            for (int i = 0; i < 64; ++i) { const int c = cg + 32 * i; const v4u w = *(const v4u*)(VT + (size_t)c * MTOK + tok0 + slot * 8);
                float x[8]; x[0] = bflo(w.x); x[1] = bfhi(w.x); x[2] = bflo(w.y); x[3] = bfhi(w.y); x[4] = bflo(w.z); x[5] = bfhi(w.z); x[6] = bflo(w.w); x[7] = bfhi(w.w);
#pragma unroll
                for (int e = 0; e < 8; ++e) { s[e] += x[e]; q[e] += x[e] * x[e]; } }
#pragma unroll
            for (int e = 0; e < 8; ++e) { red[(cg * 128 + slot * 8 + e) * 2] = s[e]; red[(cg * 128 + slot * 8 + e) * 2 + 1] = q[e]; } }
        __syncthreads();
        if (tid < 128) { float s = 0.f, q = 0.f;
            for (int cg = 0; cg < 32; ++cg) { s += red[(cg * 128 + tid) * 2]; q += red[(cg * 128 + tid) * 2 + 1]; }
            const float mean = s * (1.f / 2048.f), var = fmaxf(q * (1.f / 2048.f) - mean * mean, 0.f);
            stats[tid * 2] = mean; stats[tid * 2 + 1] = rsqrtf(var + 1e-6f); }
        __syncthreads();
        for (int gq = 0; gq < 4; ++gq) { const int g = half * 4 + gq;
            if (gq) __syncthreads();
            { const int slot = tid & 15, cr = tid >> 4; float mu[8], rs[8];
#pragma unroll
                for (int e = 0; e < 8; ++e) { mu[e] = stats[(slot * 8 + e) * 2]; rs[e] = stats[(slot * 8 + e) * 2 + 1]; }
#pragma unroll
                for (int i = 0; i < 8; ++i) { const int cl = cr + 32 * i, c = g * 256 + cl; const v4u w = *(const v4u*)(VT + (size_t)c * MTOK + tok0 + slot * 8);
                    const float lg = lng[c], lb = lnb[c];
                    float x[8]; x[0] = bflo(w.x); x[1] = bfhi(w.x); x[2] = bflo(w.y); x[3] = bfhi(w.y); x[4] = bflo(w.z); x[5] = bfhi(w.z); x[6] = bflo(w.w); x[7] = bfhi(w.w);
#pragma unroll
                    for (int e = 0; e < 8; ++e) x[e] = (x[e] - mu[e]) * rs[e] * lg + lb;
                    v4u o; o.x = pk2(x[0], x[1]); o.y = pk2(x[2], x[3]); o.z = pk2(x[4], x[5]); o.w = pk2(x[6], x[7]);
                    *(v4u*)(T + cl * TROW + slot * 16) = o; } }
            __syncthreads();
            const int mb = (wave & 3) * 32, ch = (wave >> 2) * 128;
            bf16x8 af[8];
            { const float* wrow = sgw + ((size_t)g * 128 + mb + r32) * 128 + hi * 8;
#pragma unroll
                for (int ks = 0; ks < 8; ++ks) { const f32x4 w0 = *(const f32x4*)(wrow + ks * 16), w1 = *(const f32x4*)(wrow + ks * 16 + 4);
                    v4u p; p.x = pk2(w0.x, w0.y); p.y = pk2(w0.z, w0.w); p.z = pk2(w1.x, w1.y); p.w = pk2(w1.z, w1.w); af[ks] = __builtin_bit_cast(bf16x8, p); } }
            f32x16 o[4];
#pragma unroll
            for (int d0 = 0; d0 < 4; ++d0) { o[d0] = f32x16{};
#pragma unroll
                for (int ks = 0; ks < 8; ++ks) { const bf16x8 bfr = *(const bf16x8*)(T + (ch + d0 * 32 + r32) * TROW + (16 * ks + 8 * hi) * 2);
                    o[d0] = __builtin_amdgcn_mfma_f32_32x32x16_bf16(af[ks], bfr, o[d0], 0, 0, 0); } }
            float bias[16];
#pragma unroll
            for (int r = 0; r < 16; ++r) bias[r] = sgb[g * 128 + mb + att::crow(r, hi)];
#pragma unroll
            for (int p = 0; p < 2; ++p) {
#pragma unroll
                for (int dd = 0; dd < 2; ++dd)
#pragma unroll
                    for (int r = 0; r < 16; ++r) scr[att::crow(r, hi) * 68 + dd * 32 + r32] = o[2 * p + dd][r] + bias[r];
                LDS_WAIT(); asm volatile("" ::: "memory");
                v4u uw[4];
#pragma unroll
                for (int qq = 0; qq < 4; ++qq) { const int row = (lane >> 3) + 8 * qq, c8 = (lane & 7) * 8; uw[qq] = *(const v4u*)(U + (tok0 + mb + row) * 2048 + g * 256 + ch + p * 64 + c8); }
#pragma unroll
                for (int qq = 0; qq < 4; ++qq) { const int row = (lane >> 3) + 8 * qq, c8 = (lane & 7) * 8;
                    const f32x4 m0 = *(const f32x4*)(scr + row * 68 + c8), m1 = *(const f32x4*)(scr + row * 68 + c8 + 4);
                    bf16* up = U + (tok0 + mb + row) * 2048 + g * 256 + ch + p * 64 + c8; const v4u w = uw[qq];
                    v4u ov; ov.x = pk2(bflo(w.x) * m0.x, bfhi(w.x) * m0.y); ov.y = pk2(bflo(w.y) * m0.z, bfhi(w.y) * m0.w);
                    ov.z = pk2(bflo(w.z) * m1.x, bfhi(w.z) * m1.y); ov.w = pk2(bflo(w.w) * m1.z, bfhi(w.w) * m1.w);
                    bf16* wp = up; if (probe) { const size_t tok = tok0 + mb + row; wp = (tok < 8192 ? (bf16*)(a.ws + 56 * MiB) + tok * 2048 : (bf16*)(a.ws + 220 * MiB) + (tok - 8192) * 2048) + g * 256 + ch + p * 64 + c8; }
                    *(v4u*)wp = ov; }
                LDS_WAIT(); asm volatile("" ::: "memory");
            }
        }
    }
}


#if MK_DEBUG
__device__ __forceinline__ float bfr(float f) { return __builtin_bit_cast(float, f2bf(f) << 16); }
__device__ __forceinline__ float bf2f(bf16 v) { return __builtin_bit_cast(float, (unsigned)v << 16); }
__device__ __forceinline__ void rec(float* res, int st, float got, float want) { float e = fabsf(got - want) / (fabsf(want) + 0.1f); if (!(e == e) || e > 1e30f) e = 0.77f; else e = fminf(e, 0.6f); atomicMax((unsigned*)res + st, __float_as_uint(e)); }
__device__ __forceinline__ unsigned hsh(unsigned s) { s ^= s >> 16; s *= 0x7feb352du; s ^= s >> 15; s *= 0x846ca68bu; s ^= s >> 16; return s; }
__global__ void chk_mod(Args a, float* res) {
    const int i = blockIdx.x * 256 + threadIdx.x; if (i >= 2 * 5 * 6144) return; const int l = i / (5 * 6144), r = (i / 6144) % 5, n = i % 6144;
    float s = 0.f; for (int k = 0; k < 1024; ++k) { const float c = r < 4 ? a.in[1][r * 1024 + k] : a.in[3][k]; s += (c / (1.f + expf(-c))) * a.in[4][((size_t)l * 1024 + k) * 6144 + n]; }
    s += a.in[5][l * 6144 + n]; rec(res, 0, ((const float*)(a.ws + WS_MOD))[i], s);
}
__global__ void chk_wt(const float* W, int K, int N, const bf16* WT, float* res, int st) {
    const unsigned h = hsh(blockIdx.x * 256 + threadIdx.x + 77u * st); const int k = h % K, n = (h >> 12) % N;
    rec(res, st, bf2f(WT[(size_t)n * K + k]), bfr(W[(size_t)k * N + n]));
}
__global__ void chk_norm(const float* src, const float* g, const float* modrow_sh, const float* modrow_sc, int bstride, const bf16* dst, int nrows, int rows_per_b, float* res, int st, int row_base = 0) {
    __shared__ float red[256]; const unsigned h = hsh(blockIdx.x + 1000u * st); const int row = row_base + h % nrows; const int b = rows_per_b ? row / rows_per_b : 0; const int t = threadIdx.x;
    float s = 0.f; for (int k = t; k < 1024; k += 256) { const float v = src[(size_t)row * 1024 + k]; s += v * v; } red[t] = s; __syncthreads();
    for (int o = 128; o > 0; o >>= 1) { if (t < o) red[t] += red[t + o]; __syncthreads(); }
    const float rstd = rsqrtf(red[0] / 1024.f + 1e-6f);
    for (int k = t; k < 1024; k += 256) { const float want = src[(size_t)row * 1024 + k] * rstd * g[k] * (1.f + modrow_sc[(size_t)b * bstride + k]) + modrow_sh[(size_t)b * bstride + k]; rec(res, st, bf2f(dst[(size_t)row * 1024 + k]), want); }
}
__device__ __forceinline__ float dotbf(const bf16* A, const bf16* B, int K) { float s = 0.f; for (int k = 0; k < K; ++k) s += bf2f(A[k]) * bf2f(B[k]); return s; }
__global__ void chk_gemm1(Args a, float* res) {
    const unsigned h = hsh(blockIdx.x * 256 + threadIdx.x); int row = h % 17408; int col = (h >> 15) % 2560;
    if (row >= 16384) { col = 1024 + (h >> 15) % 1536; }
    const bf16* XN = (const bf16*)(a.ws + WS_XN); const bf16* WT = (const bf16*)(a.ws + WS_WIN);
    const float want = dotbf(XN + (size_t)row * 1024, WT + (size_t)col * 1024, 1024); float got;
    if (row < 16384) { const int b = row >> 12, t = row & 4095; const size_t kv = (size_t)b * TKV + 256 + t;
        if (col < 256) got = bf2f(((const bf16*)(a.ws + WS_POOL))[(size_t)row * 256 + col]);
        else if (col < 1024) got = bf2f(((const bf16*)(a.ws + WS_Q))[(size_t)row * 768 + col - 256]);
        else if (col < 1792) got = bf2f(((const bf16*)(a.ws + WS_K))[kv * 768 + col - 1024]);
        else got = bf2f(((const bf16*)(a.ws + WS_V))[kv * 768 + col - 1792]);
    } else { const int rc = row - 16384, b = rc >> 8, j = rc & 255; const size_t kv = (size_t)b * TKV + j;
        if (col < 1792) got = bf2f(((const bf16*)(a.ws + WS_K))[kv * 768 + col - 1024]); else got = bf2f(((const bf16*)(a.ws + WS_V))[kv * 768 + col - 1792]); }
    rec(res, 3, got, want);
}
__global__ void chk_qk(Args a, float* res) {
    __shared__ float raw[64]; __shared__ float red[64]; const unsigned h = hsh(blockIdx.x + 4242u); const int d = threadIdx.x;
    int row = h % 17408; const int hg = (h >> 16) % 12; int isq = (h >> 24) & 1; if (row >= 16384) isq = 0;
    const bf16* XN = (const bf16*)(a.ws + WS_XN); const bf16* WT = (const bf16*)(a.ws + WS_WIN);
    const int col = (isq ? 256 : 1024) + hg * 64 + d;
    raw[d] = bfr(dotbf(XN + (size_t)row * 1024, WT + (size_t)col * 1024, 1024)); red[d] = raw[d] * raw[d]; __syncthreads();
    for (int o = 32; o > 0; o >>= 1) { if (d < o) red[d] += red[d + o]; __syncthreads(); }
    const float rstd = rsqrtf(red[0] / 64.f + 1e-6f); const float* gam = isq ? a.in[14] : a.in[15];
    float y = raw[d] * rstd * gam[d]; __syncthreads(); red[d] = y; __syncthreads();
    float want = y; size_t off;
    if (row < 16384) { const int t = row & 4095, pr = d >> 1; const float pos = (float)(pr < 16 ? (t >> 6) : (t & 63)); const float inv = powf(10000.f, -(float)(pr & 15) / 16.f); const float ang = pos * inv;
        const float cs = cosf(ang), sn = sinf(ang), x0 = red[2 * pr], x1 = red[2 * pr + 1]; want = (d & 1) ? x0 * sn + x1 * cs : x0 * cs - x1 * sn;
        off = isq ? (size_t)row * 768 + hg * 64 + d : ((size_t)(row >> 12) * TKV + 256 + t) * 768 + hg * 64 + d;
    } else { const int rc = row - 16384; off = ((size_t)(rc >> 8) * TKV + (rc & 255)) * 768 + hg * 64 + d; }
    const bf16* buf = isq ? (const bf16*)(a.ws + WS_Q) : (const bf16*)(a.ws + WS_K);
    rec(res, 4, bf2f(buf[off]), want);
}
__global__ void chk_pool(Args a, float* res) {
    const unsigned h = hsh(blockIdx.x * 256 + threadIdx.x + 999u); const int row = h % 16384, gi = (h >> 14) & 3, d = (h >> 16) & 63; const int b = row >> 12, t = row & 4095, hw = 1 << gi;
    const bf16* PI = (const bf16*)(a.ws + WS_POOL); const int lo = max(t - hw, 0), hi = min(t + hw, 4096); float acc = 0.f;
    for (int c = 0; c < 64; ++c) { float s = 0.f; for (int j = lo; j < hi; ++j) s += bf2f(PI[((size_t)b * 4096 + j) * 256 + gi * 64 + c]);
        const float pooled = s / (float)(hi - lo) - bf2f(PI[(size_t)row * 256 + gi * 64 + c]); acc += pooled * a.in[12][gi * 4096 + c * 64 + d]; }
    rec(res, 5, bf2f(((const bf16*)(a.ws + WS_Y))[(size_t)row * 1024 + gi * 64 + d]), acc * a.in[13][gi * 64 + d]);
}
__global__ void chk_attn(Args a, float* res) {
    __shared__ float s1[TKV], s2[TKV]; __shared__ float red[256]; __shared__ float ov[128];
    const unsigned hh = hsh(blockIdx.x + 31337u); const int row = hh % 16384, h = (hh >> 14) % 6, b = row >> 12, t = threadIdx.x;
    const bf16* Q = (const bf16*)(a.ws + WS_Q) + (size_t)row * 768 + h * 128; const bf16* KA = (const bf16*)(a.ws + WS_K) + (size_t)b * TKV * 768 + h * 128; const bf16* VA = (const bf16*)(a.ws + WS_V) + (size_t)b * TKV * 768 + h * 128;
    float l1 = 0.f, l2 = 0.f; for (int i = 0; i < 64; ++i) { l1 += a.in[16][i] * a.in[17][i]; l2 += a.in[18][i] * a.in[19][i]; } const float lam = expf(l1) - expf(l2) + 0.2f;
    for (int k = t; k < TKV; k += 256) { float x1 = 0.f, x2 = 0.f; for (int d = 0; d < 64; ++d) { x1 += bf2f(Q[d]) * bf2f(KA[(size_t)k * 768 + d]); x2 += bf2f(Q[64 + d]) * bf2f(KA[(size_t)k * 768 + 64 + d]); } s1[k] = x1 * 0.125f; s2[k] = x2 * 0.125f; }
    __syncthreads();
    float m1 = -1e30f, m2 = -1e30f; for (int k = t; k < TKV; k += 256) { m1 = fmaxf(m1, s1[k]); m2 = fmaxf(m2, s2[k]); }
    red[t] = m1; __syncthreads(); for (int o = 128; o > 0; o >>= 1) { if (t < o) red[t] = fmaxf(red[t], red[t + o]); __syncthreads(); } m1 = red[0]; __syncthreads();
    red[t] = m2; __syncthreads(); for (int o = 128; o > 0; o >>= 1) { if (t < o) red[t] = fmaxf(red[t], red[t + o]); __syncthreads(); } m2 = red[0]; __syncthreads();
    float z1 = 0.f, z2 = 0.f; for (int k = t; k < TKV; k += 256) { s1[k] = expf(s1[k] - m1); s2[k] = expf(s2[k] - m2); z1 += s1[k]; z2 += s2[k]; }
    red[t] = z1; __syncthreads(); for (int o = 128; o > 0; o >>= 1) { if (t < o) red[t] += red[t + o]; __syncthreads(); } z1 = red[0]; __syncthreads();
    red[t] = z2; __syncthreads(); for (int o = 128; o > 0; o >>= 1) { if (t < o) red[t] += red[t + o]; __syncthreads(); } z2 = red[0]; __syncthreads();
    if (t < 128) { float o = 0.f; for (int k = 0; k < TKV; ++k) o += (s1[k] / z1 - lam * s2[k] / z2) * bf2f(VA[(size_t)k * 768 + t]); ov[t] = o; red[t] = o * o; } else red[t] = 0.f;
    __syncthreads(); for (int o = 128; o > 0; o >>= 1) { if (t < o) red[t] += red[t + o]; __syncthreads(); }
    if (t < 128) { const float want = ov[t] * rsqrtf(red[0] / 128.f + 1e-6f) * a.in[20][t] * 0.8f; rec(res, 6, bf2f(((const bf16*)(a.ws + WS_Y))[(size_t)row * 1024 + 256 + h * 128 + t]), want); }
}
__global__ void chk_res(const bf16* A, const bf16* WT, int K, const float* basebuf, const float* gate, const float* out, float* res, int st, int nrows) {
    const unsigned h = hsh(blockIdx.x * 256 + threadIdx.x + 555u * st); const int row = h % nrows, col = (h >> 13) % 1024;
    const float want = basebuf[(size_t)row * 1024 + col] + gate[(size_t)(row >> 12) * 6144 + col] * dotbf(A + (size_t)row * K, WT + (size_t)col * K, K);
    rec(res, st, out[(size_t)row * 1024 + col], want);
}
__global__ void chk_act(const bf16* A, const bf16* WT, int K, int N, const bf16* O, int ldo, int act, int transposed, float* res, int st) {
    const unsigned h = hsh(blockIdx.x * 256 + threadIdx.x + 333u * st); const int row = h % 16384, col = (h >> 14) % N;
    float v = dotbf(A + (size_t)row * K, WT + (size_t)col * K, K); if (act == 2) { v = fmaxf(v, 0.f); v *= v; } else if (act == 1) v = 0.5f * v * (1.f + erff(v * 0.70710678f));
    rec(res, st, bf2f(transposed ? O[(size_t)col * ldo + row] : O[(size_t)row * ldo + col]), v);
}
__global__ void chk_copy(const float* src, float* dst, size_t n4) { for (size_t i = blockIdx.x * 256ull + threadIdx.x; i < n4; i += gridDim.x * 256ull) ((f32x4*)dst)[i] = ((const f32x4*)src)[i]; }
__global__ void chk_final(float* res, float* out, int nst) {
    for (int i = 0; i < nst; ++i) { const float e = res[i]; if (e > 0.08f) { float m = fminf(fmaxf(e * 10.f, 1.0f), 9.9f); float v = m; for (int j = 0; j < 4 + i; ++j) v *= 10.f; out[0] = v; return; } }
}
__global__ void simple_norm(const float* src, const float* g, const float* sh, const float* sc, int bstride, bf16* dst) {
    __shared__ float red[256]; const int row = blockIdx.x, b = row >> 12, t = threadIdx.x;
    float s = 0.f; for (int k = t; k < 1024; k += 256) { const float v = src[(size_t)row * 1024 + k]; s += v * v; } red[t] = s; __syncthreads();
    for (int o = 128; o > 0; o >>= 1) { if (t < o) red[t] += red[t + o]; __syncthreads(); }
    const float rstd = rsqrtf(red[0] / 1024.f + 1e-6f);
    for (int k = t; k < 1024; k += 256) dst[(size_t)row * 1024 + k] = (bf16)f2bf(src[(size_t)row * 1024 + k] * rstd * g[k] * (1.f + sc[(size_t)b * bstride + k]) + sh[(size_t)b * bstride + k]);
}
__global__ void chk_final2(float* res, float* out) { int mask = 0; for (int i = 0; i < 8; ++i) if (res[20 + i] < 0.08f) mask |= 1 << i; out[0] = (float)(mask + 1) * 1e6f; }
#endif

#define XB_TMO      128
#define XB_XCNT(j)  (256  + 64 * (j))
#define XB_XSUB(j)  (1280 + 64 * (j))
#define XB_XGEN(j)  (2304 + 64 * (j))
#define XB_TOP      3328
#define XB_TOPGEN   3392
#define XCD_BAR_WORDS 3456
#define XB_SPIN_CAP (1u << 18)

__device__ __forceinline__ unsigned xb_ld(unsigned* p)              { return __hip_atomic_load(p, __ATOMIC_RELAXED, __HIP_MEMORY_SCOPE_AGENT); }
__device__ __forceinline__ unsigned xb_add(unsigned* p, unsigned v) { return __hip_atomic_fetch_add(p, v, __ATOMIC_RELAXED, __HIP_MEMORY_SCOPE_AGENT); }
__device__ __forceinline__ unsigned xb_xcc_id() { return (unsigned)__builtin_amdgcn_s_getreg((3 << 11) | 20) & 0xFu; }
#define XB_SPIN(cond, bar) do { unsigned _sp = 0; while (cond) { __builtin_amdgcn_s_sleep(1); \
    if ((++_sp & 255u) == 0u) { if (xb_ld(&(bar)[XB_TMO])) break; if (_sp > XB_SPIN_CAP) { atomicAdd(&(bar)[XB_TMO], 1u); break; } } } } while (0)

struct XcdBarrier {
    unsigned* bar; unsigned x;
    volatile LAS unsigned* st;
};

__device__ __forceinline__ XcdBarrier xcd_barrier_post(unsigned* bar, volatile LAS unsigned* st) {
    XcdBarrier b; b.bar = bar; b.x = xb_xcc_id(); b.st = st;
    if (threadIdx.x == 0) (void)xb_add(&bar[XB_XCNT(b.x)], 1u);
    return b;
}
__device__ __forceinline__ void xcd_barrier_complete(unsigned* bar, unsigned x, unsigned& nloc, unsigned& nx) {
    const unsigned G = gridDim.x * gridDim.y * gridDim.z;
    unsigned sum, cnt, mine, sp = 0u;
    for (;;) {
        sum = 0u; cnt = 0u; mine = 0u;
#pragma unroll
        for (unsigned j = 0; j < 16; ++j) { const unsigned c = xb_ld(&bar[XB_XCNT(j)]); sum += c; cnt += (c > 0u) ? 1u : 0u; mine = (j == x) ? c : mine; }
        if (sum == G) break;
        __builtin_amdgcn_s_sleep(1);
        if ((++sp & 255u) == 0u) { if (xb_ld(&bar[XB_TMO])) break; if (sp > XB_SPIN_CAP) { atomicAdd(&bar[XB_TMO], 1u); break; } }
    }
    nloc = mine > 0u ? mine : 1u; nx = cnt > 0u ? cnt : 1u;
}

__device__ __forceinline__ void xcd_barrier(const XcdBarrier& b) {
    asm volatile("s_waitcnt vmcnt(0)" ::: "memory");
    __syncthreads();
    if (threadIdx.x == 0) {
        unsigned* bar = b.bar;
        __builtin_amdgcn_s_waitcnt(0);
        unsigned nloc = b.st[0], nx = b.st[1];
        if (nloc == 0u) { xcd_barrier_complete(bar, b.x, nloc, nx); b.st[0] = nloc; b.st[1] = nx; }
        const unsigned old = xb_add(&bar[XB_XSUB(b.x)], 1u);
        const unsigned gen = old / nloc;
        if (old + 1u == (gen + 1u) * nloc) {
            __builtin_amdgcn_fence(__ATOMIC_RELEASE, "agent");
            asm volatile("s_waitcnt vmcnt(0)" ::: "memory");
            const unsigned og = xb_add(&bar[XB_TOP], 1u);
            const unsigned tg = og / nx;
            if (og + 1u == (tg + 1u) * nx) xb_add(&bar[XB_TOPGEN], 1u);
            else XB_SPIN(xb_ld(&bar[XB_TOPGEN]) == tg, bar);
            __builtin_amdgcn_fence(__ATOMIC_ACQUIRE, "agent");
            xb_add(&bar[XB_XGEN(b.x)], 1u);
            asm volatile("s_waitcnt vmcnt(0)" ::: "memory");
        } else {
            XB_SPIN(xb_ld(&bar[XB_XGEN(b.x)]) == gen, bar);
            __builtin_amdgcn_fence(__ATOMIC_ACQUIRE, "agent");
            asm volatile("s_waitcnt vmcnt(0)" ::: "memory");
        }
    }
    __syncthreads();
}

template <int PH> __device__ __forceinline__ void run_phase(const Args& a, unsigned char* lds, int vcu, int G, int bx) {
    unsigned char* ws = a.ws;
    float* mod = (float*)(ws + WS_MOD);
    bf16* XN = (bf16*)(ws + WS_XN); bf16* XR = (bf16*)(ws + WS_XR);
    if constexpr (PH == 0) p0_prep(a, lds, vcu, G);
    else if constexpr (PH == 1)  norm_phase(a.in[0], a.in[6],        mod,            0,    1024, XN, a.in[2], vcu, G);
    else if constexpr (PH == 6)  norm_phase_h(XR, a.in[7],        mod,            3072, 4096, XN, vcu, G);
    else if constexpr (PH == 9)  norm_phase_h(XR, a.in[6] + 1024, mod + 5 * MODW, 0,    1024, XN, vcu, G);
    else if constexpr (PH == 13) norm_phase_h(XR, a.in[7] + 1024, mod + 5 * MODW, 3072, 4096, XN, vcu, G);
    else if constexpr (PH == 2) {
        pg8::Gemm g{XN, (const bf16*)(ws + WS_WIN), 17408, 2560, 1024}; pg8::OrderQKV S; S.init(G, bx);
        pg8::EpiRoute E{(bf16*)(ws + WS_POOL), (bf16*)(ws + WS_Q), (bf16*)(ws + WS_K), (bf16*)(ws + WS_V), a.in[14], a.in[15], (const float*)(ws + WS_ROPE)};
        pg8::gemm_phase<pg8::EpiRoute, pg8::OrderQKV, true, true>((LAS unsigned char*)lds, g, S, E);
    }
    else if constexpr (PH == 3) {}
    else if constexpr (PH == 4) { pool_phase(a, lds, vcu, G); attn_phase(a, lds, vcu, G);
#ifdef PROBE_ATT2
        attn_phase(a, lds, vcu, G);
#endif
    }
    else if constexpr (PH == 5 || PH == 8 || PH == 12 || PH == 15) {
        pg8::Gemm g; const float* gate; const float* bf = nullptr; const bf16* bh = XR; float* of = nullptr; bf16* oh = XR;
        if constexpr (PH == 5)       { g = pg8::Gemm{(const bf16*)(ws + WS_Y),  (const bf16*)(ws + WS_WOUT),  MTOK, 1024, 1024}; gate = mod + 2048; bf = a.in[0]; bh = nullptr; }
        else if constexpr (PH == 8)  { g = pg8::Gemm{(const bf16*)(ws + WS_HB), (const bf16*)(ws + WS_W2),    MTOK, 1024, 4096}; gate = mod + 5120; }
        else if constexpr (PH == 12) { g = pg8::Gemm{(const bf16*)(ws + WS_U),  (const bf16*)(ws + WS_ODOUT), MTOK, 1024, 2048}; gate = mod + 5 * MODW + 2048; }
        else                         { g = pg8::Gemm{(const bf16*)(ws + WS_HB), (const bf16*)(ws + WS_W2) + (size_t)1024 * 4096, MTOK, 1024, 4096}; gate = mod + 5 * MODW + 5120; of = a.out; oh = nullptr; }
        pg8::StaticOrder S; S.init(g.M, g.N, G, bx);
        constexpr int RM = (PH == 5) ? 0 : (PH == 15 ? 2 : 1);
        pg8::EpiRes<RM> E{bf, bh, of, oh, gate};
        pg8::gemm_phase<pg8::EpiRes<RM>, pg8::StaticOrder, true, true>((LAS unsigned char*)lds, g, S, E);
    }
    else if constexpr (PH == 7 || PH == 14) {
        pg8::Gemm g{XN, (const bf16*)(ws + WS_W1) + (PH == 14 ? (size_t)4096 * 1024 : 0), MTOK, FF, 1024}; pg8::EpiAct E{(bf16*)(ws + WS_HB), FF, 2};
        pg8::StaticOrder S; S.init(g.M, g.N, G, bx);
        pg8::gemm_phase<pg8::EpiAct, pg8::StaticOrder, true, true>((LAS unsigned char*)lds, g, S, E);
    }
    else if constexpr (PH == 10) {
        { pg8::Gemm g{XN, (const bf16*)(ws + WS_ODIN), MTOK, 2048, 1024}; pg8::EpiAct E{(bf16*)(ws + WS_U), 2048, 1};
          pg8::StaticOrder S; S.init(g.M, g.N, G, bx);
          pg8::gemm_phase<pg8::EpiAct, pg8::StaticOrder, true, true>((LAS unsigned char*)lds, g, S, E); }
        { pg8::Gemm g{(const bf16*)(ws + WS_ODIN) + (size_t)2048 * 1024, XN, 2048, MTOK, 1024}; pg8::EpiAct E{(bf16*)(ws + WS_VT), MTOK, 1};
          pg8::StaticOrder S; S.init(g.M, g.N, G, bx);
          pg8::gemm_phase<pg8::EpiAct, pg8::StaticOrder, true, true>((LAS unsigned char*)lds, g, S, E); }
    }
    else if constexpr (PH == 11) { spatial_phase(a, lds, vcu, G);
#ifdef PROBE_SP2
        spatial_phase(a, lds, vcu, G, true);
#endif
    }
}
constexpr int XBAR_LDS_OFF = LDS_BYTES - 64;
__global__ void __launch_bounds__(NTHR) fwd_megakernel(Args a) {
    extern __shared__ __attribute__((aligned(16))) unsigned char lds[];
    const int G = gridDim.x, bx = blockIdx.x;
    const int vcu = (G % 8 == 0) ? (bx % 8) * (G / 8) + bx / 8 : bx;
    volatile LAS unsigned* xst = (volatile LAS unsigned*)((LAS unsigned char*)lds + XBAR_LDS_OFF);
    if (threadIdx.x < 2) xst[threadIdx.x] = 0u;
    __syncthreads();
    XcdBarrier bar; bar.bar = (unsigned*)a.ws; bar.x = 0; bar.st = xst;
    const bool fused = (a.ph_hi - a.ph_lo) > 1;
    if (fused) bar = xcd_barrier_post((unsigned*)a.ws, xst);
    if (a.ph_hi > NPH) cg::this_grid().sync();
#define PHASE(k) if ((k) != 3 && a.ph_lo <= (k) && (k) < a.ph_hi) { run_phase<k>(a, lds, vcu, G, bx); if ((k) + 1 < a.ph_hi) { xcd_barrier(bar); PROBE_XB } }
    PHASE(0) PHASE(1) PHASE(2) PHASE(3) PHASE(4) PHASE(5) PHASE(6) PHASE(7) PHASE(8) PHASE(9) PHASE(10) PHASE(11) PHASE(12) PHASE(13) PHASE(14) PHASE(15)
#undef PHASE
}

extern "C" void kernel_launch(void* const* d_in, const int* in_sizes, int n_in, void* d_out, int out_size, void* d_ws, size_t ws_size, hipStream_t stream) {
    static int grid = 0;
    if (grid == 0) {
        if (n_in != 27 || in_sizes[0] != MTOK * DM || out_size != MTOK * DM || ws_size < WS_END) { fprintf(stderr, "kernel_launch: unexpected shapes (n_in %d, in0 %d, out %d, ws %zu)\n", n_in, n_in > 0 ? in_sizes[0] : -1, out_size, ws_size); grid = -1; return; }
        if (hipFuncSetAttribute((const void*)fwd_megakernel, hipFuncAttributeMaxDynamicSharedMemorySize, LDS_BYTES) != hipSuccess) { fprintf(stderr, "kernel_launch: hipFuncSetAttribute failed\n"); grid = -1; return; }
        int dev = 0, cus = 0, per_cu = 0;
        (void)hipGetDevice(&dev); (void)hipDeviceGetAttribute(&cus, hipDeviceAttributeMultiprocessorCount, dev);
        (void)hipOccupancyMaxActiveBlocksPerMultiprocessor(&per_cu, (const void*)fwd_megakernel, NTHR, LDS_BYTES);
        if (per_cu < 1 || cus < 256) fprintf(stderr, "kernel_launch: note: occupancy query %d blocks/CU, %d CUs\n", per_cu, cus);
        (void)hipGetLastError();
        grid = 256;
    }
    if (grid < 0) return;
    Args a{};
    for (int i = 0; i < 27; ++i) a.in[i] = (const float*)d_in[i];
    a.out = (float*)d_out; a.ws = (unsigned char*)d_ws;
#if MK_MULTI
#if MK_DEBUG
    float* res = (float*)d_ws; (void)hipMemsetAsync(res, 0, 256, stream);
    unsigned char* ws = (unsigned char*)d_ws; float* mod = (float*)(ws + WS_MOD); float* snap = (float*)(ws + 220 * MiB);
#endif
    for (int ph = 0; ph < NPH_RUN; ++ph) { a.ph_lo = ph; a.ph_hi = ph + 1;
#if MK_DEBUG
        if (ph == 8 || ph == 12 || ph == 15) hipLaunchKernelGGL(chk_copy, dim3(2048), dim3(256), 0, stream, (const float*)d_out, snap, (size_t)8192 * 1024 / 4);
#endif
#if MK_DEBUG
        if (ph == 6 && MK_SIMPLE6) hipLaunchKernelGGL(simple_norm, dim3(16384), dim3(256), 0, stream, (const float*)d_out, a.in[7], (const float*)(mod + 3072), (const float*)(mod + 4096), 6144, (bf16*)(ws + WS_XN)); else
#endif
        hipLaunchKernelGGL(fwd_megakernel, dim3(grid), dim3(NTHR), LDS_BYTES, stream, a);
#if MK_DEBUG
        if (ph == 0) { hipLaunchKernelGGL(chk_mod, dim3(240), dim3(256), 0, stream, a, res);
            hipLaunchKernelGGL(chk_wt, dim3(16), dim3(256), 0, stream, a.in[10], 1024, 2560, (const bf16*)(ws + WS_WIN), res, 1);
            hipLaunchKernelGGL(chk_wt, dim3(16), dim3(256), 0, stream, a.in[11], 1024, 1024, (const bf16*)(ws + WS_WOUT), res, 1);
            hipLaunchKernelGGL(chk_wt, dim3(16), dim3(256), 0, stream, a.in[8], 1024, 4096, (const bf16*)(ws + WS_W1), res, 1);
            hipLaunchKernelGGL(chk_wt, dim3(16), dim3(256), 0, stream, a.in[8] + 1024 * 4096, 1024, 4096, (const bf16*)(ws + WS_W1) + 4096 * 1024, res, 1);
            hipLaunchKernelGGL(chk_wt, dim3(16), dim3(256), 0, stream, a.in[9], 4096, 1024, (const bf16*)(ws + WS_W2), res, 1);
            hipLaunchKernelGGL(chk_wt, dim3(16), dim3(256), 0, stream, a.in[9] + 1024 * 4096, 4096, 1024, (const bf16*)(ws + WS_W2) + 4096 * 1024, res, 1);
            hipLaunchKernelGGL(chk_wt, dim3(16), dim3(256), 0, stream, a.in[21], 1024, 4096, (const bf16*)(ws + WS_ODIN), res, 1);
            hipLaunchKernelGGL(chk_wt, dim3(16), dim3(256), 0, stream, a.in[26], 2048, 1024, (const bf16*)(ws + WS_ODOUT), res, 1); }
        if (ph == 1) { hipLaunchKernelGGL(chk_norm, dim3(128), dim3(256), 0, stream, a.in[0], a.in[6], (const float*)mod, (const float*)(mod + 1024), 6144, (const bf16*)(ws + WS_XN), 16384, 4096, res, 2);
            hipLaunchKernelGGL(chk_norm, dim3(64), dim3(256), 0, stream, a.in[2], a.in[6], (const float*)(mod + 4 * 6144), (const float*)(mod + 4 * 6144 + 1024), 0, (const bf16*)(ws + WS_XN) + (size_t)16384 * 1024, 1024, 0, res, 2); }
        if (ph == 2) hipLaunchKernelGGL(chk_gemm1, dim3(32), dim3(256), 0, stream, a, res);
        if (ph == 3) { hipLaunchKernelGGL(chk_qk, dim3(512), dim3(64), 0, stream, a, res); hipLaunchKernelGGL(chk_pool, dim3(16), dim3(256), 0, stream, a, res); }
        if (ph == 4) hipLaunchKernelGGL(chk_attn, dim3(96), dim3(256), 0, stream, a, res);
        if (ph == 5) hipLaunchKernelGGL(chk_res, dim3(16), dim3(256), 0, stream, (const bf16*)(ws + WS_Y), (const bf16*)(ws + WS_WOUT), 1024, a.in[0], (const float*)(mod + 2048), (const float*)d_out, res, 7, 16384);
        if (ph == 6) hipLaunchKernelGGL(chk_norm, dim3(128), dim3(256), 0, stream, (const float*)d_out, a.in[7], (const float*)(mod + 3072), (const float*)(mod + 4096), 6144, (const bf16*)(ws + WS_XN), 16384, 4096, res, 8);
        if (ph == 7) hipLaunchKernelGGL(chk_act, dim3(16), dim3(256), 0, stream, (const bf16*)(ws + WS_XN), (const bf16*)(ws + WS_W1), 1024, 4096, (const bf16*)(ws + WS_HB), 4096, 2, 0, res, 9);
        if (ph == 8) hipLaunchKernelGGL(chk_res, dim3(16), dim3(256), 0, stream, (const bf16*)(ws + WS_HB), (const bf16*)(ws + WS_W2), 4096, (const float*)snap, (const float*)(mod + 5120), (const float*)d_out, res, 10, 8192);
        if (ph == 9) hipLaunchKernelGGL(chk_norm, dim3(128), dim3(256), 0, stream, (const float*)d_out, a.in[6] + 1024, (const float*)(mod + 5 * 6144), (const float*)(mod + 5 * 6144 + 1024), 6144, (const bf16*)(ws + WS_XN), 16384, 4096, res, 11);
        if (ph == 10) { hipLaunchKernelGGL(chk_act, dim3(16), dim3(256), 0, stream, (const bf16*)(ws + WS_XN), (const bf16*)(ws + WS_ODIN), 1024, 2048, (const bf16*)(ws + WS_U), 2048, 1, 0, res, 12);
            hipLaunchKernelGGL(chk_act, dim3(16), dim3(256), 0, stream, (const bf16*)(ws + WS_XN), (const bf16*)(ws + WS_ODIN) + (size_t)2048 * 1024, 1024, 2048, (const bf16*)(ws + WS_VT), 16384, 1, 1, res, 13); }
#endif
    }
#if MK_DEBUG
    if (NPH_RUN == 16) hipLaunchKernelGGL(chk_final, dim3(1), dim3(1), 0, stream, res, (float*)d_out, 14);
#endif
#else
    a.ph_lo = 0; a.ph_hi = NPH;
    if (hipMemsetAsync(d_ws, 0, 16384, stream) != hipSuccess) { fprintf(stderr, "kernel_launch: memset of the barrier words failed\n"); return; }
    void* args[] = {&a};
    hipError_t e = hipLaunchCooperativeKernel((const void*)fwd_megakernel, dim3(grid), dim3(NTHR), args, LDS_BYTES, stream);
    if (e != hipSuccess) fprintf(stderr, "kernel_launch: cooperative launch failed: %s\n", hipGetErrorString(e));
#endif
}
```

```cpp
#include <hip/hip_runtime.h>
#include <hip/hip_cooperative_groups.h>
#include <cstdio>
#include <cstdint>
namespace cg = cooperative_groups;
__device__ __forceinline__ int ltid() { int t = threadIdx.x; asm volatile("" : "+v"(t)); return t; }
namespace pg8 {
#define PG8_LAS __attribute__((address_space(3)))
typedef unsigned short bf16_t;
typedef short bf16x8 __attribute__((ext_vector_type(8)));
typedef float f32x4 __attribute__((ext_vector_type(4)));
typedef unsigned u32x4 __attribute__((ext_vector_type(4)));
constexpr int BM = 256, BK = 64, HALF = 128, HTB = HALF * BK * 2  , STAGE_BYTES = 8 * HTB, NXCD = 8, WGM = 8;

__host__ __device__ __forceinline__ int lds_byte(int r, int c) { const int st = (r >> 4) * 2 + (c >> 5), rr = r & 15, cc = c & 31, ob = rr * 64 + cc * 2; return st * 1024 + (ob ^ (((ob >> 9) & 1) << 5)); }
__host__ __device__ __forceinline__ void stage_rc(int b, int& R, int& C) { const int st = b / 1024, sb = b % 1024, swz = sb ^ (((sb >> 9) & 1) << 5); R = (st >> 1) * 16 + swz / 64; C = (st & 1) * 32 + (swz % 64) / 2; }
__host__ __device__ __forceinline__ int perm32(int rho) { const int n = rho >> 4, i = rho & 15; return 8 * (i >> 2) + 4 * n + (i & 3); }

struct Unit { int pm, pn; };
struct Gemm { const bf16_t* A; const bf16_t* Bt; int M, N, K; };

struct StaticOrder {
    int nM, nN, nwg, G, c;
    __host__ __device__ void init(int M, int N, int G_, int c_) { nM = M / BM; nN = N / BM; nwg = nM * nN; G = G_; c = c_; }
    __host__ __device__ bool next(int i, Unit& u) const {
        const long L = (long)i * G + c; if (L >= nwg) return false;
        int wgid = (int)L; { const int q = nwg / NXCD, r = nwg % NXCD, xcd = wgid % NXCD, off = wgid / NXCD; wgid = (xcd < r ? xcd * (q + 1) : r * (q + 1) + (xcd - r) * q) + off; }
        const int nig = WGM * nN, gid = wgid / nig, fm = gid * WGM, gsz = (nM - fm) < WGM ? (nM - fm) : WGM;
        u.pm = fm + ((wgid % nig) % gsz); u.pn = (wgid % nig) / gsz; return true;
    }
    __device__ __forceinline__ void a_ready(const Unit&) const {}
    __device__ __forceinline__ void done(const Unit&) const {}
};

__device__ __forceinline__ unsigned cvt_pk_bf16(float lo, float hi) { unsigned r; asm volatile("v_cvt_pk_bf16_f32 %0, %1, %2" : "=v"(r) : "v"(lo), "v"(hi)); return r; }
typedef float f32x2 __attribute__((ext_vector_type(2)));
__device__ __forceinline__ f32x2 gelu_pk(f32x2 v) {
    const f32x2 av = __builtin_elementwise_abs(v), d = av * 0.2316418882f + 1.0f;
    f32x2 t; t.x = __builtin_amdgcn_rcpf(d.x); t.y = __builtin_amdgcn_rcpf(d.y);
    f32x2 q = t * 0.5307027145f + (-0.7265760135f); q = q * t + 0.7107068705f; q = q * t + (-0.142248368f); q = q * t + 0.127414796f; q = q * t;
    const f32x2 s = (v * v) * (-0.72134752044f);
    f32x2 e; e.x = __builtin_amdgcn_exp2f(s.x); e.y = __builtin_amdgcn_exp2f(s.y);
    const f32x2 m = v * (q * e), r = v - m;
    f32x2 o; o.x = v.x < 0.f ? m.x : r.x; o.y = v.y < 0.f ? m.y : r.y; return o;
}


template <bool STATS> struct EpiAct {
    static constexpr bool PERM = true, AFTER_DRAIN = false;
    bf16_t* O; int ldc; int act; float* part;
    __device__ __forceinline__ void operator()(const f32x4 (&acc)[2][2][4][2], const Unit& u, int wr, int wc, int fr, int fq) const {
        const int row0 = u.pm * BM + wr * 64 + fr; const int col0 = u.pn * BM + wc * 32 + 8 * fq;
        f32x4 cs[2][2], cq[2][2];
        if constexpr (STATS) {
#pragma unroll
            for (int bj = 0; bj < 2; ++bj)
#pragma unroll
                for (int n = 0; n < 2; ++n) { cs[bj][n] = (f32x4){0.f, 0.f, 0.f, 0.f}; cq[bj][n] = (f32x4){0.f, 0.f, 0.f, 0.f}; } }
#pragma unroll
        for (int ai = 0; ai < 2; ++ai)
#pragma unroll
            for (int m = 0; m < 4; ++m) { bf16_t* rowp = O + (size_t)(row0 + ai * HALF + m * 16) * ldc + col0;
#pragma unroll
                for (int bj = 0; bj < 2; ++bj) { f32x4 v0 = acc[ai][bj][m][0], v1 = acc[ai][bj][m][1];
                    if (act == 1) { f32x2 a = gelu_pk((f32x2){v0[0], v0[1]}), b = gelu_pk((f32x2){v0[2], v0[3]}), c = gelu_pk((f32x2){v1[0], v1[1]}), d = gelu_pk((f32x2){v1[2], v1[3]});
                        v0 = (f32x4){a.x, a.y, b.x, b.y}; v1 = (f32x4){c.x, c.y, d.x, d.y}; }
                    else if (act == 2) {
#pragma unroll
                        for (int e = 0; e < 4; ++e) { const float a = fmaxf(v0[e], 0.f), b = fmaxf(v1[e], 0.f); v0[e] = a * a; v1[e] = b * b; } }
                    if constexpr (STATS) { cs[bj][0] += v0; cs[bj][1] += v1; cq[bj][0] += v0 * v0; cq[bj][1] += v1 * v1; }
                    u32x4 w; w.x = cvt_pk_bf16(v0[0], v0[1]); w.y = cvt_pk_bf16(v0[2], v0[3]); w.z = cvt_pk_bf16(v1[0], v1[1]); w.w = cvt_pk_bf16(v1[2], v1[3]);
                    *(u32x4*)(rowp + bj * HALF) = w; } }
        if constexpr (STATS) {
#pragma unroll
            for (int bj = 0; bj < 2; ++bj)
#pragma unroll
                for (int n = 0; n < 2; ++n)
#pragma unroll
                    for (int e = 0; e < 4; ++e) { float a = cs[bj][n][e], b = cq[bj][n][e];
#pragma unroll
                        for (int o = 1; o < 16; o <<= 1) { a += __shfl_xor(a, o); b += __shfl_xor(b, o); }
                        cs[bj][n][e] = a; cq[bj][n][e] = b; }
            if (fr == 0) { float* pp = part + ((size_t)(2 * u.pm + wr) * 16384 + col0) * 2;
#pragma unroll
                for (int bj = 0; bj < 2; ++bj)
#pragma unroll
                    for (int n = 0; n < 2; ++n) { *(f32x4*)(pp + (bj * HALF + 4 * n) * 2) = (f32x4){cs[bj][n][0], cq[bj][n][0], cs[bj][n][1], cq[bj][n][1]};
                        *(f32x4*)(pp + (bj * HALF + 4 * n) * 2 + 4) = (f32x4){cs[bj][n][2], cq[bj][n][2], cs[bj][n][3], cq[bj][n][3]}; } }
        }
    }
};
struct EpiRoute {
    static constexpr bool PERM = true, AFTER_DRAIN = false;
    bf16_t *pool, *q, *k, *v;
    const float *qg, *kg; const float* rope;
    __device__ __forceinline__ void operator()(const f32x4 (&acc)[2][2][4][2], const Unit& u, int wr, int wc, int fr, int fq) const {
        const int pm = u.pm, pn = u.pn; bf16_t* base; int ld, colt; long rowbase;
        if (pm < 64) { const int b = pm >> 4; const long lat = (long)pm * 256, kvrow = (long)b * 4352 + 256 + (pm & 15) * 256;
            if (pn == 0)     { base = pool; ld = 256; colt = 0;              rowbase = lat; }
            else if (pn < 4) { base = q;    ld = 768; colt = (pn - 1) * 256; rowbase = lat; }
            else if (pn < 7) { base = k;    ld = 768; colt = (pn - 4) * 256; rowbase = kvrow; }
            else             { base = v;    ld = 768; colt = (pn - 7) * 256; rowbase = kvrow; }
        } else { const int b = pm - 64; rowbase = (long)b * 4352; ld = 768;
            if (pn < 7) { base = k; colt = (pn - 4) * 256; } else { base = v; colt = (pn - 7) * 256; } }
        const long row0 = rowbase + wr * 64 + fr;
        if (pn >= 1 && pn <= 6) {
            const float* gam = pn < 4 ? qg : kg; const bool rope_on = pm < 64; const int col0 = colt + 64 * wc + 8 * fq;
            f32x4 gm[2][2];
#pragma unroll
            for (int bj = 0; bj < 2; ++bj)
#pragma unroll
                for (int n = 0; n < 2; ++n) gm[bj][n] = *(const f32x4*)(gam + 32 * bj + 8 * fq + 4 * n);
#pragma unroll
            for (int ai = 0; ai < 2; ++ai)
#pragma unroll
                for (int m = 0; m < 4; ++m) { const int rl = wr * 64 + ai * HALF + m * 16 + fr; const int t = (pm & 15) * 256 + rl;
                    float ss = 0.f;
#pragma unroll
                    for (int bj = 0; bj < 2; ++bj)
#pragma unroll
                        for (int n = 0; n < 2; ++n) { const f32x4 x = acc[ai][bj][m][n]; ss += (x[0] * x[0] + x[1] * x[1]) + (x[2] * x[2] + x[3] * x[3]); }
                    ss += __shfl_xor(ss, 16); ss += __shfl_xor(ss, 32);
                    const float rstd = __builtin_amdgcn_rsqf(ss * (1.f / 64.f) + 1e-6f);
                    bf16_t* rowp = base + (size_t)(row0 + ai * HALF + m * 16) * ld + col0;
#pragma unroll
                    for (int bj = 0; bj < 2; ++bj) { f32x4 y0 = acc[ai][bj][m][0] * rstd * gm[bj][0], y1 = acc[ai][bj][m][1] * rstd * gm[bj][1];
                        if (rope_on) { const int pos = bj == 0 ? (t >> 6) : (t & 63); const float* tp = rope + (pos * 16 + 4 * fq) * 2;
                            const f32x4 c01 = *(const f32x4*)tp, c23 = *(const f32x4*)(tp + 4);
                            y0 = (f32x4){y0[0] * c01[0] - y0[1] * c01[1], y0[0] * c01[1] + y0[1] * c01[0], y0[2] * c01[2] - y0[3] * c01[3], y0[2] * c01[3] + y0[3] * c01[2]};
                            y1 = (f32x4){y1[0] * c23[0] - y1[1] * c23[1], y1[0] * c23[1] + y1[1] * c23[0], y1[2] * c23[2] - y1[3] * c23[3], y1[2] * c23[3] + y1[3] * c23[2]}; }
                        u32x4 w; w.x = cvt_pk_bf16(y0[0], y0[1]); w.y = cvt_pk_bf16(y0[2], y0[3]); w.z = cvt_pk_bf16(y1[0], y1[1]); w.w = cvt_pk_bf16(y1[2], y1[3]);
                        *(u32x4*)(rowp + 32 * bj) = w; } }
            return;
        }
        const int col0 = colt + wc * 32 + 8 * fq;
#pragma unroll
        for (int ai = 0; ai < 2; ++ai)
#pragma unroll
            for (int m = 0; m < 4; ++m) { bf16_t* rowp = base + (size_t)(row0 + ai * HALF + m * 16) * ld + col0;
#pragma unroll
                for (int bj = 0; bj < 2; ++bj) { const f32x4 v0 = acc[ai][bj][m][0], v1 = acc[ai][bj][m][1];
                    u32x4 w; w.x = cvt_pk_bf16(v0[0], v0[1]); w.y = cvt_pk_bf16(v0[2], v0[3]); w.z = cvt_pk_bf16(v1[0], v1[1]); w.w = cvt_pk_bf16(v1[2], v1[3]);
                    *(u32x4*)(rowp + bj * HALF) = w; } }
    }
};
template <int MODE  > struct EpiRes {
    static constexpr bool PERM = true, AFTER_DRAIN = false;
    const float* base_f; const bf16_t* base_h; float* out_f; bf16_t* out_h; const float* gate;
    __device__ __forceinline__ void operator()(const f32x4 (&acc)[2][2][4][2], const Unit& u, int wr, int wc, int fr, int fq) const {
        const int col0 = u.pn * BM + wc * 32 + 8 * fq; const float* gp = gate + (size_t)(u.pm >> 4) * 6144 + col0;
        f32x4 gv[2][2];
#pragma unroll
        for (int bj = 0; bj < 2; ++bj)
#pragma unroll
            for (int n = 0; n < 2; ++n) gv[bj][n] = *(const f32x4*)(gp + bj * HALF + 4 * n);
#pragma unroll
        for (int ai = 0; ai < 2; ++ai)
#pragma unroll
            for (int m = 0; m < 4; ++m) { const size_t off = (size_t)(u.pm * BM + ai * HALF + wr * 64 + m * 16 + fr) * 1024 + col0;
#pragma unroll
                for (int bj = 0; bj < 2; ++bj) { f32x4 b0, b1;
                    if constexpr (MODE == 0) { b0 = *(const f32x4*)(base_f + off + bj * HALF); b1 = *(const f32x4*)(base_f + off + bj * HALF + 4); }
                    else { const u32x4 w = *(const u32x4*)(base_h + off + bj * HALF);
                        b0 = (f32x4){__builtin_bit_cast(float, w.x << 16), __builtin_bit_cast(float, w.x & 0xffff0000u), __builtin_bit_cast(float, w.y << 16), __builtin_bit_cast(float, w.y & 0xffff0000u)};
                        b1 = (f32x4){__builtin_bit_cast(float, w.z << 16), __builtin_bit_cast(float, w.z & 0xffff0000u), __builtin_bit_cast(float, w.w << 16), __builtin_bit_cast(float, w.w & 0xffff0000u)}; }
                    const f32x4 o0 = b0 + gv[bj][0] * acc[ai][bj][m][0], o1 = b1 + gv[bj][1] * acc[ai][bj][m][1];
                    if constexpr (MODE == 2) { *(f32x4*)(out_f + off + bj * HALF) = o0; *(f32x4*)(out_f + off + bj * HALF + 4) = o1; }
                    else { u32x4 w; w.x = cvt_pk_bf16(o0[0], o0[1]); w.y = cvt_pk_bf16(o0[2], o0[3]); w.z = cvt_pk_bf16(o1[0], o1[1]); w.w = cvt_pk_bf16(o1[2], o1[3]); *(u32x4*)(out_h + off + bj * HALF) = w; } }
                if (m & 1) asm volatile("" ::: "memory"); }
    }
};
struct OrderQKV {
    StaticOrder so;
    __host__ __device__ void init(int G_, int c_) { so.init(16384, 2560, G_, c_); }
    __host__ __device__ bool next(int i, Unit& u) const {
        const long L = (long)i * so.G + so.c; if (L < so.nwg) return so.next(i, u);
        const int e = (int)(L - so.nwg); if (e >= 24) return false; u.pm = 64 + e / 6; u.pn = 4 + e % 6; return true; }
    __device__ __forceinline__ void a_ready(const Unit&) const {}
    __device__ __forceinline__ void done(const Unit&) const {}
};

template <class Epi, class Sched, bool ALIGN_EPI = false, bool SP2 = false>
__device__ __forceinline__ void gemm_phase(PG8_LAS unsigned char* lds, const Gemm g, const Sched& S, const Epi& E) {
    const int tid = ltid(), wid = __builtin_amdgcn_readfirstlane(tid >> 6), lane = tid & 63, wr = wid >> 2, wc = wid & 3, fr = lane & 15, fq = lane >> 4;
    const int K = g.K, nt = K / BK;
    unsigned voffA[2], voffB[2];
#pragma unroll
    for (int i = 0; i < 2; ++i) { int R, C; stage_rc(tid * 16 + i * 8192, R, C); const int Rb = Epi::PERM ? ((R & ~31) + perm32(R & 31)) : R;
        voffA[i] = (unsigned)(R * K + C) * 2u; voffB[i] = (unsigned)(Rb * K + C) * 2u; }
    const size_t kstep = (size_t)(BK * 2);
    const size_t hstep = (size_t)HALF * K * 2;
    const size_t tstep = 2 * hstep;
    const unsigned ldsw = (unsigned)wid * 1024u;
    const int aoff = lds_byte(wr * 64 + fr, fq * 8), boff = lds_byte(wc * 32 + fr, fq * 8);
#define PG8_SA(b, h) (((b) * 2 + (h)) * HTB)
#define PG8_SB(b, h) ((4 + (b) * 2 + (h)) * HTB)
#define PG8_STAGE(bufoff, gbase, voff) do { _Pragma("unroll") for (int _i = 0; _i < 2; ++_i) \
        __builtin_amdgcn_global_load_lds((const unsigned*)((const char*)(gbase) + (voff)[_i]), (PG8_LAS unsigned*)(lds + (bufoff) + ldsw + _i * 8192), 16, 0, 0); } while (0)
#define PG8_LDA(dst, b, h) do { _Pragma("unroll") for (int m = 0; m < 4; ++m) _Pragma("unroll") for (int k = 0; k < 2; ++k) dst[m][k] = *(const PG8_LAS bf16x8*)(lds + PG8_SA(b, h) + aoff + m * 2048 + k * 1024); } while (0)
#define PG8_LDB(dst, b, h) do { _Pragma("unroll") for (int n = 0; n < 2; ++n) _Pragma("unroll") for (int k = 0; k < 2; ++k) dst[n][k] = *(const PG8_LAS bf16x8*)(lds + PG8_SB(b, h) + boff + n * 2048 + k * 1024); } while (0)
#define PG8_MMA(ai, bj, At, Bt) do { __builtin_amdgcn_s_setprio(1); _Pragma("unroll") for (int m = 0; m < 4; ++m) _Pragma("unroll") for (int n = 0; n < 2; ++n) _Pragma("unroll") for (int k = 0; k < 2; ++k) \
        acc[ai][bj][m][n] = __builtin_amdgcn_mfma_f32_16x16x32_bf16(Bt[n][k], At[m][k], acc[ai][bj][m][n], 0, 0, 0); __builtin_amdgcn_s_setprio(0); } while (0)
#define PG8_WAIT_V(n) asm volatile("s_waitcnt vmcnt(" #n ")" ::: "memory")
#define PG8_WAIT_L(n) asm volatile("s_waitcnt lgkmcnt(" #n ")" ::: "memory")
#define PG8_BAR __builtin_amdgcn_s_barrier()
#define PG8_SCHED __builtin_amdgcn_sched_barrier(0)
    Unit cur, nxt; int ui = 0;
    if (!S.next(0, cur)) return;
    f32x4 acc[2][2][4][2];
#pragma unroll
    for (int a = 0; a < 2; ++a)
#pragma unroll
        for (int b = 0; b < 2; ++b)
#pragma unroll
            for (int m = 0; m < 4; ++m)
#pragma unroll
                for (int n = 0; n < 2; ++n) acc[a][b][m][n] = (f32x4){0.f, 0.f, 0.f, 0.f};
    bf16x8 At[4][2], B0[2][2], B1[2][2];
    const char* cA = (const char*)g.A + (size_t)cur.pm * tstep; const char* cB = (const char*)g.Bt + (size_t)cur.pn * tstep;
    S.a_ready(cur);
    if constexpr (SP2) {
        PG8_STAGE(PG8_SB(0, 0), cB, voffB); PG8_STAGE(PG8_SB(0, 1), cB + hstep, voffB); PG8_STAGE(PG8_SA(0, 0), cA, voffA); PG8_STAGE(PG8_SA(0, 1), cA + hstep, voffA);
        if (wr == 1) PG8_BAR;
        PG8_WAIT_V(2); PG8_BAR;
        PG8_STAGE(PG8_SB(1, 0), cB + kstep, voffB); PG8_STAGE(PG8_SA(1, 0), cA + kstep, voffA); PG8_STAGE(PG8_SB(1, 1), cB + hstep + kstep, voffB);
        PG8_WAIT_V(6); PG8_BAR;
    } else {
        PG8_STAGE(PG8_SB(0, 0), cB, voffB); PG8_STAGE(PG8_SA(0, 0), cA, voffA); PG8_STAGE(PG8_SB(0, 1), cB + hstep, voffB); PG8_STAGE(PG8_SA(0, 1), cA + hstep, voffA);
        if (wr == 1) PG8_BAR;
        PG8_WAIT_V(4); PG8_BAR;
        PG8_STAGE(PG8_SB(1, 0), cB + kstep, voffB); PG8_STAGE(PG8_SA(1, 0), cA + kstep, voffA); PG8_STAGE(PG8_SB(1, 1), cB + hstep + kstep, voffB);
        PG8_WAIT_V(6); PG8_BAR;
    }
    for (;;) {
        const bool has_next = S.next(ui + 1, nxt);
        const char* nA = has_next ? (const char*)g.A + (size_t)nxt.pm * tstep : cA; const char* nB = has_next ? (const char*)g.Bt + (size_t)nxt.pn * tstep : cB;
        for (int t = 0; t < nt; t += 2) {
            const bool last = (t == nt - 2);
            const char* a1 = cA + (size_t)(t + 1) * kstep;
            const char* a2 = last ? nA : cA + (size_t)(t + 2) * kstep; const char* b2 = last ? nB : cB + (size_t)(t + 2) * kstep;
            const char* a3 = a2 + kstep; const char* b3 = b2 + kstep;
            if (last && has_next) S.a_ready(nxt);
            if constexpr (SP2) {
            PG8_LDB(B0, 0, 0); PG8_LDB(B1, 0, 1); PG8_SCHED; PG8_LDA(At, 0, 0); PG8_STAGE(PG8_SA(1, 1), a1 + hstep, voffA);
            PG8_WAIT_V(8); PG8_WAIT_L(0); PG8_BAR; PG8_MMA(0, 0, At, B0); PG8_MMA(0, 1, At, B1); PG8_BAR; PG8_SCHED;
            PG8_LDA(At, 0, 1); PG8_STAGE(PG8_SB(0, 0), b2, voffB); PG8_STAGE(PG8_SB(0, 1), b2 + hstep, voffB); PG8_STAGE(PG8_SA(0, 0), a2, voffA);
            PG8_WAIT_V(8); PG8_WAIT_L(0); PG8_BAR; PG8_MMA(1, 0, At, B0); PG8_MMA(1, 1, At, B1); PG8_BAR; PG8_SCHED;
            PG8_LDB(B0, 1, 0); PG8_LDB(B1, 1, 1); PG8_SCHED; PG8_LDA(At, 1, 0); PG8_STAGE(PG8_SA(0, 1), a2 + hstep, voffA);
            PG8_WAIT_V(8); PG8_WAIT_L(0); PG8_BAR; PG8_MMA(0, 0, At, B0); PG8_MMA(0, 1, At, B1); PG8_BAR; PG8_SCHED;
            PG8_LDA(At, 1, 1); PG8_STAGE(PG8_SB(1, 0), b3, voffB); PG8_STAGE(PG8_SB(1, 1), b3 + hstep, voffB); PG8_STAGE(PG8_SA(1, 0), a3, voffA);
            PG8_WAIT_V(8); PG8_WAIT_L(0); PG8_BAR; PG8_MMA(1, 0, At, B0); PG8_MMA(1, 1, At, B1); PG8_BAR; PG8_SCHED;
            } else {
            PG8_LDB(B0, 0, 0); PG8_SCHED; PG8_LDA(At, 0, 0); PG8_STAGE(PG8_SA(1, 1), a1 + hstep, voffA);
            PG8_WAIT_L(8); PG8_BAR; PG8_WAIT_L(0); PG8_MMA(0, 0, At, B0); PG8_BAR; PG8_SCHED;
            PG8_LDB(B1, 0, 1); PG8_STAGE(PG8_SB(0, 0), b2, voffB);
            PG8_BAR; PG8_WAIT_L(0); PG8_MMA(0, 1, At, B1); PG8_BAR;
            PG8_LDA(At, 0, 1); PG8_STAGE(PG8_SA(0, 0), a2, voffA);
            PG8_BAR; PG8_WAIT_L(0); PG8_MMA(1, 0, At, B0); PG8_BAR; PG8_SCHED;
            PG8_STAGE(PG8_SB(0, 1), b2 + hstep, voffB);
            PG8_WAIT_V(6); PG8_BAR; PG8_MMA(1, 1, At, B1); PG8_BAR;
            PG8_LDB(B0, 1, 0); PG8_SCHED; PG8_LDA(At, 1, 0); PG8_STAGE(PG8_SA(0, 1), a2 + hstep, voffA);
            PG8_WAIT_L(8); PG8_BAR; PG8_WAIT_L(0); PG8_MMA(0, 0, At, B0); PG8_BAR; PG8_SCHED;
            PG8_LDB(B1, 1, 1); PG8_STAGE(PG8_SB(1, 0), b3, voffB);
            PG8_BAR; PG8_WAIT_L(0); PG8_MMA(0, 1, At, B1); PG8_BAR;
            PG8_LDA(At, 1, 1); PG8_STAGE(PG8_SA(1, 0), a3, voffA);
            PG8_BAR; PG8_WAIT_L(0); PG8_MMA(1, 0, At, B0); PG8_BAR; PG8_SCHED;
            PG8_STAGE(PG8_SB(1, 1), b3 + hstep, voffB);
            PG8_WAIT_V(6); PG8_BAR; PG8_MMA(1, 1, At, B1); PG8_BAR;
            }
        }
        if constexpr (ALIGN_EPI) { if (wr == 0) PG8_BAR; }
        if constexpr (!Epi::AFTER_DRAIN) { E(acc, cur, wr, wc, fr, fq); S.done(cur); }
        if (!has_next) break;
#pragma unroll
        for (int a = 0; a < 2; ++a)
#pragma unroll
            for (int b = 0; b < 2; ++b)
#pragma unroll
                for (int m = 0; m < 4; ++m)
#pragma unroll
                    for (int n = 0; n < 2; ++n) acc[a][b][m][n] = (f32x4){0.f, 0.f, 0.f, 0.f};
        cur = nxt; cA = nA; cB = nB; ++ui;
        if constexpr (ALIGN_EPI) { if (wr == 1) PG8_BAR; }
    }
    PG8_WAIT_V(0);
    if constexpr (!ALIGN_EPI) { if (wr == 0) PG8_BAR; }
    PG8_BAR;
    if constexpr (Epi::AFTER_DRAIN) { E.fused(acc, cur, wr, wc, fr, fq, lds, wid, lane); S.done(cur); }
#undef PG8_SA
#undef PG8_SB
#undef PG8_STAGE
#undef PG8_LDA
#undef PG8_LDB
#undef PG8_MMA
#undef PG8_WAIT_V
#undef PG8_WAIT_L
#undef PG8_BAR
#undef PG8_SCHED
}
}

namespace att {
using bf16x8 = __attribute__((ext_vector_type(8))) short;
using s16x4  = __attribute__((ext_vector_type(4))) short;
using f32x16 = __attribute__((ext_vector_type(16))) float;
using u32x4  = __attribute__((ext_vector_type(4))) unsigned;
typedef unsigned short bf16;
constexpr int NW = 8, QBLK = 32, KVBLK = 64, LDQ = 768, LDK = 768, LDY = 1024, SEQK = 4352;
constexpr float SCALE = 0.125f, THR = 8.f;
constexpr int SDEPTH = 2;
constexpr int NSLOT = 3;
constexpr size_t SHM_V = KVBLK * 128 * 2, SHM_K = KVBLK * 128 * 2, SHM_ATTN = NSLOT * SHM_V + NSLOT * SHM_K + NW * 64 * 4;
#define KSWZ(row, colB) ((row) * 256 + ((colB) ^ (((row) & 7) << 4)))
#define SBAR() __builtin_amdgcn_sched_barrier(0)
__device__ __forceinline__ int crow(int r, int hi) { return (r & 3) + 8 * (r >> 2) + 4 * hi; }
__device__ __forceinline__ unsigned cvtpk(float lo, float hi) { unsigned r; asm volatile("v_cvt_pk_bf16_f32 %0, %1, %2" : "=v"(r) : "v"(lo), "v"(hi)); return r; }
__device__ __forceinline__ unsigned short f2bf(float f) { unsigned u = __builtin_bit_cast(unsigned, f); return (unsigned short)((u + 0x7fffu + ((u >> 16) & 1u)) >> 16); }

__device__ __forceinline__ void partialSM(f32x16& p0, f32x16& p1, float& m_reg, float& mn, float& alpha) {
  constexpr float C = SCALE * 1.4426950408889634f;
  float pmax = p0[0];
#pragma unroll
  for (int r = 1; r < 16; ++r) pmax = fmaxf(pmax, p0[r]);
#pragma unroll
  for (int r = 0; r < 16; ++r) pmax = fmaxf(pmax, p1[r]);
  { auto rr = __builtin_amdgcn_permlane32_swap(__float_as_uint(pmax), __float_as_uint(pmax), false, false);
    pmax = fmaxf(__uint_as_float(rr[0]), __uint_as_float(rr[1])); }
  if (__builtin_expect(__all(pmax - m_reg <= THR / SCALE), 1)) { mn = m_reg; alpha = 1.f; }
  else { mn = fmaxf(m_reg, pmax); alpha = __builtin_amdgcn_exp2f((m_reg - mn) * C); m_reg = mn; }
  float mnC = -mn * C;
#pragma unroll
  for (int r = 0; r < 16; ++r) p0[r] = fmaf(p0[r], C, mnC);
#pragma unroll
  for (int r = 0; r < 16; ++r) p1[r] = fmaf(p1[r], C, mnC);
#pragma unroll
  for (int r = 0; r < 16; ++r) p0[r] = __builtin_amdgcn_exp2f(p0[r]);
}
__device__ __forceinline__ void partialSM_fixed(f32x16& p0, f32x16& p1, float mBC) {
  constexpr float C = SCALE * 1.4426950408889634f;
#pragma unroll
  for (int r = 0; r < 16; ++r) p0[r] = fmaf(p0[r], C, mBC);
#pragma unroll
  for (int r = 0; r < 16; ++r) p1[r] = fmaf(p1[r], C, mBC);
#pragma unroll
  for (int r = 0; r < 16; ++r) p0[r] = __builtin_amdgcn_exp2f(p0[r]);
}
__device__ __forceinline__ void finishSM(f32x16& p0, f32x16& p1, float alpha, float& l_reg, bf16x8& pa0, bf16x8& pa1, bf16x8& pa2, bf16x8& pa3) {
#pragma unroll
  for (int r = 0; r < 16; ++r) p1[r] = __builtin_amdgcn_exp2f(p1[r]);
  float ps = 0;
#pragma unroll
  for (int r = 0; r < 16; ++r) ps += p0[r];
#pragma unroll
  for (int r = 0; r < 16; ++r) ps += p1[r];
  { auto rr = __builtin_amdgcn_permlane32_swap(__float_as_uint(ps), __float_as_uint(ps), false, false);
    ps = __uint_as_float(rr[0]) + __uint_as_float(rr[1]); }
  l_reg = l_reg * alpha + ps;
#define PK4(P, BASE, OUT) do { unsigned a0 = cvtpk(P[BASE + 0], P[BASE + 1]), a1 = cvtpk(P[BASE + 2], P[BASE + 3]);   \
    unsigned b0 = cvtpk(P[BASE + 4], P[BASE + 5]), b1 = cvtpk(P[BASE + 6], P[BASE + 7]);                              \
    auto r0 = __builtin_amdgcn_permlane32_swap(a0, b0, false, false); auto r1 = __builtin_amdgcn_permlane32_swap(a1, b1, false, false); \
    u32x4 w = {r0[0], r1[0], r0[1], r1[1]}; OUT = *reinterpret_cast<bf16x8*>(&w); } while (0)
  PK4(p0, 0, pa0); PK4(p0, 8, pa1); PK4(p1, 0, pa2); PK4(p1, 8, pa3);
#undef PK4
}
__device__ __forceinline__ void qkt(f32x16& p0, f32x16& p1, const bf16* Ks, const bf16x8* qr, int r32, int hi, int comp) {
  p0 = f32x16{}; p1 = f32x16{};
#pragma unroll
  for (int d0 = 0; d0 < 4; ++d0) { int cb = (comp * 64 + d0 * 16 + hi * 8) * 2;
    bf16x8 b0 = *reinterpret_cast<const bf16x8*>((const char*)Ks + KSWZ(r32, cb));
    bf16x8 b1 = *reinterpret_cast<const bf16x8*>((const char*)Ks + KSWZ(32 + r32, cb));
    p0 = __builtin_amdgcn_mfma_f32_32x32x16_bf16(b0, qr[d0], p0, 0, 0, 0);
    p1 = __builtin_amdgcn_mfma_f32_32x32x16_bf16(b1, qr[d0], p1, 0, 0, 0); }
}
__device__ __forceinline__ int v_st(int k, int c) { const int kk = (k & ~0xC) | ((k & 4) << 1) | ((k & 8) >> 1); return ((kk >> 3) * 4 + (c >> 5)) * 512 + ((kk & 7) * 32 + (c & 31)) * 2; }
__device__ __forceinline__ int v_rd_base(int lane) { return ((lane & 3) << 3) | (((lane >> 2) & 3) << 6) | (((lane >> 4) & 1) << 5) | (((lane >> 5) & 1) << 8); }
constexpr int v_rd_off(int d0, int ks, int half) { return d0 * 512 + ks * 4096 + half * 2048; }
template <int OFF> __device__ __forceinline__ s16x4 tr_read(int vb) {
  s16x4 r; asm volatile("ds_read_b64_tr_b16 %0, %1 offset:%2" : "=&v"(r) : "v"(vb), "i"(OFF) : "memory"); return r;
}
template <int D0> __device__ __forceinline__ void v_rd8(s16x4 (&f)[8], int vb) {
  f[0] = tr_read<v_rd_off(D0, 0, 0)>(vb); f[1] = tr_read<v_rd_off(D0, 0, 1)>(vb); f[2] = tr_read<v_rd_off(D0, 1, 0)>(vb); f[3] = tr_read<v_rd_off(D0, 1, 1)>(vb);
  f[4] = tr_read<v_rd_off(D0, 2, 0)>(vb); f[5] = tr_read<v_rd_off(D0, 2, 1)>(vb); f[6] = tr_read<v_rd_off(D0, 3, 0)>(vb); f[7] = tr_read<v_rd_off(D0, 3, 1)>(vb);
}
__device__ __forceinline__ void pv_mf(f32x16& od, const s16x4 (&f)[8], bf16x8 pa0, bf16x8 pa1, bf16x8 pa2, bf16x8 pa3) {
#define PK(L, H) (bf16x8){L[0], L[1], L[2], L[3], H[0], H[1], H[2], H[3]}
  od = __builtin_amdgcn_mfma_f32_32x32x16_bf16(pa0, PK(f[0], f[1]), od, 0, 0, 0);
  od = __builtin_amdgcn_mfma_f32_32x32x16_bf16(pa1, PK(f[2], f[3]), od, 0, 0, 0);
  od = __builtin_amdgcn_mfma_f32_32x32x16_bf16(pa2, PK(f[4], f[5]), od, 0, 0, 0);
  od = __builtin_amdgcn_mfma_f32_32x32x16_bf16(pa3, PK(f[6], f[7]), od, 0, 0, 0);
#undef PK
}
__device__ __forceinline__ void pv_d0(f32x16* o, int vb, bf16x8 pa0, bf16x8 pa1, bf16x8 pa2, bf16x8 pa3) {
  s16x4 fa[8], fb[8];
#define LWAIT() do { asm volatile("s_waitcnt lgkmcnt(0)" ::: "memory"); SBAR(); } while (0)
  v_rd8<0>(fa, vb);
  LWAIT(); v_rd8<1>(fb, vb); SBAR(); pv_mf(o[0], fa, pa0, pa1, pa2, pa3); SBAR();
  LWAIT(); v_rd8<2>(fa, vb); SBAR(); pv_mf(o[1], fb, pa0, pa1, pa2, pa3); SBAR();
  LWAIT(); v_rd8<3>(fb, vb); SBAR(); pv_mf(o[2], fa, pa0, pa1, pa2, pa3); SBAR();
  LWAIT(); pv_mf(o[3], fb, pa0, pa1, pa2, pa3);
#undef LWAIT
}

template <bool FIXED> __device__ __forceinline__ void attn_unit(const bf16* __restrict__ Qb, const bf16* __restrict__ Kh, const bf16* __restrict__ Vh, bf16* __restrict__ Yb,
                                          const float* __restrict__ subg, float lam, float mBC, char* lds) {
  const int tid = ltid(), wid = tid >> 6, lane = tid & 63, r32 = lane & 31, hi = lane >> 5;
  const int comp = wid >> 2, wq = wid & 3;
  bf16* V_lds = (bf16*)lds; bf16* K_lds = (bf16*)(lds + NSLOT * SHM_V);
  float* ws = (float*)(lds + NSLOT * SHM_V + NSLOT * SHM_K) + wid * 64; float* li_l = ws; float* al_l = ws + 32;
  float m_reg = -1e30f, l_reg = 0; f32x16 o[4] = {}; bf16x8 qr[4];
  const bf16* Qw = Qb + (long)(wq * QBLK + r32) * LDQ + comp * 64 + hi * 8;
#pragma unroll
  for (int d0 = 0; d0 < 4; ++d0) qr[d0] = *reinterpret_cast<const bf16x8*>(Qw + d0 * 16);
  const int sr = tid >> 4, sc = (tid & 15) * 8, vst0 = v_st(sr, sc), vst1 = v_st(32 + sr, sc);
  const int vb0 = (int)(uintptr_t)V_lds + v_rd_base(lane);
  struct { bf16x8 vs0, vs1, ks0, ks1; } sr_[SDEPTH];
#define SLOAD(i, k0) do { sr_[i].vs0 = *reinterpret_cast<const bf16x8*>(&Vh[(long)((k0) + sr) * LDK + sc]); sr_[i].vs1 = *reinterpret_cast<const bf16x8*>(&Vh[(long)((k0) + 32 + sr) * LDK + sc]); \
    sr_[i].ks0 = *reinterpret_cast<const bf16x8*>(&Kh[(long)((k0) + sr) * LDK + sc]); sr_[i].ks1 = *reinterpret_cast<const bf16x8*>(&Kh[(long)((k0) + 32 + sr) * LDK + sc]); } while (0)
#define SWRITE(b, i) do { *(bf16x8*)((char*)V_lds + (b) * SHM_V + vst0) = sr_[i].vs0;          \
    *(bf16x8*)((char*)V_lds + (b) * SHM_V + vst1) = sr_[i].vs1; int kc = sc * 2;               \
    *(bf16x8*)((char*)K_lds + (b) * SHM_K + KSWZ(sr, kc)) = sr_[i].ks0;                       \
    *(bf16x8*)((char*)K_lds + (b) * SHM_K + KSWZ(32 + sr, kc)) = sr_[i].ks1; } while (0)
#define SWAIT() do { asm volatile("s_waitcnt vmcnt(4)" ::: "memory"); } while (0)
#define PSM(P0, P1, MN, AL) do { if constexpr (FIXED) { partialSM_fixed(P0, P1, mBC); AL = 1.f; } else partialSM(P0, P1, m_reg, MN, AL); } while (0)
#define RESC(a) do { if constexpr (!FIXED) if (__any((a) < 1.f)) { if (hi == 0) al_l[r32] = (a); asm volatile("s_waitcnt lgkmcnt(0)" ::: "memory"); \
    _Pragma("unroll") for (int d = 0; d < 4; ++d) _Pragma("unroll") for (int r = 0; r < 16; ++r) o[d][r] *= al_l[crow(r, hi)]; } } while (0)
  f32x16 pA0, pA1, pB0, pB1; float mnA, mnB, alA, alB; bf16x8 pa0, pa1, pa2, pa3; constexpr int NT = SEQK / KVBLK;
  constexpr int SE = 0, SO = SDEPTH - 1;
  SLOAD(SE, 0); asm volatile("s_waitcnt vmcnt(0)" ::: "memory"); SWRITE(0, SE); __syncthreads();
  qkt(pA0, pA1, K_lds, qr, r32, hi, comp); PSM(pA0, pA1, mnA, alA);
  SLOAD(SO, KVBLK); if (2 < NT) SLOAD(SE, 2 * KVBLK);
  SWAIT(); SWRITE(1, SO); __syncthreads();
  int sk = 1, sv = 0, sw = 2;
#define ROT() do { sv = sk; sk = sw; sw = (sw == NSLOT - 1) ? 0 : sw + 1; } while (0)
  for (int j = 1; j + 1 < NT; j += 2) {
    SBAR(); qkt(pB0, pB1, (bf16*)((char*)K_lds + sk * SHM_K), qr, r32, hi, comp);
    finishSM(pA0, pA1, alA, l_reg, pa0, pa1, pa2, pa3); SBAR();
    SLOAD(SO, (j + SDEPTH) * KVBLK); SBAR();
    SWAIT(); SWRITE(sw, SE); SBAR();
    pv_d0(o, vb0 + sv * (int)SHM_V, pa0, pa1, pa2, pa3); PSM(pB0, pB1, mnB, alB);
    RESC(alB); __syncthreads(); ROT();
    SBAR(); qkt(pA0, pA1, (bf16*)((char*)K_lds + sk * SHM_K), qr, r32, hi, comp);
    finishSM(pB0, pB1, alB, l_reg, pa0, pa1, pa2, pa3); SBAR();
    if (j + 3 < NT) { SLOAD(SE, (j + 1 + SDEPTH) * KVBLK); SBAR(); SWAIT(); } else { asm volatile("s_waitcnt vmcnt(0)" ::: "memory"); }
    SWRITE(sw, SO); SBAR();
    pv_d0(o, vb0 + sv * (int)SHM_V, pa0, pa1, pa2, pa3); PSM(pA0, pA1, mnA, alA);
    RESC(alA); __syncthreads(); ROT();
  }
  SBAR(); qkt(pB0, pB1, (bf16*)((char*)K_lds + sk * SHM_K), qr, r32, hi, comp);
  finishSM(pA0, pA1, alA, l_reg, pa0, pa1, pa2, pa3); SBAR();
  pv_d0(o, vb0 + sv * (int)SHM_V, pa0, pa1, pa2, pa3); PSM(pB0, pB1, mnB, alB);
  RESC(alB);
  finishSM(pB0, pB1, alB, l_reg, pa0, pa1, pa2, pa3); SBAR();
  pv_d0(o, vb0 + sk * (int)SHM_V, pa0, pa1, pa2, pa3);
#undef ROT
  if (hi == 0) li_l[r32] = l_reg; asm volatile("s_waitcnt lgkmcnt(0)" ::: "memory");
  float rli[16];
#pragma unroll
  for (int r = 0; r < 16; ++r) rli[r] = __builtin_amdgcn_rcpf(li_l[crow(r, hi)]);
  __syncthreads();
  float* X = (float*)lds + wq * 4096;
  if (comp == 1) {
#pragma unroll
    for (int d0 = 0; d0 < 4; ++d0)
#pragma unroll
      for (int r = 0; r < 16; ++r) X[(d0 * 16 + r) * 64 + lane] = o[d0][r] * rli[r] * lam;
  }
  __syncthreads();
  if (comp == 0) {
    float ss[16];
#pragma unroll
    for (int r = 0; r < 16; ++r) ss[r] = 0.f;
#pragma unroll
    for (int d0 = 0; d0 < 4; ++d0)
#pragma unroll
      for (int r = 0; r < 16; ++r) { const float d = o[d0][r] * rli[r] - X[(d0 * 16 + r) * 64 + lane]; o[d0][r] = d; ss[r] += d * d; }
#pragma unroll
    for (int r = 0; r < 16; ++r) {
#pragma unroll
      for (int off = 1; off < 32; off <<= 1) ss[r] += __shfl_xor(ss[r], off);
    }
    float g4[4];
#pragma unroll
    for (int d0 = 0; d0 < 4; ++d0) g4[d0] = subg[d0 * 32 + r32] * 0.8f;
#pragma unroll
    for (int r = 0; r < 16; ++r) { const float rs = rsqrtf(ss[r] * (1.f / 128.f) + 1e-6f); bf16* yrow = Yb + (long)(wq * QBLK + crow(r, hi)) * LDY;
#pragma unroll
      for (int d0 = 0; d0 < 4; ++d0) yrow[d0 * 32 + r32] = f2bf(o[d0][r] * rs * g4[d0]); }
  }
  __syncthreads();
#undef SLOAD
#undef SWRITE
#undef SWAIT
#undef RESC
#undef PSM
}
#undef SBAR
}


#ifndef MK_DEBUG
#define MK_DEBUG 0
#endif
#define PROBE_XB
#ifndef MK_SIMPLE6
#define MK_SIMPLE6 0
#endif
#ifndef NPH_RUN
#define NPH_RUN 16
#endif
#ifndef PHMASK
#define PHMASK 0xFFFF
#endif
#define PHM(k) ((PHMASK >> (k)) & 1)
#ifndef MK_MULTI
#define MK_MULTI 0
#endif
#define LAS __attribute__((address_space(3)))
#define GAS __attribute__((address_space(1)))
typedef unsigned short bf16;
typedef unsigned v4u __attribute__((ext_vector_type(4)));
typedef unsigned v2u __attribute__((ext_vector_type(2)));
typedef float f32x4 __attribute__((ext_vector_type(4)));
typedef short bf16x8 __attribute__((ext_vector_type(8)));
typedef float f32x16 __attribute__((ext_vector_type(16)));
#define LDS_WAIT() asm volatile("s_waitcnt lgkmcnt(0)" ::: "memory")
constexpr int NWAVES = 8, NTHR = 512, NPH = 16;
constexpr int SEQ = 4096, DM = 1024, MTOK = 16384, TKV = 4352, FF = 4096, MODW = 6144;
constexpr size_t MiB = 1u << 20;
constexpr size_t WS_ROPE = 524288;
constexpr size_t WS_MOD = 1 * MiB, WS_WIN = 2 * MiB, WS_WOUT = 7 * MiB, WS_W1 = 9 * MiB, WS_W2 = 25 * MiB, WS_ODIN = 41 * MiB, WS_ODOUT = 49 * MiB;
constexpr size_t WS_XN = 56 * MiB;
constexpr size_t WS_Q = 92 * MiB, WS_K = 116 * MiB, WS_V = 142 * MiB, WS_POOL = 168 * MiB, WS_Y = 176 * MiB;
constexpr size_t WS_HB = 92 * MiB;
constexpr size_t WS_U = 92 * MiB, WS_VT = 156 * MiB;
constexpr size_t WS_XR = 220 * MiB;
constexpr size_t WS_PART = 252 * MiB;
constexpr size_t WS_END = 254 * MiB;
constexpr int LDS_BYTES = 147456;

__device__ __forceinline__ unsigned f2bf(float f) { unsigned u = __builtin_bit_cast(unsigned, f); return (u + 0x7fffu + ((u >> 16) & 1u)) >> 16; }
__device__ __forceinline__ unsigned pk2(float lo, float hi) { return f2bf(lo) | (f2bf(hi) << 16); }
__device__ __forceinline__ float bflo(unsigned w) { return __builtin_bit_cast(float, w << 16); }
__device__ __forceinline__ float bfhi(unsigned w) { return __builtin_bit_cast(float, w & 0xffff0000u); }
__device__ __forceinline__ float wave_sum(float v) {
#pragma unroll
    for (int o = 1; o < 64; o <<= 1) v += __shfl_xor(v, o);
    return v;
}

struct Args { const float* in[27]; float* out; unsigned char* ws; int ph_lo, ph_hi; };

__device__ __forceinline__ void p0_transpose_item(const float* W, int K, int N, bf16* WT, LAS float* scr, int item, int lane, bool permqk = false) {
    const int nblk = N / 32, kb = item / nblk, nb = item % nblk, k0 = 64 * kb, n0 = 32 * nb;
    int d0 = n0;
    if (permqk) { const int tile = n0 >> 8, c = n0 & 255; if (tile >= 1 && tile <= 6) d0 = tile * 256 + 128 * ((c >> 5) & 1) + 32 * (c >> 6); }
#pragma unroll 8
    for (int i = 0; i < 32; ++i) { const int kk = 2 * i + (lane >> 5); scr[kk * 33 + (lane & 31)] = W[(size_t)(k0 + kk) * N + n0 + (lane & 31)]; }
    LDS_WAIT(); asm volatile("" ::: "memory");
    const int c = lane & 7;
#pragma unroll
    for (int j = 0; j < 4; ++j) { const int n = (lane >> 3) + 8 * j; const LAS float* s = scr + (8 * c) * 33 + n;
        v4u o; o.x = pk2(s[0 * 33], s[1 * 33]); o.y = pk2(s[2 * 33], s[3 * 33]); o.z = pk2(s[4 * 33], s[5 * 33]); o.w = pk2(s[6 * 33], s[7 * 33]);
        *(v4u*)(WT + (size_t)(d0 + n) * K + k0 + 8 * c) = o; }
    LDS_WAIT(); asm volatile("" ::: "memory");
}
__device__ __forceinline__ void p0_prep(const Args& a, unsigned char* ldsg, int vcu, int G) {
    LAS unsigned char* lds = (LAS unsigned char*)ldsg;
    const int tid = ltid(), lane = tid & 63, wave = tid >> 6;
    float* mod = (float*)(a.ws + WS_MOD);
    for (int item = blockIdx.x; item < 192; item += G) {
        LAS float* sin_ = (LAS float*)lds;
        for (int i = tid; i < 5 * 1024; i += NTHR) { const int r = i >> 10, k = i & 1023; const float c = r < 4 ? a.in[1][r * 1024 + k] : a.in[3][k]; sin_[i] = c / (1.f + __expf(-c)); }
        __syncthreads();
        const int l = item / 96, cb = item % 96;
        const float* W = a.in[4] + (size_t)l * 1024 * MODW + cb * 64 + lane;
        float acc[5] = {0.f, 0.f, 0.f, 0.f, 0.f};
        const int k0 = wave * 128;
#pragma unroll 8
        for (int kk = 0; kk < 128; ++kk) { const int k = k0 + kk; const float w = W[(size_t)k * MODW];
#pragma unroll
            for (int r = 0; r < 5; ++r) acc[r] += sin_[r * 1024 + k] * w; }
        LAS float* red = (LAS float*)(lds + 20480);
#pragma unroll
        for (int r = 0; r < 5; ++r) red[(wave * 5 + r) * 64 + lane] = acc[r];
        __syncthreads();
        if (tid < 320) { const int r = tid >> 6, col = tid & 63; float s = 0.f;
#pragma unroll
            for (int w = 0; w < 8; ++w) s += red[(w * 5 + r) * 64 + col];
            s += a.in[5][l * MODW + cb * 64 + col]; mod[(size_t)(l * 5 + r) * MODW + cb * 64 + col] = s; }
        __syncthreads();
    }
    if (blockIdx.x == G - 1) { float* rt = (float*)(a.ws + WS_ROPE);
        for (int i = tid; i < 1024; i += NTHR) { const int pos = i >> 4, f = i & 15; const float inv = powf(10000.0f, -(float)f / 16.0f); const float ang = (float)pos * inv; float sn, cs; sincosf(ang, &sn, &cs); rt[2 * i] = cs; rt[2 * i + 1] = sn; } }
    LAS float* scr = (LAS float*)(lds + 32768 + wave * 8448);
    const int gw = vcu * NWAVES + wave, NGW = G * NWAVES;
    constexpr int I_WIN = 16 * 80, I_WOUT = 16 * 32, I_W1 = 16 * 128, I_W2 = 64 * 32, I_ODIN = 16 * 128, I_ODOUT = 32 * 32;
    constexpr int NITEMS = I_WIN + I_WOUT + 2 * I_W1 + 2 * I_W2 + I_ODIN + I_ODOUT;
    for (int it = gw; it < NITEMS; it += NGW) {
        int r = it;
        if (r < I_WIN) { p0_transpose_item(a.in[10], 1024, 2560, (bf16*)(a.ws + WS_WIN), scr, r, lane, true); continue; } r -= I_WIN;
        if (r < I_WOUT) { p0_transpose_item(a.in[11], 1024, 1024, (bf16*)(a.ws + WS_WOUT), scr, r, lane); continue; } r -= I_WOUT;
        if (r < 2 * I_W1) { const int l = r / I_W1; p0_transpose_item(a.in[8] + (size_t)l * 1024 * 4096, 1024, 4096, (bf16*)(a.ws + WS_W1) + (size_t)l * 4096 * 1024, scr, r % I_W1, lane); continue; } r -= 2 * I_W1;
        if (r < 2 * I_W2) { const int l = r / I_W2; p0_transpose_item(a.in[9] + (size_t)l * 4096 * 1024, 4096, 1024, (bf16*)(a.ws + WS_W2) + (size_t)l * 1024 * 4096, scr, r % I_W2, lane); continue; } r -= 2 * I_W2;
        if (r < I_ODIN) { p0_transpose_item(a.in[21], 1024, 4096, (bf16*)(a.ws + WS_ODIN), scr, r, lane); continue; } r -= I_ODIN;
        p0_transpose_item(a.in[26], 2048, 1024, (bf16*)(a.ws + WS_ODOUT), scr, r, lane);
    }
}

__device__ __forceinline__ void norm_row(const float* xrow, bf16* orow, const f32x4 (&gs)[4], const f32x4 (&sh)[4], int lane) {
    const f32x4* xr = (const f32x4*)xrow + lane;
    f32x4 v[4]; float s2 = 0.f;
#pragma unroll
    for (int j = 0; j < 4; ++j) { v[j] = xr[64 * j]; s2 += (v[j].x * v[j].x + v[j].y * v[j].y) + (v[j].z * v[j].z + v[j].w * v[j].w); }
    const float rstd = rsqrtf(wave_sum(s2) * (1.f / 1024.f) + 1e-6f);
    unsigned long long* o8 = (unsigned long long*)orow + lane;
#pragma unroll
    for (int j = 0; j < 4; ++j) { const f32x4 y = v[j] * rstd * gs[j] + sh[j];
        o8[64 * j] = (unsigned long long)pk2(y.x, y.y) | ((unsigned long long)pk2(y.z, y.w) << 32); }
}
__device__ __forceinline__ void load_mod(const float* g, const float* shp, const float* scp, f32x4 (&gs)[4], f32x4 (&sh)[4], int lane) {
#pragma unroll
    for (int j = 0; j < 4; ++j) { const int idx = 4 * lane + 256 * j; const f32x4 gv = *(const f32x4*)(g + idx), sv = *(const f32x4*)(scp + idx); gs[j] = gv * (sv + 1.0f); sh[j] = *(const f32x4*)(shp + idx); }
}
__device__ __forceinline__ void norm_phase(const float* src, const float* g, const float* modl, int sh_off, int sc_off, bf16* dst, const float* ctx, int vcu, int G) {
    const int tid = ltid(), lane = tid & 63, wave = tid >> 6;
    for (int rb = vcu; rb < 256; rb += G) {
        const int b = rb >> 6; f32x4 gs[4], sh[4];
        load_mod(g, modl + (size_t)b * MODW + sh_off, modl + (size_t)b * MODW + sc_off, gs, sh, lane);
        for (int rr = 0; rr < 8; ++rr) { const size_t row = (size_t)rb * 64 + wave * 8 + rr; norm_row(src + row * 1024, dst + row * 1024, gs, sh, lane); }
        if (ctx && wave < 4) {
            load_mod(g, modl + (size_t)4 * MODW + sh_off, modl + (size_t)4 * MODW + sc_off, gs, sh, lane);
            const size_t row = (size_t)rb * 4 + wave; norm_row(ctx + row * 1024, dst + ((size_t)MTOK + row) * 1024, gs, sh, lane);
        }
    }
}

__device__ __forceinline__ void norm_phase_h(const bf16* src, const float* g, const float* modl, int sh_off, int sc_off, bf16* dst, int vcu, int G) {
    const int tid = ltid(), lane = tid & 63, wave = tid >> 6;
    for (int rb = vcu; rb < 256; rb += G) {
        const int b = rb >> 6; f32x4 gs[4], sh[4];
#pragma unroll
        for (int j = 0; j < 4; ++j) { const int idx = 16 * lane + 4 * j; const f32x4 gv = *(const f32x4*)(g + idx), sv = *(const f32x4*)(modl + (size_t)b * MODW + sc_off + idx); gs[j] = gv * (sv + 1.0f); sh[j] = *(const f32x4*)(modl + (size_t)b * MODW + sh_off + idx); }
        for (int hb = 0; hb < 2; ++hb) {
        v4u w[4][2];
#pragma unroll
        for (int rr = 0; rr < 4; ++rr) { const size_t row = (size_t)rb * 64 + wave * 8 + hb * 4 + rr; w[rr][0] = *(const v4u*)(src + row * 1024 + 16 * lane); w[rr][1] = *(const v4u*)(src + row * 1024 + 16 * lane + 8); }
#pragma unroll
        for (int rr = 0; rr < 4; ++rr) { const size_t row = (size_t)rb * 64 + wave * 8 + hb * 4 + rr; f32x4 v[4];
            v[0] = (f32x4){bflo(w[rr][0].x), bfhi(w[rr][0].x), bflo(w[rr][0].y), bfhi(w[rr][0].y)}; v[1] = (f32x4){bflo(w[rr][0].z), bfhi(w[rr][0].z), bflo(w[rr][0].w), bfhi(w[rr][0].w)};
            v[2] = (f32x4){bflo(w[rr][1].x), bfhi(w[rr][1].x), bflo(w[rr][1].y), bfhi(w[rr][1].y)}; v[3] = (f32x4){bflo(w[rr][1].z), bfhi(w[rr][1].z), bflo(w[rr][1].w), bfhi(w[rr][1].w)};
            float s2 = 0.f;
#pragma unroll
            for (int j = 0; j < 4; ++j) s2 += (v[j].x * v[j].x + v[j].y * v[j].y) + (v[j].z * v[j].z + v[j].w * v[j].w);
            const float rstd = rsqrtf(wave_sum(s2) * (1.f / 1024.f) + 1e-6f);
            v4u o0, o1; f32x4 y;
            y = v[0] * rstd * gs[0] + sh[0]; o0.x = pk2(y.x, y.y); o0.y = pk2(y.z, y.w); y = v[1] * rstd * gs[1] + sh[1]; o0.z = pk2(y.x, y.y); o0.w = pk2(y.z, y.w);
            y = v[2] * rstd * gs[2] + sh[2]; o1.x = pk2(y.x, y.y); o1.y = pk2(y.z, y.w); y = v[3] * rstd * gs[3] + sh[3]; o1.z = pk2(y.x, y.y); o1.w = pk2(y.z, y.w);
            *(v4u*)(dst + row * 1024 + 16 * lane) = o0; *(v4u*)(dst + row * 1024 + 16 * lane + 8) = o1; }
        }
    }
}

__device__ __forceinline__ void pool_phase(const Args& a, unsigned char* lds, int vcu, int G) {
    const int tid = ltid(), lane = tid & 63, wave = tid >> 6;
    bf16* in_ = (bf16*)(lds + 8192);
    float* pooled = (float*)(lds + 8192 + 40960);
    const bf16* PI = (const bf16*)(a.ws + WS_POOL); bf16* Y = (bf16*)(a.ws + WS_Y);
    const float* pw = a.in[12]; const float* pscale = a.in[13];
    for (int tb = vcu; tb < 256; tb += G) {
        const int b = tb >> 6, t0 = (tb & 63) * 64;
        __syncthreads();
#pragma unroll
        for (int ps = 0; ps < 5; ++ps) { const int row = ps * 16 + (tid >> 5), c8 = (tid & 31) * 8, t = t0 - 8 + row;
            v4u w = {0u, 0u, 0u, 0u}; if (t >= 0 && t < SEQ) w = *(const v4u*)(PI + ((size_t)b * SEQ + t) * 256 + c8);
            *(v4u*)(in_ + row * 256 + c8) = w; }
        __syncthreads();
        { const int c = tid & 255, th = tid >> 8, hw = 1 << (c >> 6);
            for (int tt = 0; tt < 32; ++tt) { const int tl = th * 32 + tt, t = t0 + tl; const int lo = max(t - hw, 0), hi = min(t + hw, SEQ);
                float s = 0.f; for (int j = lo; j < hi; ++j) s += bflo((unsigned)in_[(j - t0 + 8) * 256 + c]);
                pooled[tl * 256 + c] = s / (float)(hi - lo) - bflo((unsigned)in_[(tl + 8) * 256 + c]); } }
        __syncthreads();
        { const int gi = wave & 3, th = wave >> 2; float pwr[64];
#pragma unroll
            for (int c = 0; c < 64; ++c) pwr[c] = pw[gi * 4096 + c * 64 + lane];
            const float psc = pscale[gi * 64 + lane];
            for (int tt = 0; tt < 32; ++tt) { const int tl = th * 32 + tt; const f32x4* pp = (const f32x4*)(pooled + tl * 256 + gi * 64); float acc = 0.f;
#pragma unroll
                for (int c4 = 0; c4 < 16; ++c4) { const f32x4 v = pp[c4]; acc += v.x * pwr[4 * c4] + v.y * pwr[4 * c4 + 1] + v.z * pwr[4 * c4 + 2] + v.w * pwr[4 * c4 + 3]; }
                Y[((size_t)b * SEQ + t0 + tl) * 1024 + gi * 64 + lane] = (bf16)f2bf(acc * psc); } }
    }
    __syncthreads();
}

__device__ __forceinline__ void attn_phase(const Args& a, unsigned char* lds, int vcu, int G) {
    const int lane = ltid() & 63;
    const float s1 = wave_sum(a.in[16][lane] * a.in[17][lane]), s2 = wave_sum(a.in[18][lane] * a.in[19][lane]);
    const float lam = expf(s1) - expf(s2) + 0.2f;
    float mq = fabsf(a.in[14][lane]), mk = fabsf(a.in[15][lane]);
#pragma unroll
    for (int o = 1; o < 64; o <<= 1) { mq = fmaxf(mq, __shfl_xor(mq, o)); mk = fmaxf(mk, __shfl_xor(mk, o)); }
    const float Bq = 0.125f * 64.f * mq * mk * 1.02f;
    const bool fixed = Bq <= 20.f;
    const float mBC = -Bq * 1.4426950408889634f;
    const bf16* Q = (const bf16*)(a.ws + WS_Q); const bf16* KA = (const bf16*)(a.ws + WS_K); const bf16* VA = (const bf16*)(a.ws + WS_V); bf16* Y = (bf16*)(a.ws + WS_Y);
    const int per = 768 / G;
    for (int i = 0; i < per; ++i) { const int u = vcu * per + i, bh = u >> 5, qb = u & 31, b = bh / 6, h = bh - b * 6;
        const bf16* Qp = Q + ((size_t)b * SEQ + qb * 128) * 768 + h * 128; const bf16* Kp = KA + (size_t)b * TKV * 768 + h * 128; const bf16* Vp = VA + (size_t)b * TKV * 768 + h * 128;
        bf16* Yp = Y + ((size_t)b * SEQ + qb * 128) * 1024 + 256 + h * 128;
        if (fixed) att::attn_unit<true>(Qp, Kp, Vp, Yp, a.in[20], lam, mBC, (char*)lds);
        else       att::attn_unit<false>(Qp, Kp, Vp, Yp, a.in[20], lam, mBC, (char*)lds); }
}

__device__ __forceinline__ void spatial_phase(const Args& a, unsigned char* lds, int vcu, int G, bool probe = false) {
    const int tid = ltid(), lane = tid & 63, wave = tid >> 6, r32 = lane & 31, hi = lane >> 5;
    const bf16* VT = (const bf16*)(a.ws + WS_VT); bf16* U = (bf16*)(a.ws + WS_U);
    const float* lng = a.in[22]; const float* lnb = a.in[23]; const float* sgw = a.in[24]; const float* sgb = a.in[25];
    constexpr int TROW = 272;
    unsigned char* T = lds;
    float* red = (float*)lds;
    float* scr = (float*)(lds + 69632) + wave * (32 * 68);
    float* stats = (float*)(lds + 69632 + 69632);
    for (int un = vcu; un < 256; un += G) {
        const int chunk = un >> 1, half = un & 1; const size_t tok0 = (size_t)chunk * 128;
        __syncthreads();
        if (tid < 128) { const float* pp = (const float*)(a.ws + WS_PART) + (tok0 + tid) * 2; float s = 0.f, q = 0.f;
#pragma unroll
            for (int p = 0; p < 16; ++p) { const float2 v = *(const float2*)(pp + (size_t)p * 16384 * 2); s += v.x; q += v.y; }
            const float mean = s * (1.f / 2048.f), var = fmaxf(q * (1.f / 2048.f) - mean * mean, 0.f);
            stats[tid * 2] = mean; stats[tid * 2 + 1] = rsqrtf(var + 1e-6f); }
        __syncthreads();
        for (int gq = 0; gq < 4; ++gq) { const int g = half * 4 + gq;
            if (gq) __syncthreads();
            { const int slot = tid & 15, cr = tid >> 4; float mu[8], rs[8];
#pragma unroll
                for (int e = 0; e < 8; ++e) { mu[e] = stats[(slot * 8 + e) * 2]; rs[e] = stats[(slot * 8 + e) * 2 + 1]; }
#pragma unroll
                for (int i = 0; i < 8; ++i) { const int cl = cr + 32 * i, c = g * 256 + cl; const v4u w = *(const v4u*)(VT + (size_t)c * MTOK + tok0 + slot * 8);
                    const float lg = lng[c], lb = lnb[c];
                    float x[8]; x[0] = bflo(w.x); x[1] = bfhi(w.x); x[2] = bflo(w.y); x[3] = bfhi(w.y); x[4] = bflo(w.z); x[5] = bfhi(w.z); x[6] = bflo(w.w); x[7] = bfhi(w.w);
#pragma unroll
                    for (int e = 0; e < 8; ++e) x[e] = (x[e] - mu[e]) * rs[e] * lg + lb;
                    v4u o; o.x = pk2(x[0], x[1]); o.y = pk2(x[2], x[3]); o.z = pk2(x[4], x[5]); o.w = pk2(x[6], x[7]);
                    *(v4u*)(T + cl * TROW + slot * 16) = o; } }
            __syncthreads();
            const int mb = (wave & 3) * 32, ch = (wave >> 2) * 128;
            bf16x8 af[8];
            { const float* wrow = sgw + ((size_t)g * 128 + mb + r32) * 128 + hi * 8;
#pragma unroll
                for (int ks = 0; ks < 8; ++ks) { const f32x4 w0 = *(const f32x4*)(wrow + ks * 16), w1 = *(const f32x4*)(wrow + ks * 16 + 4);
                    v4u p; p.x = pk2(w0.x, w0.y); p.y = pk2(w0.z, w0.w); p.z = pk2(w1.x, w1.y); p.w = pk2(w1.z, w1.w); af[ks] = __builtin_bit_cast(bf16x8, p); } }
            f32x16 o[4];
#pragma unroll
            for (int d0 = 0; d0 < 4; ++d0) { o[d0] = f32x16{};
#pragma unroll
                for (int ks = 0; ks < 8; ++ks) { const bf16x8 bfr = *(const bf16x8*)(T + (ch + d0 * 32 + r32) * TROW + (16 * ks + 8 * hi) * 2);
                    o[d0] = __builtin_amdgcn_mfma_f32_32x32x16_bf16(af[ks], bfr, o[d0], 0, 0, 0); } }
            float bias[16];
#pragma unroll
            for (int r = 0; r < 16; ++r) bias[r] = sgb[g * 128 + mb + att::crow(r, hi)];
#pragma unroll
            for (int p = 0; p < 2; ++p) {
#pragma unroll
                for (int dd = 0; dd < 2; ++dd)
#pragma unroll
                    for (int r = 0; r < 16; ++r) scr[att::crow(r, hi) * 68 + dd * 32 + r32] = o[2 * p + dd][r] + bias[r];
                LDS_WAIT(); asm volatile("" ::: "memory");
                v4u uw[4];
#pragma unroll
                for (int qq = 0; qq < 4; ++qq) { const int row = (lane >> 3) + 8 * qq, c8 = (lane & 7) * 8; uw[qq] = *(const v4u*)(U + (tok0 + mb + row) * 2048 + g * 256 + ch + p * 64 + c8); }
#pragma unroll
                for (int qq = 0; qq < 4; ++qq) { const int row = (lane >> 3) + 8 * qq, c8 = (lane & 7) * 8;
                    const f32x4 m0 = *(const f32x4*)(scr + row * 68 + c8), m1 = *(const f32x4*)(scr + row * 68 + c8 + 4);
                    bf16* up = U + (tok0 + mb + row) * 2048 + g * 256 + ch + p * 64 + c8; const v4u w = uw[qq];
                    v4u ov; ov.x = pk2(bflo(w.x) * m0.x, bfhi(w.x) * m0.y); ov.y = pk2(bflo(w.y) * m0.z, bfhi(w.y) * m0.w);
                    ov.z = pk2(bflo(w.z) * m1.x, bfhi(w.z) * m1.y); ov.w = pk2(bflo(w.w) * m1.z, bfhi(w.w) * m1.w);
                    bf16* wp = up; if (probe) { const size_t tok = tok0 + mb + row; wp = (tok < 8192 ? (bf16*)(a.ws + 56 * MiB) + tok * 2048 : (bf16*)(a.ws + 220 * MiB) + (tok - 8192) * 2048) + g * 256 + ch + p * 64 + c8; }
                    *(v4u*)wp = ov; }
                LDS_WAIT(); asm volatile("" ::: "memory");
            }
        }
    }
}


#if MK_DEBUG
__device__ __forceinline__ float bfr(float f) { return __builtin_bit_cast(float, f2bf(f) << 16); }
__device__ __forceinline__ float bf2f(bf16 v) { return __builtin_bit_cast(float, (unsigned)v << 16); }
__device__ __forceinline__ void rec(float* res, int st, float got, float want) { float e = fabsf(got - want) / (fabsf(want) + 0.1f); if (!(e == e) || e > 1e30f) e = 0.77f; else e = fminf(e, 0.6f); atomicMax((unsigned*)res + st, __float_as_uint(e)); }
__device__ __forceinline__ unsigned hsh(unsigned s) { s ^= s >> 16; s *= 0x7feb352du; s ^= s >> 15; s *= 0x846ca68bu; s ^= s >> 16; return s; }
__global__ void chk_mod(Args a, float* res) {
    const int i = blockIdx.x * 256 + threadIdx.x; if (i >= 2 * 5 * 6144) return; const int l = i / (5 * 6144), r = (i / 6144) % 5, n = i % 6144;
    float s = 0.f; for (int k = 0; k < 1024; ++k) { const float c = r < 4 ? a.in[1][r * 1024 + k] : a.in[3][k]; s += (c / (1.f + expf(-c))) * a.in[4][((size_t)l * 1024 + k) * 6144 + n]; }
    s += a.in[5][l * 6144 + n]; rec(res, 0, ((const float*)(a.ws + WS_MOD))[i], s);
}
__global__ void chk_wt(const float* W, int K, int N, const bf16* WT, float* res, int st) {
    const unsigned h = hsh(blockIdx.x * 256 + threadIdx.x + 77u * st); const int k = h % K, n = (h >> 12) % N;
    rec(res, st, bf2f(WT[(size_t)n * K + k]), bfr(W[(size_t)k * N + n]));
}
__global__ void chk_norm(const float* src, const float* g, const float* modrow_sh, const float* modrow_sc, int bstride, const bf16* dst, int nrows, int rows_per_b, float* res, int st, int row_base = 0) {
    __shared__ float red[256]; const unsigned h = hsh(blockIdx.x + 1000u * st); const int row = row_base + h % nrows; const int b = rows_per_b ? row / rows_per_b : 0; const int t = threadIdx.x;
    float s = 0.f; for (int k = t; k < 1024; k += 256) { const float v = src[(size_t)row * 1024 + k]; s += v * v; } red[t] = s; __syncthreads();
    for (int o = 128; o > 0; o >>= 1) { if (t < o) red[t] += red[t + o]; __syncthreads(); }
    const float rstd = rsqrtf(red[0] / 1024.f + 1e-6f);
    for (int k = t; k < 1024; k += 256) { const float want = src[(size_t)row * 1024 + k] * rstd * g[k] * (1.f + modrow_sc[(size_t)b * bstride + k]) + modrow_sh[(size_t)b * bstride + k]; rec(res, st, bf2f(dst[(size_t)row * 1024 + k]), want); }
}
__device__ __forceinline__ float dotbf(const bf16* A, const bf16* B, int K) { float s = 0.f; for (int k = 0; k < K; ++k) s += bf2f(A[k]) * bf2f(B[k]); return s; }
__global__ void chk_gemm1(Args a, float* res) {
    const unsigned h = hsh(blockIdx.x * 256 + threadIdx.x); int row = h % 17408; int col = (h >> 15) % 2560;
    if (row >= 16384) { col = 1024 + (h >> 15) % 1536; }
    const bf16* XN = (const bf16*)(a.ws + WS_XN); const bf16* WT = (const bf16*)(a.ws + WS_WIN);
    const float want = dotbf(XN + (size_t)row * 1024, WT + (size_t)col * 1024, 1024); float got;
    if (row < 16384) { const int b = row >> 12, t = row & 4095; const size_t kv = (size_t)b * TKV + 256 + t;
        if (col < 256) got = bf2f(((const bf16*)(a.ws + WS_POOL))[(size_t)row * 256 + col]);
        else if (col < 1024) got = bf2f(((const bf16*)(a.ws + WS_Q))[(size_t)row * 768 + col - 256]);
        else if (col < 1792) got = bf2f(((const bf16*)(a.ws + WS_K))[kv * 768 + col - 1024]);
        else got = bf2f(((const bf16*)(a.ws + WS_V))[kv * 768 + col - 1792]);
    } else { const int rc = row - 16384, b = rc >> 8, j = rc & 255; const size_t kv = (size_t)b * TKV + j;
        if (col < 1792) got = bf2f(((const bf16*)(a.ws + WS_K))[kv * 768 + col - 1024]); else got = bf2f(((const bf16*)(a.ws + WS_V))[kv * 768 + col - 1792]); }
    rec(res, 3, got, want);
}
__global__ void chk_qk(Args a, float* res) {
    __shared__ float raw[64]; __shared__ float red[64]; const unsigned h = hsh(blockIdx.x + 4242u); const int d = threadIdx.x;
    int row = h % 17408; const int hg = (h >> 16) % 12; int isq = (h >> 24) & 1; if (row >= 16384) isq = 0;
    const bf16* XN = (const bf16*)(a.ws + WS_XN); const bf16* WT = (const bf16*)(a.ws + WS_WIN);
    const int col = (isq ? 256 : 1024) + hg * 64 + d;
    raw[d] = bfr(dotbf(XN + (size_t)row * 1024, WT + (size_t)col * 1024, 1024)); red[d] = raw[d] * raw[d]; __syncthreads();
    for (int o = 32; o > 0; o >>= 1) { if (d < o) red[d] += red[d + o]; __syncthreads(); }
    const float rstd = rsqrtf(red[0] / 64.f + 1e-6f); const float* gam = isq ? a.in[14] : a.in[15];
    float y = raw[d] * rstd * gam[d]; __syncthreads(); red[d] = y; __syncthreads();
    float want = y; size_t off;
    if (row < 16384) { const int t = row & 4095, pr = d >> 1; const float pos = (float)(pr < 16 ? (t >> 6) : (t & 63)); const float inv = powf(10000.f, -(float)(pr & 15) / 16.f); const float ang = pos * inv;
        const float cs = cosf(ang), sn = sinf(ang), x0 = red[2 * pr], x1 = red[2 * pr + 1]; want = (d & 1) ? x0 * sn + x1 * cs : x0 * cs - x1 * sn;
        off = isq ? (size_t)row * 768 + hg * 64 + d : ((size_t)(row >> 12) * TKV + 256 + t) * 768 + hg * 64 + d;
    } else { const int rc = row - 16384; off = ((size_t)(rc >> 8) * TKV + (rc & 255)) * 768 + hg * 64 + d; }
    const bf16* buf = isq ? (const bf16*)(a.ws + WS_Q) : (const bf16*)(a.ws + WS_K);
    rec(res, 4, bf2f(buf[off]), want);
}
__global__ void chk_pool(Args a, float* res) {
    const unsigned h = hsh(blockIdx.x * 256 + threadIdx.x + 999u); const int row = h % 16384, gi = (h >> 14) & 3, d = (h >> 16) & 63; const int b = row >> 12, t = row & 4095, hw = 1 << gi;
    const bf16* PI = (const bf16*)(a.ws + WS_POOL); const int lo = max(t - hw, 0), hi = min(t + hw, 4096); float acc = 0.f;
    for (int c = 0; c < 64; ++c) { float s = 0.f; for (int j = lo; j < hi; ++j) s += bf2f(PI[((size_t)b * 4096 + j) * 256 + gi * 64 + c]);
        const float pooled = s / (float)(hi - lo) - bf2f(PI[(size_t)row * 256 + gi * 64 + c]); acc += pooled * a.in[12][gi * 4096 + c * 64 + d]; }
    rec(res, 5, bf2f(((const bf16*)(a.ws + WS_Y))[(size_t)row * 1024 + gi * 64 + d]), acc * a.in[13][gi * 64 + d]);
}
__global__ void chk_attn(Args a, float* res) {
    __shared__ float s1[TKV], s2[TKV]; __shared__ float red[256]; __shared__ float ov[128];
    const unsigned hh = hsh(blockIdx.x + 31337u); const int row = hh % 16384, h = (hh >> 14) % 6, b = row >> 12, t = threadIdx.x;
    const bf16* Q = (const bf16*)(a.ws + WS_Q) + (size_t)row * 768 + h * 128; const bf16* KA = (const bf16*)(a.ws + WS_K) + (size_t)b * TKV * 768 + h * 128; const bf16* VA = (const bf16*)(a.ws + WS_V) + (size_t)b * TKV * 768 + h * 128;
    float l1 = 0.f, l2 = 0.f; for (int i = 0; i < 64; ++i) { l1 += a.in[16][i] * a.in[17][i]; l2 += a.in[18][i] * a.in[19][i]; } const float lam = expf(l1) - expf(l2) + 0.2f;
    for (int k = t; k < TKV; k += 256) { float x1 = 0.f, x2 = 0.f; for (int d = 0; d < 64; ++d) { x1 += bf2f(Q[d]) * bf2f(KA[(size_t)k * 768 + d]); x2 += bf2f(Q[64 + d]) * bf2f(KA[(size_t)k * 768 + 64 + d]); } s1[k] = x1 * 0.125f; s2[k] = x2 * 0.125f; }
    __syncthreads();
    float m1 = -1e30f, m2 = -1e30f; for (int k = t; k < TKV; k += 256) { m1 = fmaxf(m1, s1[k]); m2 = fmaxf(m2, s2[k]); }
    red[t] = m1; __syncthreads(); for (int o = 128; o > 0; o >>= 1) { if (t < o) red[t] = fmaxf(red[t], red[t + o]); __syncthreads(); } m1 = red[0]; __syncthreads();
    red[t] = m2; __syncthreads(); for (int o = 128; o > 0; o >>= 1) { if (t < o) red[t] = fmaxf(red[t], red[t + o]); __syncthreads(); } m2 = red[0]; __syncthreads();
    float z1 = 0.f, z2 = 0.f; for (int k = t; k < TKV; k += 256) { s1[k] = expf(s1[k] - m1); s2[k] = expf(s2[k] - m2); z1 += s1[k]; z2 += s2[k]; }
    red[t] = z1; __syncthreads(); for (int o = 128; o > 0; o >>= 1) { if (t < o) red[t] += red[t + o]; __syncthreads(); } z1 = red[0]; __syncthreads();
    red[t] = z2; __syncthreads(); for (int o = 128; o > 0; o >>= 1) { if (t < o) red[t] += red[t + o]; __syncthreads(); } z2 = red[0]; __syncthreads();
    if (t < 128) { float o = 0.f; for (int k = 0; k < TKV; ++k) o += (s1[k] / z1 - lam * s2[k] / z2) * bf2f(VA[(size_t)k * 768 + t]); ov[t] = o; red[t] = o * o; } else red[t] = 0.f;
    __syncthreads(); for (int o = 128; o > 0; o >>= 1) { if (t < o) red[t] += red[t + o]; __syncthreads(); }
    if (t < 128) { const float want = ov[t] * rsqrtf(red[0] / 128.f + 1e-6f) * a.in[20][t] * 0.8f; rec(res, 6, bf2f(((const bf16*)(a.ws + WS_Y))[(size_t)row * 1024 + 256 + h * 128 + t]), want); }
}
__global__ void chk_res(const bf16* A, const bf16* WT, int K, const float* basebuf, const float* gate, const float* out, float* res, int st, int nrows) {
    const unsigned h = hsh(blockIdx.x * 256 + threadIdx.x + 555u * st); const int row = h % nrows, col = (h >> 13) % 1024;
    const float want = basebuf[(size_t)row * 1024 + col] + gate[(size_t)(row >> 12) * 6144 + col] * dotbf(A + (size_t)row * K, WT + (size_t)col * K, K);
    rec(res, st, out[(size_t)row * 1024 + col], want);
}
__global__ void chk_act(const bf16* A, const bf16* WT, int K, int N, const bf16* O, int ldo, int act, int transposed, float* res, int st) {
    const unsigned h = hsh(blockIdx.x * 256 + threadIdx.x + 333u * st); const int row = h % 16384, col = (h >> 14) % N;
    float v = dotbf(A + (size_t)row * K, WT + (size_t)col * K, K); if (act == 2) { v = fmaxf(v, 0.f); v *= v; } else if (act == 1) v = 0.5f * v * (1.f + erff(v * 0.70710678f));
    rec(res, st, bf2f(transposed ? O[(size_t)col * ldo + row] : O[(size_t)row * ldo + col]), v);
}
__global__ void chk_copy(const float* src, float* dst, size_t n4) { for (size_t i = blockIdx.x * 256ull + threadIdx.x; i < n4; i += gridDim.x * 256ull) ((f32x4*)dst)[i] = ((const f32x4*)src)[i]; }
__global__ void chk_final(float* res, float* out, int nst) {
    for (int i = 0; i < nst; ++i) { const float e = res[i]; if (e > 0.08f) { float m = fminf(fmaxf(e * 10.f, 1.0f), 9.9f); float v = m; for (int j = 0; j < 4 + i; ++j) v *= 10.f; out[0] = v; return; } }
}
__global__ void simple_norm(const float* src, const float* g, const float* sh, const float* sc, int bstride, bf16* dst) {
    __shared__ float red[256]; const int row = blockIdx.x, b = row >> 12, t = threadIdx.x;
    float s = 0.f; for (int k = t; k < 1024; k += 256) { const float v = src[(size_t)row * 1024 + k]; s += v * v; } red[t] = s; __syncthreads();
    for (int o = 128; o > 0; o >>= 1) { if (t < o) red[t] += red[t + o]; __syncthreads(); }
    const float rstd = rsqrtf(red[0] / 1024.f + 1e-6f);
    for (int k = t; k < 1024; k += 256) dst[(size_t)row * 1024 + k] = (bf16)f2bf(src[(size_t)row * 1024 + k] * rstd * g[k] * (1.f + sc[(size_t)b * bstride + k]) + sh[(size_t)b * bstride + k]);
}
__global__ void chk_final2(float* res, float* out) { int mask = 0; for (int i = 0; i < 8; ++i) if (res[20 + i] < 0.08f) mask |= 1 << i; out[0] = (float)(mask + 1) * 1e6f; }
#endif

#define XB_TMO      128
#define XB_XCNT(j)  (256  + 64 * (j))
#define XB_XSUB(j)  (1280 + 64 * (j))
#define XB_XGEN(j)  (2304 + 64 * (j))
#define XB_TOP      3328
#define XB_TOPGEN   3392
#define XCD_BAR_WORDS 3456
#define XB_SPIN_CAP (1u << 18)

__device__ __forceinline__ unsigned xb_ld(unsigned* p)              { return __hip_atomic_load(p, __ATOMIC_RELAXED, __HIP_MEMORY_SCOPE_AGENT); }
__device__ __forceinline__ unsigned xb_add(unsigned* p, unsigned v) { return __hip_atomic_fetch_add(p, v, __ATOMIC_RELAXED, __HIP_MEMORY_SCOPE_AGENT); }
__device__ __forceinline__ unsigned xb_xcc_id() { return (unsigned)__builtin_amdgcn_s_getreg((3 << 11) | 20) & 0xFu; }
#define XB_SPIN(cond, bar) do { unsigned _sp = 0; while (cond) { __builtin_amdgcn_s_sleep(1); \
    if ((++_sp & 255u) == 0u) { if (xb_ld(&(bar)[XB_TMO])) break; if (_sp > XB_SPIN_CAP) { atomicAdd(&(bar)[XB_TMO], 1u); break; } } } } while (0)

struct XcdBarrier {
    unsigned* bar; unsigned x;
    volatile LAS unsigned* st;
};

__device__ __forceinline__ XcdBarrier xcd_barrier_post(unsigned* bar, volatile LAS unsigned* st) {
    XcdBarrier b; b.bar = bar; b.x = xb_xcc_id(); b.st = st;
    if (threadIdx.x == 0) (void)xb_add(&bar[XB_XCNT(b.x)], 1u);
    return b;
}
__device__ __forceinline__ void xcd_barrier_complete(unsigned* bar, unsigned x, unsigned& nloc, unsigned& nx) {
    const unsigned G = gridDim.x * gridDim.y * gridDim.z;
    unsigned sum, cnt, mine, sp = 0u;
    for (;;) {
        sum = 0u; cnt = 0u; mine = 0u;
#pragma unroll
        for (unsigned j = 0; j < 16; ++j) { const unsigned c = xb_ld(&bar[XB_XCNT(j)]); sum += c; cnt += (c > 0u) ? 1u : 0u; mine = (j == x) ? c : mine; }
        if (sum == G) break;
        __builtin_amdgcn_s_sleep(1);
        if ((++sp & 255u) == 0u) { if (xb_ld(&bar[XB_TMO])) break; if (sp > XB_SPIN_CAP) { atomicAdd(&bar[XB_TMO], 1u); break; } }
    }
    nloc = mine > 0u ? mine : 1u; nx = cnt > 0u ? cnt : 1u;
}

__device__ __forceinline__ void xcd_barrier(const XcdBarrier& b) {
    asm volatile("s_waitcnt vmcnt(0)" ::: "memory");
    __syncthreads();
    if (threadIdx.x == 0) {
        unsigned* bar = b.bar;
        __builtin_amdgcn_s_waitcnt(0);
        unsigned nloc = b.st[0], nx = b.st[1];
        if (nloc == 0u) { xcd_barrier_complete(bar, b.x, nloc, nx); b.st[0] = nloc; b.st[1] = nx; }
        const unsigned old = xb_add(&bar[XB_XSUB(b.x)], 1u);
        const unsigned gen = old / nloc;
        if (old + 1u == (gen + 1u) * nloc) {
            __builtin_amdgcn_fence(__ATOMIC_RELEASE, "agent");
            asm volatile("s_waitcnt vmcnt(0)" ::: "memory");
            const unsigned og = xb_add(&bar[XB_TOP], 1u);
            const unsigned tg = og / nx;
            if (og + 1u == (tg + 1u) * nx) xb_add(&bar[XB_TOPGEN], 1u);
            else XB_SPIN(xb_ld(&bar[XB_TOPGEN]) == tg, bar);
            __builtin_amdgcn_fence(__ATOMIC_ACQUIRE, "agent");
            xb_add(&bar[XB_XGEN(b.x)], 1u);
            asm volatile("s_waitcnt vmcnt(0)" ::: "memory");
        } else {
            XB_SPIN(xb_ld(&bar[XB_XGEN(b.x)]) == gen, bar);
            __builtin_amdgcn_fence(__ATOMIC_ACQUIRE, "agent");
            asm volatile("s_waitcnt vmcnt(0)" ::: "memory");
        }
    }
    __syncthreads();
}

template <int PH> __device__ __forceinline__ void run_phase(const Args& a, unsigned char* lds, int vcu, int G, int bx) {
    unsigned char* ws = a.ws;
    float* mod = (float*)(ws + WS_MOD);
    bf16* XN = (bf16*)(ws + WS_XN); bf16* XR = (bf16*)(ws + WS_XR);
    if constexpr (PH == 0) p0_prep(a, lds, vcu, G);
    else if constexpr (PH == 1)  norm_phase(a.in[0], a.in[6],        mod,            0,    1024, XN, a.in[2], vcu, G);
    else if constexpr (PH == 6)  norm_phase_h(XR, a.in[7],        mod,            3072, 4096, XN, vcu, G);
    else if constexpr (PH == 9)  norm_phase_h(XR, a.in[6] + 1024, mod + 5 * MODW, 0,    1024, XN, vcu, G);
    else if constexpr (PH == 13) norm_phase_h(XR, a.in[7] + 1024, mod + 5 * MODW, 3072, 4096, XN, vcu, G);
    else if constexpr (PH == 2) {
        pg8::Gemm g{XN, (const bf16*)(ws + WS_WIN), 17408, 2560, 1024}; pg8::OrderQKV S; S.init(G, bx);
        pg8::EpiRoute E{(bf16*)(ws + WS_POOL), (bf16*)(ws + WS_Q), (bf16*)(ws + WS_K), (bf16*)(ws + WS_V), a.in[14], a.in[15], (const float*)(ws + WS_ROPE)};
        pg8::gemm_phase<pg8::EpiRoute, pg8::OrderQKV, true, true>((LAS unsigned char*)lds, g, S, E);
    }
    else if constexpr (PH == 3) {}
    else if constexpr (PH == 4) { pool_phase(a, lds, vcu, G); attn_phase(a, lds, vcu, G);
#ifdef PROBE_ATT2
        attn_phase(a, lds, vcu, G);
#endif
    }
    else if constexpr (PH == 5 || PH == 8 || PH == 12 || PH == 15) {
        pg8::Gemm g; const float* gate; const float* bf = nullptr; const bf16* bh = XR; float* of = nullptr; bf16* oh = XR;
        if constexpr (PH == 5)       { g = pg8::Gemm{(const bf16*)(ws + WS_Y),  (const bf16*)(ws + WS_WOUT),  MTOK, 1024, 1024}; gate = mod + 2048; bf = a.in[0]; bh = nullptr; }
        else if constexpr (PH == 8)  { g = pg8::Gemm{(const bf16*)(ws + WS_HB), (const bf16*)(ws + WS_W2),    MTOK, 1024, 4096}; gate = mod + 5120; }
        else if constexpr (PH == 12) { g = pg8::Gemm{(const bf16*)(ws + WS_U),  (const bf16*)(ws + WS_ODOUT), MTOK, 1024, 2048}; gate = mod + 5 * MODW + 2048; }
        else                         { g = pg8::Gemm{(const bf16*)(ws + WS_HB), (const bf16*)(ws + WS_W2) + (size_t)1024 * 4096, MTOK, 1024, 4096}; gate = mod + 5 * MODW + 5120; of = a.out; oh = nullptr; }
        pg8::StaticOrder S; S.init(g.M, g.N, G, bx);
        constexpr int RM = (PH == 5) ? 0 : (PH == 15 ? 2 : 1);
        pg8::EpiRes<RM> E{bf, bh, of, oh, gate};
        pg8::gemm_phase<pg8::EpiRes<RM>, pg8::StaticOrder, true, true>((LAS unsigned char*)lds, g, S, E);
    }
    else if constexpr (PH == 7 || PH == 14) {
        pg8::Gemm g{XN, (const bf16*)(ws + WS_W1) + (PH == 14 ? (size_t)4096 * 1024 : 0), MTOK, FF, 1024}; pg8::EpiAct<false> E{(bf16*)(ws + WS_HB), FF, 2, nullptr};
        pg8::StaticOrder S; S.init(g.M, g.N, G, bx);
        pg8::gemm_phase<pg8::EpiAct<false>, pg8::StaticOrder, true, true>((LAS unsigned char*)lds, g, S, E);
    }
    else if constexpr (PH == 10) {
        { pg8::Gemm g{XN, (const bf16*)(ws + WS_ODIN), MTOK, 2048, 1024}; pg8::EpiAct<false> E{(bf16*)(ws + WS_U), 2048, 1, nullptr};
          pg8::StaticOrder S; S.init(g.M, g.N, G, bx);
          pg8::gemm_phase<pg8::EpiAct<false>, pg8::StaticOrder, true, true>((LAS unsigned char*)lds, g, S, E); }
        { pg8::Gemm g{(const bf16*)(ws + WS_ODIN) + (size_t)2048 * 1024, XN, 2048, MTOK, 1024}; pg8::EpiAct<true> E{(bf16*)(ws + WS_VT), MTOK, 1, (float*)(ws + WS_PART)};
          pg8::StaticOrder S; S.init(g.M, g.N, G, bx);
          pg8::gemm_phase<pg8::EpiAct<true>, pg8::StaticOrder, true, true>((LAS unsigned char*)lds, g, S, E); }
    }
    else if constexpr (PH == 11) { spatial_phase(a, lds, vcu, G);
#ifdef PROBE_SP2
        spatial_phase(a, lds, vcu, G, true);
#endif
    }
}
constexpr int XBAR_LDS_OFF = LDS_BYTES - 64;
__global__ void __launch_bounds__(NTHR) fwd_megakernel(Args a) {
    extern __shared__ __attribute__((aligned(16))) unsigned char lds[];
    const int G = gridDim.x, bx = blockIdx.x;
    const int vcu = (G % 8 == 0) ? (bx % 8) * (G / 8) + bx / 8 : bx;
    volatile LAS unsigned* xst = (volatile LAS unsigned*)((LAS unsigned char*)lds + XBAR_LDS_OFF);
    if (threadIdx.x < 2) xst[threadIdx.x] = 0u;
    __syncthreads();
    XcdBarrier bar; bar.bar = (unsigned*)a.ws; bar.x = 0; bar.st = xst;
    const bool fused = (a.ph_hi - a.ph_lo) > 1;
    if (fused) bar = xcd_barrier_post((unsigned*)a.ws, xst);
    if (a.ph_hi > NPH) cg::this_grid().sync();
#define PHASE(k) if ((k) != 3 && a.ph_lo <= (k) && (k) < a.ph_hi) { run_phase<k>(a, lds, vcu, G, bx); if ((k) + 1 < a.ph_hi) { xcd_barrier(bar); PROBE_XB } }
    PHASE(0) PHASE(1) PHASE(2) PHASE(3) PHASE(4) PHASE(5) PHASE(6) PHASE(7) PHASE(8) PHASE(9) PHASE(10) PHASE(11) PHASE(12) PHASE(13) PHASE(14) PHASE(15)
#undef PHASE
}

extern "C" void kernel_launch(void* const* d_in, const int* in_sizes, int n_in, void* d_out, int out_size, void* d_ws, size_t ws_size, hipStream_t stream) {
    static int grid = 0;
    if (grid == 0) {
        if (n_in != 27 || in_sizes[0] != MTOK * DM || out_size != MTOK * DM || ws_size < WS_END) { fprintf(stderr, "kernel_launch: unexpected shapes (n_in %d, in0 %d, out %d, ws %zu)\n", n_in, n_in > 0 ? in_sizes[0] : -1, out_size, ws_size); grid = -1; return; }
        if (hipFuncSetAttribute((const void*)fwd_megakernel, hipFuncAttributeMaxDynamicSharedMemorySize, LDS_BYTES) != hipSuccess) { fprintf(stderr, "kernel_launch: hipFuncSetAttribute failed\n"); grid = -1; return; }
        int dev = 0, cus = 0, per_cu = 0;
        (void)hipGetDevice(&dev); (void)hipDeviceGetAttribute(&cus, hipDeviceAttributeMultiprocessorCount, dev);
        (void)hipOccupancyMaxActiveBlocksPerMultiprocessor(&per_cu, (const void*)fwd_megakernel, NTHR, LDS_BYTES);
        if (per_cu < 1 || cus < 256) fprintf(stderr, "kernel_launch: note: occupancy query %d blocks/CU, %d CUs\n", per_cu, cus);
        (void)hipGetLastError();
        grid = 256;
    }
    if (grid < 0) return;
    Args a{};
    for (int i = 0; i < 27; ++i) a.in[i] = (const float*)d_in[i];
    a.out = (float*)d_out; a.ws = (unsigned char*)d_ws;
#if MK_MULTI
#if MK_DEBUG
    float* res = (float*)d_ws; (void)hipMemsetAsync(res, 0, 256, stream);
    unsigned char* ws = (unsigned char*)d_ws; float* mod = (float*)(ws + WS_MOD); float* snap = (float*)(ws + 220 * MiB);
#endif
    for (int ph = 0; ph < NPH_RUN; ++ph) { a.ph_lo = ph; a.ph_hi = ph + 1;
#if MK_DEBUG
        if (ph == 8 || ph == 12 || ph == 15) hipLaunchKernelGGL(chk_copy, dim3(2048), dim3(256), 0, stream, (const float*)d_out, snap, (size_t)8192 * 1024 / 4);
#endif
#if MK_DEBUG
        if (ph == 6 && MK_SIMPLE6) hipLaunchKernelGGL(simple_norm, dim3(16384), dim3(256), 0, stream, (const float*)d_out, a.in[7], (const float*)(mod + 3072), (const float*)(mod + 4096), 6144, (bf16*)(ws + WS_XN)); else
#endif
        hipLaunchKernelGGL(fwd_megakernel, dim3(grid), dim3(NTHR), LDS_BYTES, stream, a);
#if MK_DEBUG
        if (ph == 0) { hipLaunchKernelGGL(chk_mod, dim3(240), dim3(256), 0, stream, a, res);
            hipLaunchKernelGGL(chk_wt, dim3(16), dim3(256), 0, stream, a.in[10], 1024, 2560, (const bf16*)(ws + WS_WIN), res, 1);
            hipLaunchKernelGGL(chk_wt, dim3(16), dim3(256), 0, stream, a.in[11], 1024, 1024, (const bf16*)(ws + WS_WOUT), res, 1);
            hipLaunchKernelGGL(chk_wt, dim3(16), dim3(256), 0, stream, a.in[8], 1024, 4096, (const bf16*)(ws + WS_W1), res, 1);
            hipLaunchKernelGGL(chk_wt, dim3(16), dim3(256), 0, stream, a.in[8] + 1024 * 4096, 1024, 4096, (const bf16*)(ws + WS_W1) + 4096 * 1024, res, 1);
            hipLaunchKernelGGL(chk_wt, dim3(16), dim3(256), 0, stream, a.in[9], 4096, 1024, (const bf16*)(ws + WS_W2), res, 1);
            hipLaunchKernelGGL(chk_wt, dim3(16), dim3(256), 0, stream, a.in[9] + 1024 * 4096, 4096, 1024, (const bf16*)(ws + WS_W2) + 4096 * 1024, res, 1);
            hipLaunchKernelGGL(chk_wt, dim3(16), dim3(256), 0, stream, a.in[21], 1024, 4096, (const bf16*)(ws + WS_ODIN), res, 1);
            hipLaunchKernelGGL(chk_wt, dim3(16), dim3(256), 0, stream, a.in[26], 2048, 1024, (const bf16*)(ws + WS_ODOUT), res, 1); }
        if (ph == 1) { hipLaunchKernelGGL(chk_norm, dim3(128), dim3(256), 0, stream, a.in[0], a.in[6], (const float*)mod, (const float*)(mod + 1024), 6144, (const bf16*)(ws + WS_XN), 16384, 4096, res, 2);
            hipLaunchKernelGGL(chk_norm, dim3(64), dim3(256), 0, stream, a.in[2], a.in[6], (const float*)(mod + 4 * 6144), (const float*)(mod + 4 * 6144 + 1024), 0, (const bf16*)(ws + WS_XN) + (size_t)16384 * 1024, 1024, 0, res, 2); }
        if (ph == 2) hipLaunchKernelGGL(chk_gemm1, dim3(32), dim3(256), 0, stream, a, res);
        if (ph == 3) { hipLaunchKernelGGL(chk_qk, dim3(512), dim3(64), 0, stream, a, res); hipLaunchKernelGGL(chk_pool, dim3(16), dim3(256), 0, stream, a, res); }
        if (ph == 4) hipLaunchKernelGGL(chk_attn, dim3(96), dim3(256), 0, stream, a, res);
        if (ph == 5) hipLaunchKernelGGL(chk_res, dim3(16), dim3(256), 0, stream, (const bf16*)(ws + WS_Y), (const bf16*)(ws + WS_WOUT), 1024, a.in[0], (const float*)(mod + 2048), (const float*)d_out, res, 7, 16384);
        if (ph == 6) hipLaunchKernelGGL(chk_norm, dim3(128), dim3(256), 0, stream, (const float*)d_out, a.in[7], (const float*)(mod + 3072), (const float*)(mod + 4096), 6144, (const bf16*)(ws + WS_XN), 16384, 4096, res, 8);
        if (ph == 7) hipLaunchKernelGGL(chk_act, dim3(16), dim3(256), 0, stream, (const bf16*)(ws + WS_XN), (const bf16*)(ws + WS_W1), 1024, 4096, (const bf16*)(ws + WS_HB), 4096, 2, 0, res, 9);
        if (ph == 8) hipLaunchKernelGGL(chk_res, dim3(16), dim3(256), 0, stream, (const bf16*)(ws + WS_HB), (const bf16*)(ws + WS_W2), 4096, (const float*)snap, (const float*)(mod + 5120), (const float*)d_out, res, 10, 8192);
        if (ph == 9) hipLaunchKernelGGL(chk_norm, dim3(128), dim3(256), 0, stream, (const float*)d_out, a.in[6] + 1024, (const float*)(mod + 5 * 6144), (const float*)(mod + 5 * 6144 + 1024), 6144, (const bf16*)(ws + WS_XN), 16384, 4096, res, 11);
        if (ph == 10) { hipLaunchKernelGGL(chk_act, dim3(16), dim3(256), 0, stream, (const bf16*)(ws + WS_XN), (const bf16*)(ws + WS_ODIN), 1024, 2048, (const bf16*)(ws + WS_U), 2048, 1, 0, res, 12);
            hipLaunchKernelGGL(chk_act, dim3(16), dim3(256), 0, stream, (const bf16*)(ws + WS_XN), (const bf16*)(ws + WS_ODIN) + (size_t)2048 * 1024, 1024, 2048, (const bf16*)(ws + WS_VT), 16384, 1, 1, res, 13); }
#endif
    }
#if MK_DEBUG
    if (NPH_RUN == 16) hipLaunchKernelGGL(chk_final, dim3(1), dim3(1), 0, stream, res, (float*)d_out, 14);
#endif
#else
    a.ph_lo = 0; a.ph_hi = NPH;
    if (hipMemsetAsync(d_ws, 0, 16384, stream) != hipSuccess) { fprintf(stderr, "kernel_launch: memset of the barrier words failed\n"); return; }
    void* args[] = {&a};
    hipError_t e = hipLaunchCooperativeKernel((const void*)fwd_megakernel, dim3(grid), dim3(NTHR), args, LDS_BYTES, stream);
    if (e != hipSuccess) fprintf(stderr, "kernel_launch: cooperative launch failed: %s\n", hipGetErrorString(e));
#endif
}
```
